# Optimizing an MI355X kernel written in HIP

```python
import jax, jax.numpy as jnp
from jax import lax
import numpy as np

D_MODEL = 1024
BATCH = 8
SEQ = 4096
DEPTH = 4

GRID_W = 64
CTX_LEN = 256
N_MIXERS = 3
D_FF = 4 * D_MODEL
N_MOD = 6
LN_EPS = 1e-6
DEEPNORM_ALPHA = (2.0 * DEPTH) ** 0.25
DEEPNORM_BETA = (8.0 * DEPTH) ** -0.25

ATT_HEAD_DIM = 128
ATT_HEADS = D_MODEL // ATT_HEAD_DIM
ATT_KV_HEADS = 2
ATT_GROUPS = ATT_HEADS // ATT_KV_HEADS
ATT_QKV = (ATT_HEADS + 2 * ATT_KV_HEADS) * ATT_HEAD_DIM
ATT_BLOCK = 128
ROPE_BASE = 10000.0

NA_HEAD_DIM = 64
NA_HEADS = D_MODEL // NA_HEAD_DIM
NA_WIN_H = 8
NA_WIN_W = 16

RW_HEAD = 64
RW_HEADS = D_MODEL // RW_HEAD
RW_DECAY_LORA = 64
RW_AAA_LORA = 64
RW_GATE_LORA = 128
RW_GN_EPS = 64e-5
N_DIR = 2

N_LAYERS_A = (DEPTH + 2) // 3
N_LAYERS_B = (DEPTH + 1) // 3
N_LAYERS_C = DEPTH // 3

kernel_name = 'hybrid_dit_gqa_natten_rwkv7'


def _layernorm(x, g, b):
    xf = x.astype(jnp.float32)
    mu = jnp.mean(xf, -1, keepdims=True)
    var = jnp.mean(jnp.square(xf - mu), -1, keepdims=True)
    return ((xf - mu) * lax.rsqrt(var + LN_EPS) * g + b).astype(x.dtype)


def _rmsnorm(x, g):
    xf = x.astype(jnp.float32)
    return (xf * lax.rsqrt(jnp.mean(xf * xf, -1, keepdims=True) + LN_EPS) * g).astype(x.dtype)


def _modulation(cond, w, b):
    m = jax.nn.silu(cond) @ w + b
    return jnp.split(m[..., None, :], N_MOD, axis=-1)


def _sqrelu_mlp(h, w1, w2):
    return jnp.square(jax.nn.relu(h @ w1)) @ w2


def _axial_rope(n_tokens, head_dim):
    t = jnp.arange(n_tokens)
    row = (t // GRID_W).astype(jnp.float32)
    col = (t % GRID_W).astype(jnp.float32)
    half = head_dim // 2
    freqs = ROPE_BASE ** (-jnp.arange(0, half, 2, dtype=jnp.float32) / half)
    ang_r = row[:, None] * freqs[None, :]
    ang_c = col[:, None] * freqs[None, :]
    ang = jnp.concatenate([ang_r, ang_r, ang_c, ang_c], axis=-1)
    return jnp.cos(ang), jnp.sin(ang)


def _apply_rope(x, cos, sin):
    x1, x2, x3, x4 = jnp.split(x, 4, axis=-1)
    rot = jnp.concatenate([-x2, x1, -x4, x3], axis=-1)
    return (x * cos[:, None] + rot * sin[:, None]).astype(x.dtype)


def _gqa_attend(qb, k, v):
    b, q_len = qb.shape[:2]
    qg = qb.reshape(b, q_len, ATT_KV_HEADS, ATT_GROUPS, ATT_HEAD_DIM)
    s = jnp.einsum('bqkgd,btkd->bkgqt', qg, k, preferred_element_type=jnp.float32) * (ATT_HEAD_DIM ** -0.5)
    p = jax.nn.softmax(s, axis=-1).astype(v.dtype)
    o = jnp.einsum('bkgqt,btkd->bqkgd', p, v)
    return o.reshape(b, q_len, ATT_HEADS * ATT_HEAD_DIM)


def _gqa_axial_attention(h, hc, wqkv, wo, q_norm, k_norm, want_ctx):
    B, S, _ = h.shape
    split = [ATT_HEADS * ATT_HEAD_DIM, (ATT_HEADS + ATT_KV_HEADS) * ATT_HEAD_DIM]

    def project(u):
        b, t = u.shape[:2]
        q, k, v = jnp.split(u @ wqkv, split, axis=-1)
        q = _rmsnorm(q.reshape(b, t, ATT_HEADS, ATT_HEAD_DIM), q_norm)
        k = _rmsnorm(k.reshape(b, t, ATT_KV_HEADS, ATT_HEAD_DIM), k_norm)
        return q, k, v.reshape(b, t, ATT_KV_HEADS, ATT_HEAD_DIM)

    q, k, v = project(h)
    qc, kc, vc = project(hc)
    cos, sin = _axial_rope(S, ATT_HEAD_DIM)
    q = _apply_rope(q, cos, sin)
    k = _apply_rope(k, cos, sin)
    k_all = jnp.concatenate([k, kc], axis=1)
    v_all = jnp.concatenate([v, vc], axis=1)
    n_blk = S // ATT_BLOCK
    q_blk = jnp.moveaxis(q.reshape(B, n_blk, ATT_BLOCK, ATT_HEADS, ATT_HEAD_DIM), 1, 0)
    o = lax.map(lambda qb: _gqa_attend(qb, k_all, v_all), q_blk)
    y = jnp.moveaxis(o, 0, 1).reshape(B, S, ATT_HEADS * ATT_HEAD_DIM) @ wo
    yc = _gqa_attend(qc, kc, vc) @ wo if want_ctx else None
    return y, yc


def _neighbourhood_attention(h, hc, wqkv, wo, rpb, want_ctx):
    B, S, _ = h.shape
    rows = S // GRID_W
    wr = min(NA_WIN_H, rows)
    scale = NA_HEAD_DIM ** -0.5

    def project(u):
        shp = u.shape[:2] + (NA_HEADS, NA_HEAD_DIM)
        q, k, v = jnp.split(u @ wqkv, 3, axis=-1)
        return q.reshape(shp), k.reshape(shp), v.reshape(shp)

    q, k, v = project(h)
    qc, kc, vc = project(hc)
    grid = (B, rows, GRID_W, NA_HEADS, NA_HEAD_DIM)
    k_grid, v_grid = k.reshape(grid), v.reshape(grid)
    q_rows = jnp.moveaxis(q.reshape(grid), 1, 0)
    col = jnp.arange(GRID_W)
    col_idx = jnp.clip(col - NA_WIN_W // 2, 0, GRID_W - NA_WIN_W)[:, None] + jnp.arange(NA_WIN_W)[None, :]
    dc = col_idx - col[:, None] + (NA_WIN_W - 1)
    n_loc = wr * NA_WIN_W

    def row_block(args):
        r, qr = args
        r0 = jnp.clip(r - wr // 2, 0, rows - wr)
        k_win = lax.dynamic_slice_in_dim(k_grid, r0, wr, axis=1)[:, :, col_idx]
        v_win = lax.dynamic_slice_in_dim(v_grid, r0, wr, axis=1)[:, :, col_idx]
        dr = r0 + jnp.arange(wr) - r + (NA_WIN_H - 1)
        bias = jnp.transpose(rpb[:, dr[:, None, None], dc[None, :, :]], (0, 2, 1, 3))
        s_loc = jnp.einsum('bqhd,bjqwhd->bhqjw', qr, k_win, preferred_element_type=jnp.float32) * scale + bias
        s_ctx = jnp.einsum('bqhd,blhd->bhql', qr, kc, preferred_element_type=jnp.float32) * scale
        p = jax.nn.softmax(jnp.concatenate([s_loc.reshape(B, NA_HEADS, GRID_W, n_loc), s_ctx], axis=-1), axis=-1).astype(v.dtype)
        p_loc = p[..., :n_loc].reshape(B, NA_HEADS, GRID_W, wr, NA_WIN_W)
        o = jnp.einsum('bhqjw,bjqwhd->bqhd', p_loc, v_win) + jnp.einsum('bhql,blhd->bqhd', p[..., n_loc:], vc)
        return o.reshape(B, GRID_W, D_MODEL)

    o = lax.map(row_block, (jnp.arange(rows), q_rows))
    y = jnp.moveaxis(o, 0, 1).reshape(B, S, D_MODEL) @ wo
    yc = None
    if want_ctx:
        sc = jnp.einsum('bqhd,blhd->bhql', qc, kc, preferred_element_type=jnp.float32) * scale
        oc = jnp.einsum('bhql,blhd->bqhd', jax.nn.softmax(sc, axis=-1).astype(vc.dtype), vc)
        yc = oc.reshape(B, hc.shape[1], D_MODEL) @ wo
    return y, yc


def _token_shift_centred(x):
    prev = jnp.pad(x[:, :-1], ((0, 0), (1, 0), (0, 0)))
    nxt = jnp.pad(x[:, 1:], ((0, 0), (0, 1), (0, 0)))
    return 0.5 * (prev + nxt) - x


def _time_major_bidir(u):
    u = jnp.stack([u[0], jnp.flip(u[1], axis=1)])
    return jnp.moveaxis(u, 2, 0).astype(jnp.float32)


def _rwkv_prepare(h, p):
    B, T, _ = h.shape
    hs = (B, T, RW_HEADS, RW_HEAD)
    dhs = (N_DIR,) + hs
    xx = _token_shift_centred(h)
    xr, xw, xk, xv, xa, xg = [h + xx * p['mu'][j] for j in range(6)]
    r = (xr @ p['wr']).reshape(hs)
    k = xk @ p['wk']
    v = (xv @ p['wv']).reshape(hs)
    w = p['w0'][:, None, None] + jnp.einsum('nbtr,nrd->nbtd', jnp.tanh(jnp.einsum('btd,ndr->nbtr', xw, p['w1'])), p['w2'])
    w = -jax.nn.softplus(-w.astype(jnp.float32)) - 0.5
    a = jax.nn.sigmoid(p['a0'][:, None, None] + jnp.einsum('nbtr,nrd->nbtd', jnp.einsum('btd,ndr->nbtr', xa, p['a1']), p['a2']))
    g = jax.nn.sigmoid(xg @ p['g1']) @ p['g2']
    kk = (k * p['k_k']).reshape(hs).astype(jnp.float32)
    kk = kk * lax.rsqrt(jnp.maximum(jnp.sum(kk * kk, -1, keepdims=True), 1e-12))
    k_dir = (k[None] * (1.0 + (a - 1.0) * p['k_a'])).reshape(dhs)
    a = a.reshape(dhs)
    decay = jnp.exp(-jnp.exp(w)).reshape(dhs)
    both = lambda u: jnp.broadcast_to(u, dhs)
    scan_in = (_time_major_bidir(both(r)), _time_major_bidir(decay), _time_major_bidir(k_dir),
               _time_major_bidir(both(v)), _time_major_bidir(both(-kk)), _time_major_bidir(kk[None] * a))
    return scan_in, r, k_dir, v, g


def _rwkv_scan(scan_in, s0, emit):
    def step(s, inp):
        r_t, w_t, k_t, v_t, a_t, b_t = inp
        sa = jnp.einsum('nbhij,nbhj->nbhi', s, a_t)
        s = s * w_t[..., None, :] + sa[..., None] * b_t[..., None, :] + v_t[..., None] * k_t[..., None, :]
        return s, (jnp.einsum('nbhij,nbhj->nbhi', s, r_t) if emit else None)
    return lax.scan(step, s0, scan_in)


def _rwkv_output(ys, r, k_dir, v, g, p):
    y = ys[:, 0] + jnp.flip(ys[:, 1], axis=0)
    y = jnp.moveaxis(y, 0, 1)
    mu = jnp.mean(y, -1, keepdims=True)
    var = jnp.mean(jnp.square(y - mu), -1, keepdims=True)
    y = (y - mu) * lax.rsqrt(var + RW_GN_EPS) * p['lnx_g'].reshape(RW_HEADS, RW_HEAD) + p['lnx_b'].reshape(RW_HEADS, RW_HEAD)
    bonus = jnp.sum(jnp.sum(r[None] * k_dir * p['r_k'], -1, keepdims=True), axis=0) * v
    y = (y + bonus).astype(g.dtype).reshape(g.shape)
    return (y * g) @ p['wo']


def _bidir_rwkv7(h, hc, p, want_ctx):
    B = h.shape[0]
    ctx_in, rc, kc, vc, gc = _rwkv_prepare(hc, p)
    lat_in, r, k, v, g = _rwkv_prepare(h, p)
    s0 = jnp.zeros((N_DIR, B, RW_HEADS, RW_HEAD, RW_HEAD), jnp.float32)
    s_ctx, ys_ctx = _rwkv_scan(ctx_in, s0, want_ctx)
    _, ys = _rwkv_scan(lat_in, s_ctx, True)
    y = _rwkv_output(ys, r, k, v, g, p)
    yc = _rwkv_output(ys_ctx, rc, kc, vc, gc, p) if want_ctx else None
    return y, yc


def setup_inputs(seed: int = 0) -> dict:
    key = jax.random.key(seed)
    keys = iter(jax.random.split(key, 64))

    def nrm(shape, scale):
        return jax.random.normal(next(keys), shape, jnp.float32) * scale

    D = D_MODEL
    sD = D ** -0.5
    return {
        'x': nrm((BATCH, SEQ, D), 1.0),
        'c': nrm((BATCH, D), 1.0),
        'ctx': nrm((BATCH, CTX_LEN, D), 1.0),
        'c_ctx': nrm((D,), 1.0),
        'mod_w': nrm((DEPTH, D, N_MOD * D), 0.5 * sD),
        'mod_b': nrm((DEPTH, N_MOD * D), 0.01),
        'post_ln_g': 1.0 + nrm((DEPTH, 2, D), 0.02),
        'post_ln_b': nrm((DEPTH, 2, D), 0.02),
        'mlp_w1': nrm((DEPTH, D, D_FF), sD),
        'mlp_w2': nrm((DEPTH, D_FF, D), D_FF ** -0.5 * DEEPNORM_BETA),
        'att_wqkv': nrm((N_LAYERS_A, D, ATT_QKV), sD),
        'att_wo': nrm((N_LAYERS_A, ATT_HEADS * ATT_HEAD_DIM, D), sD * DEEPNORM_BETA),
        'att_q_norm': 1.0 + nrm((N_LAYERS_A, ATT_HEAD_DIM), 0.02),
        'att_k_norm': 1.0 + nrm((N_LAYERS_A, ATT_HEAD_DIM), 0.02),
        'na_wqkv': nrm((N_LAYERS_B, D, 3 * D), sD),
        'na_wo': nrm((N_LAYERS_B, D, D), sD * DEEPNORM_BETA),
        'na_rpb': nrm((N_LAYERS_B, NA_HEADS, 2 * NA_WIN_H - 1, 2 * NA_WIN_W - 1), 0.1),
        'rw_mu': jax.random.uniform(next(keys), (N_LAYERS_C, 6, D), jnp.float32),
        'rw_wr': nrm((N_LAYERS_C, D, D), sD),
        'rw_wk': nrm((N_LAYERS_C, D, D), sD),
        'rw_wv': nrm((N_LAYERS_C, D, D), sD),
        'rw_wo': nrm((N_LAYERS_C, D, D), sD * DEEPNORM_BETA),
        'rw_w0': -2.0 + nrm((N_LAYERS_C, N_DIR, D), 0.5),
        'rw_w1': nrm((N_LAYERS_C, N_DIR, D, RW_DECAY_LORA), sD),
        'rw_w2': nrm((N_LAYERS_C, N_DIR, RW_DECAY_LORA, D), 0.5 * RW_DECAY_LORA ** -0.5),
        'rw_a0': nrm((N_LAYERS_C, N_DIR, D), 0.5),
        'rw_a1': nrm((N_LAYERS_C, N_DIR, D, RW_AAA_LORA), sD),
        'rw_a2': nrm((N_LAYERS_C, N_DIR, RW_AAA_LORA, D), 0.5 * RW_AAA_LORA ** -0.5),
        'rw_g1': nrm((N_LAYERS_C, D, RW_GATE_LORA), sD),
        'rw_g2': nrm((N_LAYERS_C, RW_GATE_LORA, D), RW_GATE_LORA ** -0.5),
        'rw_k_k': 0.85 + nrm((N_LAYERS_C, D), 0.02),
        'rw_k_a': 1.0 + nrm((N_LAYERS_C, D), 0.02),
        'rw_r_k': nrm((N_LAYERS_C, RW_HEADS, RW_HEAD), 0.1),
        'rw_lnx_g': 1.0 + nrm((N_LAYERS_C, D), 0.02),
        'rw_lnx_b': nrm((N_LAYERS_C, D), 0.02),
    }


def reference(x, c, ctx, c_ctx, mod_w, mod_b, post_ln_g, post_ln_b, mlp_w1, mlp_w2,
              att_wqkv, att_wo, att_q_norm, att_k_norm, na_wqkv, na_wo, na_rpb,
              rw_mu, rw_wr, rw_wk, rw_wv, rw_wo, rw_w0, rw_w1, rw_w2, rw_a0, rw_a1, rw_a2,
              rw_g1, rw_g2, rw_k_k, rw_k_a, rw_r_k, rw_lnx_g, rw_lnx_b):
    xc = ctx
    for i in range(DEPTH):
        kind, slot = i % N_MIXERS, i // N_MIXERS
        want_ctx = i < DEPTH - 1
        sh1, sc1, gt1, sh2, sc2, gt2 = _modulation(c, mod_w[i], mod_b[i])
        csh1, csc1, cgt1, csh2, csc2, cgt2 = _modulation(c_ctx, mod_w[i], mod_b[i])
        h = x * (1.0 + sc1) + sh1
        hc = xc * (1.0 + csc1) + csh1
        if kind == 0:
            y, yc = _gqa_axial_attention(h, hc, att_wqkv[slot], att_wo[slot], att_q_norm[slot], att_k_norm[slot], want_ctx)
        elif kind == 1:
            y, yc = _neighbourhood_attention(h, hc, na_wqkv[slot], na_wo[slot], na_rpb[slot], want_ctx)
        else:
            p = {'mu': rw_mu[slot], 'wr': rw_wr[slot], 'wk': rw_wk[slot], 'wv': rw_wv[slot], 'wo': rw_wo[slot],
                 'w0': rw_w0[slot], 'w1': rw_w1[slot], 'w2': rw_w2[slot], 'a0': rw_a0[slot], 'a1': rw_a1[slot],
                 'a2': rw_a2[slot], 'g1': rw_g1[slot], 'g2': rw_g2[slot], 'k_k': rw_k_k[slot], 'k_a': rw_k_a[slot],
                 'r_k': rw_r_k[slot], 'lnx_g': rw_lnx_g[slot], 'lnx_b': rw_lnx_b[slot]}
            y, yc = _bidir_rwkv7(h, hc, p, want_ctx)
        x = _layernorm(DEEPNORM_ALPHA * x + gt1 * y, post_ln_g[i, 0], post_ln_b[i, 0])
        x = _layernorm(DEEPNORM_ALPHA * x + gt2 * _sqrelu_mlp(x * (1.0 + sc2) + sh2, mlp_w1[i], mlp_w2[i]),
                       post_ln_g[i, 1], post_ln_b[i, 1])
        if want_ctx:
            xc = _layernorm(DEEPNORM_ALPHA * xc + cgt1 * yc, post_ln_g[i, 0], post_ln_b[i, 0])
            xc = _layernorm(DEEPNORM_ALPHA * xc + cgt2 * _sqrelu_mlp(xc * (1.0 + csc2) + csh2, mlp_w1[i], mlp_w2[i]),
                            post_ln_g[i, 1], post_ln_b[i, 1])
    return x
```

```cpp
#include <hip/hip_runtime.h>
#include <hip/hip_cooperative_groups.h>
#include <cstdio>
#include <cstdint>
namespace cg = cooperative_groups;

#ifndef FUSED
#define FUSED 0
#endif

typedef unsigned short u16;
typedef short v8s __attribute__((ext_vector_type(8)));
typedef short v4s __attribute__((ext_vector_type(4)));
typedef float v2f __attribute__((ext_vector_type(2)));
typedef float v4f __attribute__((ext_vector_type(4)));
typedef float v16f __attribute__((ext_vector_type(16)));
typedef unsigned v4u __attribute__((ext_vector_type(4)));
typedef unsigned v2u __attribute__((ext_vector_type(2)));

constexpr int D = 1024, NB = 8, SEQ = 4096, CTXL = 256, TB = SEQ + CTXL, M = NB * TB;
constexpr float ALPHA = 1.6817928305074292f;
constexpr float LN_EPS = 1e-6f;
constexpr float LOG2E = 1.4426950408889634f;
constexpr size_t MiB = (size_t)1 << 20;
constexpr int LDS_BYTES = 131072 + 1024;
constexpr int NPHASE = 34;

constexpr size_t OFF_WB = 0;
constexpr size_t OFF_XC = 34 * MiB;
constexpr size_t OFF_MOD = 42 * MiB;
constexpr size_t OFF_TAB = 43 * MiB;
constexpr size_t OFF_BON = 44 * MiB;
constexpr size_t OFF_AR = 50 * MiB;
constexpr size_t WB_W1T = 0, WB_W2T = 8 * MiB, WB_MIX = 16 * MiB;
constexpr size_t WB_ATT_WO = 19 * MiB, WB_NA_WO = 22 * MiB, WB_RW_WO = 30 * MiB, WB_RW_BG = 32 * MiB, WB_RW_W2T = 32 * MiB + 768 * 1024, WB_RW_A2T = 33 * MiB;
constexpr size_t AR_H = 0;
constexpr size_t AR_QKV = 68 * MiB, AR_ATT_O = 170 * MiB;
constexpr size_t AR_NA_QK = 68 * MiB, AR_NA_VT = 204 * MiB, AR_NA_O = 272 * MiB;
constexpr size_t AR_HID = 68 * MiB;
constexpr size_t AR_Y0 = 0, AR_Y1 = 68 * MiB, AR_R = 136 * MiB, AR_K = 204 * MiB, AR_V = 272 * MiB, AR_L1 = 340 * MiB, AR_G = 366 * MiB, AR_YG = 136 * MiB;

struct P {
  const float *x, *c, *ctx, *c_ctx, *mod_w, *mod_b, *ln_g, *ln_b, *mlp_w1, *mlp_w2;
  const float *att_wqkv, *att_wo, *att_qn, *att_kn, *na_wqkv, *na_wo, *na_rpb;
  const float *rw_mu, *rw_wr, *rw_wk, *rw_wv, *rw_wo, *rw_w0, *rw_w1, *rw_w2, *rw_a0, *rw_a1, *rw_a2, *rw_g1, *rw_g2, *rw_kk, *rw_ka, *rw_rk, *rw_lng, *rw_lnb;
  float* out; unsigned char* ws;
};

typedef const __attribute__((address_space(4))) P* PP;
__device__ __forceinline__ int get_tid() { int t = threadIdx.x; asm volatile("" : "+v"(t)); return t; }
__device__ __forceinline__ int get_bid() { int t = blockIdx.x; asm volatile("" : "+s"(t)); return t; }
__device__ __forceinline__ int get_gdim() { int t = gridDim.x; asm volatile("" : "+s"(t)); return t; }
__device__ __forceinline__ unsigned cvtpk(float lo, float hi) { unsigned r; asm volatile("v_cvt_pk_bf16_f32 %0, %1, %2" : "=v"(r) : "v"(lo), "v"(hi)); return r; }
__device__ __forceinline__ float bf2f(u16 v) { return __uint_as_float((unsigned)v << 16); }
__device__ __forceinline__ float bflo(unsigned w) { return __uint_as_float(w << 16); }
__device__ __forceinline__ float bfhi(unsigned w) { return __uint_as_float(w & 0xffff0000u); }
__device__ __forceinline__ float wave_sum(float v) {
#pragma unroll
  for (int o = 32; o >= 1; o >>= 1) v += __shfl_xor(v, o);
  return v;
}
template <int CTRL> __device__ __forceinline__ float dppf(float v) { return __int_as_float(__builtin_amdgcn_update_dpp(0, __float_as_int(v), CTRL, 0xF, 0xF, true)); }
__device__ __forceinline__ float row_sum16(float v) { v += dppf<0xB1>(v); v += dppf<0x4E>(v); v += dppf<0x141>(v); v += dppf<0x140>(v); return v; }
__device__ __forceinline__ float* xrow(PP p, int row) {
  const int b = row / TB, t = row - b * TB;
  return t < SEQ ? p->out + (size_t)(b * SEQ + t) * D : (float*)(p->ws + OFF_XC) + (size_t)(b * CTXL + t - SEQ) * D;
}
__device__ __forceinline__ int modidx(int row) { const int b = row / TB, t = row - b * TB; return t < SEQ ? b : 8; }
__device__ __forceinline__ int crow(int r, int hi) { return (r & 3) + 8 * (r >> 2) + 4 * hi; }

namespace pg8 {
#define PG8_LAS __attribute__((address_space(3)))
typedef unsigned short bf16_t;
typedef short bf16x8 __attribute__((ext_vector_type(8)));
typedef float f32x4 __attribute__((ext_vector_type(4)));
typedef unsigned u32x4 __attribute__((ext_vector_type(4)));
constexpr int BM = 256, BK = 64, HALF = 128, HTB = HALF * BK * 2  , STAGE_BYTES = 8 * HTB, NXCD = 8, WGM = 8;

__host__ __device__ __forceinline__ int lds_byte(int r, int c) { const int st = (r >> 4) * 2 + (c >> 5), rr = r & 15, cc = c & 31, ob = rr * 64 + cc * 2; return st * 1024 + (ob ^ (((ob >> 9) & 1) << 5)); }
__host__ __device__ __forceinline__ void stage_rc(int b, int& R, int& C) { const int st = b / 1024, sb = b % 1024, swz = sb ^ (((sb >> 9) & 1) << 5); R = (st >> 1) * 16 + swz / 64; C = (st & 1) * 32 + (swz % 64) / 2; }
__host__ __device__ __forceinline__ int perm32(int rho) { const int n = rho >> 4, i = rho & 15; return 8 * (i >> 2) + 4 * n + (i & 3); }

struct Unit { int pm, pn; };
struct Gemm { const bf16_t* A; const bf16_t* Bt; int M, N, K; };

struct StaticOrder {
    int nM, nN, nwg, G, c;
    __host__ __device__ void init(int M, int N, int G_, int c_) { nM = M / BM; nN = N / BM; nwg = nM * nN; G = G_; c = c_; }
    __host__ __device__ bool next(int i, Unit& u) const {
        const long L = (long)i * G + c; if (L >= nwg) return false;
        int wgid = (int)L; { const int q = nwg / NXCD, r = nwg % NXCD, xcd = wgid % NXCD, off = wgid / NXCD; wgid = (xcd < r ? xcd * (q + 1) : r * (q + 1) + (xcd - r) * q) + off; }
        const int nig = WGM * nN, gid = wgid / nig, fm = gid * WGM, gsz = (nM - fm) < WGM ? (nM - fm) : WGM;
        u.pm = fm + ((wgid % nig) % gsz); u.pn = (wgid % nig) / gsz; return true;
    }
    __device__ __forceinline__ void a_ready(const Unit&) const {}
    __device__ __forceinline__ void done(const Unit&) const {}
};
__device__ __forceinline__ unsigned cvt_pk_bf16(float lo, float hi) { unsigned r; asm volatile("v_cvt_pk_bf16_f32 %0, %1, %2" : "=v"(r) : "v"(lo), "v"(hi)); return r; }
typedef float f32x2 __attribute__((ext_vector_type(2)));
template <class Epi, class Sched, bool STAMP = false>
__device__ __forceinline__ void gemm_phase(PG8_LAS unsigned char* lds, const Gemm g, const Sched& S, const Epi& E, unsigned long long* stamps) {
    const int tid = get_tid(), wid = __builtin_amdgcn_readfirstlane(tid >> 6), lane = tid & 63, wr = wid >> 2, wc = wid & 3, fr = lane & 15, fq = lane >> 4;
    const int K = g.K, nt = K / BK;
    int ts_lo = 0, ts_hi = 0, nts = 0; const unsigned long long rt_entry = STAMP ? (unsigned long long)wall_clock64() : 0ull;
#define PG8_STAMP() do { if (STAMP && wid == 0 && nts < 64) { const unsigned long long _c = (unsigned long long)clock64(); \
        ts_lo = (lane == nts) ? (int)(unsigned)_c : ts_lo; ts_hi = (lane == nts) ? (int)(unsigned)(_c >> 32) : ts_hi; ++nts; } } while (0)
    PG8_STAMP();
    unsigned voffA[2], voffB[2];
#pragma unroll
    for (int i = 0; i < 2; ++i) { int R, C; stage_rc(tid * 16 + i * 8192, R, C); const int Rb = Epi::PERM ? ((R & ~31) + perm32(R & 31)) : R;
        voffA[i] = (unsigned)(R * K + C) * 2u; voffB[i] = (unsigned)(Rb * K + C) * 2u; }
    const size_t kstep = (size_t)(BK * 2);
    const size_t hstep = (size_t)HALF * K * 2;
    const size_t tstep = 2 * hstep;
    const unsigned ldsw = (unsigned)wid * 1024u;
    const int aoff = lds_byte(wr * 64 + fr, fq * 8), boff = lds_byte(wc * 32 + fr, fq * 8);
#define PG8_SA(b, h) (((b) * 2 + (h)) * HTB)
#define PG8_SB(b, h) ((4 + (b) * 2 + (h)) * HTB)
#define PG8_STAGE(bufoff, gbase, voff) do { _Pragma("unroll") for (int _i = 0; _i < 2; ++_i) \
        __builtin_amdgcn_global_load_lds((const unsigned*)((const char*)(gbase) + (voff)[_i]), (PG8_LAS unsigned*)(lds + (bufoff) + ldsw + _i * 8192), 16, 0, 0); } while (0)
#define PG8_LDA(dst, b, h) do { _Pragma("unroll") for (int m = 0; m < 4; ++m) _Pragma("unroll") for (int k = 0; k < 2; ++k) dst[m][k] = *(const PG8_LAS bf16x8*)(lds + PG8_SA(b, h) + aoff + m * 2048 + k * 1024); } while (0)
#define PG8_LDB(dst, b, h) do { _Pragma("unroll") for (int n = 0; n < 2; ++n) _Pragma("unroll") for (int k = 0; k < 2; ++k) dst[n][k] = *(const PG8_LAS bf16x8*)(lds + PG8_SB(b, h) + boff + n * 2048 + k * 1024); } while (0)
#define PG8_MMA(ai, bj, At, Bt) do { __builtin_amdgcn_s_setprio(1); _Pragma("unroll") for (int m = 0; m < 4; ++m) _Pragma("unroll") for (int n = 0; n < 2; ++n) _Pragma("unroll") for (int k = 0; k < 2; ++k) \
        acc[ai][bj][m][n] = __builtin_amdgcn_mfma_f32_16x16x32_bf16(Bt[n][k], At[m][k], acc[ai][bj][m][n], 0, 0, 0); __builtin_amdgcn_s_setprio(0); } while (0)
#define PG8_WAIT_V(n) asm volatile("s_waitcnt vmcnt(" #n ")" ::: "memory")
#define PG8_WAIT_L(n) asm volatile("s_waitcnt lgkmcnt(" #n ")" ::: "memory")
#define PG8_BAR __builtin_amdgcn_s_barrier()
#define PG8_SCHED __builtin_amdgcn_sched_barrier(0)
    Unit cur, nxt; int ui = 0;
    if (!S.next(0, cur)) return;
    f32x4 acc[2][2][4][2];
#pragma unroll
    for (int a = 0; a < 2; ++a)
#pragma unroll
        for (int b = 0; b < 2; ++b)
#pragma unroll
            for (int m = 0; m < 4; ++m)
#pragma unroll
                for (int n = 0; n < 2; ++n) acc[a][b][m][n] = (f32x4){0.f, 0.f, 0.f, 0.f};
    bf16x8 At[4][2], B0[2][2], B1[2][2];
    const char* cA = (const char*)g.A + (size_t)cur.pm * tstep; const char* cB = (const char*)g.Bt + (size_t)cur.pn * tstep;
    S.a_ready(cur);
    PG8_STAGE(PG8_SB(0, 0), cB, voffB); PG8_STAGE(PG8_SA(0, 0), cA, voffA); PG8_STAGE(PG8_SB(0, 1), cB + hstep, voffB); PG8_STAGE(PG8_SA(0, 1), cA + hstep, voffA);
    if (wr == 1) PG8_BAR;
    PG8_WAIT_V(4); PG8_BAR;
    PG8_STAGE(PG8_SB(1, 0), cB + kstep, voffB); PG8_STAGE(PG8_SA(1, 0), cA + kstep, voffA); PG8_STAGE(PG8_SB(1, 1), cB + hstep + kstep, voffB);
    PG8_WAIT_V(6); PG8_BAR;
    PG8_STAMP();
    for (;;) {
        const bool has_next = S.next(ui + 1, nxt);
        const char* nA = has_next ? (const char*)g.A + (size_t)nxt.pm * tstep : cA; const char* nB = has_next ? (const char*)g.Bt + (size_t)nxt.pn * tstep : cB;
        for (int t = 0; t < nt; t += 2) {
            const bool last = (t == nt - 2);
            const char* a1 = cA + (size_t)(t + 1) * kstep;
            const char* a2 = last ? nA : cA + (size_t)(t + 2) * kstep; const char* b2 = last ? nB : cB + (size_t)(t + 2) * kstep;
            const char* a3 = a2 + kstep; const char* b3 = b2 + kstep;
            if (last && has_next) S.a_ready(nxt);
            PG8_LDB(B0, 0, 0); PG8_SCHED; PG8_LDA(At, 0, 0); PG8_STAGE(PG8_SA(1, 1), a1 + hstep, voffA);
            PG8_WAIT_L(8); PG8_BAR; PG8_WAIT_L(0); PG8_MMA(0, 0, At, B0); PG8_BAR; PG8_SCHED;
            PG8_LDB(B1, 0, 1); PG8_STAGE(PG8_SB(0, 0), b2, voffB);
            PG8_BAR; PG8_WAIT_L(0); PG8_MMA(0, 1, At, B1); PG8_BAR;
            PG8_LDA(At, 0, 1); PG8_STAGE(PG8_SA(0, 0), a2, voffA);
            PG8_BAR; PG8_WAIT_L(0); PG8_MMA(1, 0, At, B0); PG8_BAR; PG8_SCHED;
            PG8_STAGE(PG8_SB(0, 1), b2 + hstep, voffB);
            PG8_WAIT_V(6); PG8_BAR; PG8_MMA(1, 1, At, B1); PG8_BAR;
            PG8_LDB(B0, 1, 0); PG8_SCHED; PG8_LDA(At, 1, 0); PG8_STAGE(PG8_SA(0, 1), a2 + hstep, voffA);
            PG8_WAIT_L(8); PG8_BAR; PG8_WAIT_L(0); PG8_MMA(0, 0, At, B0); PG8_BAR; PG8_SCHED;
            PG8_LDB(B1, 1, 1); PG8_STAGE(PG8_SB(1, 0), b3, voffB);
            PG8_BAR; PG8_WAIT_L(0); PG8_MMA(0, 1, At, B1); PG8_BAR;
            PG8_LDA(At, 1, 1); PG8_STAGE(PG8_SA(1, 0), a3, voffA);
            PG8_BAR; PG8_WAIT_L(0); PG8_MMA(1, 0, At, B0); PG8_BAR; PG8_SCHED;
            PG8_STAGE(PG8_SB(1, 1), b3 + hstep, voffB);
            PG8_WAIT_V(6); PG8_BAR; PG8_MMA(1, 1, At, B1); PG8_BAR;
        }
        PG8_STAMP();
        if constexpr (!Epi::AFTER_DRAIN) { E(acc, cur, wr, wc, fr, fq); S.done(cur); }
        PG8_STAMP();
        if (!has_next) break;
#pragma unroll
        for (int a = 0; a < 2; ++a)
#pragma unroll
            for (int b = 0; b < 2; ++b)
#pragma unroll
                for (int m = 0; m < 4; ++m)
#pragma unroll
                    for (int n = 0; n < 2; ++n) acc[a][b][m][n] = (f32x4){0.f, 0.f, 0.f, 0.f};
        cur = nxt; cA = nA; cB = nB; ++ui;
    }
    PG8_WAIT_V(0);
    if (wr == 0) PG8_BAR;
    PG8_BAR;
    if constexpr (Epi::AFTER_DRAIN) { E.fused(acc, cur, wr, wc, fr, fq, lds, wid, lane); S.done(cur); }
    PG8_STAMP();
    if (STAMP && wid == 0) { stamps[lane] = lane < nts ? (((unsigned long long)(unsigned)ts_hi << 32) | (unsigned)ts_lo) : 0ull;
        if (lane == 62) stamps[62] = rt_entry; if (lane == 63) stamps[63] = (unsigned long long)wall_clock64(); }
#undef PG8_STAMP
#undef PG8_SA
#undef PG8_SB
#undef PG8_STAGE
#undef PG8_LDA
#undef PG8_LDB
#undef PG8_MMA
#undef PG8_WAIT_V
#undef PG8_WAIT_L
#undef PG8_BAR
#undef PG8_SCHED
}
}

struct EpiStore {
  static constexpr bool PERM = true, AFTER_DRAIN = false;
  u16* O; int ldc; int act;
  __device__ __forceinline__ void operator()(const pg8::f32x4 (&acc)[2][2][4][2], const pg8::Unit& u, int wr, int wc, int fr, int fq) const {
    const int row0 = u.pm * 256 + wr * 64 + fr, col0 = u.pn * 256 + wc * 32 + 8 * fq;
#pragma unroll
    for (int ai = 0; ai < 2; ++ai)
#pragma unroll
      for (int m = 0; m < 4; ++m) {
        u16* rowp = O + (size_t)(row0 + ai * 128 + m * 16) * ldc + col0;
#pragma unroll
        for (int bj = 0; bj < 2; ++bj) {
          pg8::f32x4 v0 = acc[ai][bj][m][0], v1 = acc[ai][bj][m][1];
          if (act == 1) {
#pragma unroll
            for (int j = 0; j < 4; ++j) { float a = fmaxf(v0[j], 0.f), b = fmaxf(v1[j], 0.f); v0[j] = a * a; v1[j] = b * b; }
          }
          v4u w; w.x = cvtpk(v0[0], v0[1]); w.y = cvtpk(v0[2], v0[3]); w.z = cvtpk(v1[0], v1[1]); w.w = cvtpk(v1[2], v1[3]);
          *(v4u*)(rowp + bj * 128) = w;
        }
      }
  }
};
struct EpiResid {
  static constexpr bool PERM = false, AFTER_DRAIN = false;
  float* out; float* xc; const float* gate;
  __device__ __forceinline__ void operator()(const pg8::f32x4 (&acc)[2][2][4][2], const pg8::Unit& u, int wr, int wc, int fr, int fq) const {
    const int row0 = u.pm * 256 + wr * 64 + fr, col0 = u.pn * 256 + wc * 32 + 4 * fq;
#pragma unroll
    for (int ai = 0; ai < 2; ++ai)
#pragma unroll
      for (int m = 0; m < 4; ++m) {
        const int row = row0 + ai * 128 + m * 16; const int b = row / TB, t = row - b * TB;
        float* xr = t < SEQ ? out + (size_t)(b * SEQ + t) * D : xc + (size_t)(b * CTXL + t - SEQ) * D;
        const float* g = gate + (t < SEQ ? b : 8) * 6144;
#pragma unroll
        for (int bj = 0; bj < 2; ++bj)
#pragma unroll
          for (int n = 0; n < 2; ++n) {
            const int c = col0 + bj * 128 + n * 16;
            const pg8::f32x4 x = *(const pg8::f32x4*)(xr + c), gg = *(const pg8::f32x4*)(g + c);
            *(pg8::f32x4*)(xr + c) = x * ALPHA + gg * acc[ai][bj][m][n];
          }
      }
  }
};
struct EpiRw1 {
  static constexpr bool PERM = true, AFTER_DRAIN = false;
  u16* RKV; u16* L1;
  __device__ __forceinline__ void operator()(const pg8::f32x4 (&acc)[2][2][4][2], const pg8::Unit& u, int wr, int wc, int fr, int fq) const {
    const int row0 = u.pm * 256 + wr * 64 + fr, lc0 = wc * 32 + 8 * fq;
    if (u.pn < 12) {
      u16* base = RKV + (size_t)(u.pn >> 2) * ((size_t)M * 1024) + (u.pn & 3) * 256 + lc0;
#pragma unroll
      for (int ai = 0; ai < 2; ++ai)
#pragma unroll
        for (int m = 0; m < 4; ++m) {
          u16* rowp = base + (size_t)(row0 + ai * 128 + m * 16) * 1024;
#pragma unroll
          for (int bj = 0; bj < 2; ++bj) {
            const pg8::f32x4 v0 = acc[ai][bj][m][0], v1 = acc[ai][bj][m][1];
            v4u w; w.x = cvtpk(v0[0], v0[1]); w.y = cvtpk(v0[2], v0[3]); w.z = cvtpk(v1[0], v1[1]); w.w = cvtpk(v1[2], v1[3]);
            *(v4u*)(rowp + bj * 128) = w;
          }
        }
    } else {
#pragma unroll
      for (int ai = 0; ai < 2; ++ai)
#pragma unroll
        for (int m = 0; m < 4; ++m) {
          u16* rowp = L1 + (size_t)(row0 + ai * 128 + m * 16) * 384 + (u.pn - 12) * 256 + lc0;
#pragma unroll
          for (int bj = 0; bj < 2; ++bj) {
            if (u.pn == 13 && bj == 1) continue;
            const int mode = (u.pn == 12) ? (bj == 0 ? 1 : 0) : 2;
            float v[8];
#pragma unroll
            for (int j = 0; j < 4; ++j) { v[j] = acc[ai][bj][m][0][j]; v[4 + j] = acc[ai][bj][m][1][j]; }
#pragma unroll
            for (int j = 0; j < 8; ++j) {
              if (mode == 1) v[j] = 1.f - 2.f / (1.f + __expf(2.f * v[j]));
              else if (mode == 2) v[j] = 1.f / (1.f + __expf(-v[j]));
            }
            v4u w; w.x = cvtpk(v[0], v[1]); w.y = cvtpk(v[2], v[3]); w.z = cvtpk(v[4], v[5]); w.w = cvtpk(v[6], v[7]);
            *(v4u*)(rowp + bj * 128) = w;
          }
        }
    }
  }
};

template <class Epi>
__device__ __forceinline__ void run_gemm(unsigned char* smem, const u16* A, const u16* Bt, int Mr, int N, int K, const Epi& E) {
  pg8::Gemm g{A, Bt, Mr, N, K}; pg8::StaticOrder S; S.init(Mr, N, get_gdim(), get_bid());
  pg8::gemm_phase<Epi, pg8::StaticOrder, false>((PG8_LAS unsigned char*)smem, g, S, E, nullptr);
  __syncthreads();
}

__device__ __forceinline__ void my_sincos(double x, float& s, float& c) {
  const double kd = rint(x * 0.6366197723675814);
  const int k = (int)kd;
  double r = fma(-kd, 1.5707963267948966, x); r = fma(-kd, 6.123233995736766e-17, r);
  const double r2 = r * r;
  const double sp = r * (1.0 + r2 * (-1.0 / 6.0 + r2 * (1.0 / 120.0 + r2 * (-1.0 / 5040.0 + r2 * (1.0 / 362880.0 + r2 * (-1.0 / 39916800.0 + r2 * (1.0 / 6227020800.0)))))));
  const double cp = 1.0 + r2 * (-0.5 + r2 * (1.0 / 24.0 + r2 * (-1.0 / 720.0 + r2 * (1.0 / 40320.0 + r2 * (-1.0 / 3628800.0 + r2 * (1.0 / 479001600.0 + r2 * (-1.0 / 87178291200.0)))))));
  const int q = k & 3;
  const double ss = (q == 0) ? sp : (q == 1) ? cp : (q == 2) ? -sp : -cp;
  const double cc = (q == 0) ? cp : (q == 1) ? -sp : (q == 2) ? -cp : sp;
  s = (float)ss; c = (float)cc;
}

__device__ void phase_mod(PP p, unsigned char* smem) {
  float* sc = (float*)smem; float* red = sc + 9 * 1024;
  const int tid = get_tid();
  for (int e = tid; e < 9 * 1024; e += 512) { const int j = e >> 10, k = e & 1023; const float v = j < 8 ? p->c[j * 1024 + k] : p->c_ctx[k]; sc[e] = v / (1.f + __expf(-v)); }
  __syncthreads();
  float* MOD = (float*)(p->ws + OFF_MOD);
  for (int item = get_bid(); item < 4 * 48; item += get_gdim()) {
    const int l = item / 48, cb = item % 48, cl = tid & 127, col = cb * 128 + cl, kq = tid >> 7;
    const float* w = p->mod_w + (size_t)l * 1024 * 6144 + col;
    float acc[9];
#pragma unroll
    for (int j = 0; j < 9; ++j) acc[j] = 0.f;
    for (int k = kq * 256; k < kq * 256 + 256; ++k) {
      const float wv = w[(size_t)k * 6144];
#pragma unroll
      for (int j = 0; j < 9; ++j) acc[j] += sc[j * 1024 + k] * wv;
    }
#pragma unroll
    for (int j = 0; j < 9; ++j) red[(kq * 128 + cl) * 9 + j] = acc[j];
    __syncthreads();
    if (kq == 0) {
      const float bb = p->mod_b[l * 6144 + col];
#pragma unroll
      for (int j = 0; j < 9; ++j)
        MOD[(size_t)(l * 9 + j) * 6144 + col] = red[cl * 9 + j] + red[(128 + cl) * 9 + j] + red[(256 + cl) * 9 + j] + red[(384 + cl) * 9 + j] + bb;
    }
    __syncthreads();
  }
  if (get_bid() == get_gdim() - 1) {
    v2f* TAB = (v2f*)(p->ws + OFF_TAB);
    for (int e = tid; e < 2048; e += 512) {
      const int pos = e >> 5, i = e & 31;
      double f = 1.0; for (int q = 0; q < i; ++q) f *= 0.7498942093324559;
      float s, c; my_sincos((double)pos * f, s, c);
      TAB[e] = (v2f){c, s};
    }
  }
}

__device__ void cvt_T(const float* src, int ldsrc, u16* dst, int ldd, int K, int N, const float* scale, float* tile, int& rot) {
  const int tid = get_tid(), G = get_gdim();
  const int ntn = N / 64, nt = (K / 64) * ntn;
  const int first = ((get_bid() - rot) % G + G) % G;
  for (int t = first; t < nt; t += G) {
    const int tk = t / ntn, tn = t - tk * ntn;
#pragma unroll
    for (int i = 0; i < 8; ++i) {
      const int e = tid + 512 * i, k = e >> 6, n = e & 63;
      float v = src[(size_t)(tk * 64 + k) * ldsrc + tn * 64 + n];
      if (scale) v *= scale[tk * 64 + k];
      tile[k * 65 + n] = v;
    }
    __syncthreads();
    {
      const int n = tid >> 3, kc = (tid & 7) * 8;
      float v[8];
#pragma unroll
      for (int i = 0; i < 8; ++i) v[i] = tile[(kc + i) * 65 + n];
      v4u w; w.x = cvtpk(v[0], v[1]); w.y = cvtpk(v[2], v[3]); w.z = cvtpk(v[4], v[5]); w.w = cvtpk(v[6], v[7]);
      *(v4u*)(dst + (size_t)(tn * 64 + n) * ldd + tk * 64 + kc) = w;
    }
    __syncthreads();
  }
  rot = (rot + nt) % G;
}
__device__ void zero_bf16(u16* dst, int ldd, int nrows, int c0, int ncols) {
  const int per = ncols / 8; const long total = (long)nrows * per;
  for (long i = (long)get_bid() * 512 + get_tid(); i < total; i += (long)get_gdim() * 512) {
    const long r = i / per; const int cc = (int)(i - r * per);
    *(v4u*)(dst + (size_t)r * ldd + c0 + cc * 8) = (v4u){0u, 0u, 0u, 0u};
  }
}

__device__ void convert_layer_weights(PP p, int layer, unsigned char* smem) {
  float* tile = (float*)smem; int rot = 0;
  const int kind = layer % 3, slot = layer / 3;
  u16* WB = (u16*)(p->ws + OFF_WB);
  cvt_T(p->mlp_w1 + (size_t)layer * 1024 * 4096, 4096, (u16*)(p->ws + OFF_WB + WB_W1T), 1024, 1024, 4096, nullptr, tile, rot);
  cvt_T(p->mlp_w2 + (size_t)layer * 4096 * 1024, 1024, (u16*)(p->ws + OFF_WB + WB_W2T), 4096, 4096, 1024, nullptr, tile, rot);
  u16* MIX = (u16*)(p->ws + OFF_WB + WB_MIX);
  if (kind == 0) {
    cvt_T(p->att_wqkv + (size_t)slot * 1024 * 1536, 1536, MIX, 1024, 1024, 1536, nullptr, tile, rot);
    cvt_T(p->att_wo + (size_t)slot * 1024 * 1024, 1024, (u16*)(p->ws + OFF_WB + WB_ATT_WO), 1024, 1024, 1024, nullptr, tile, rot);
  } else if (kind == 1) {
    cvt_T(p->na_wqkv + (size_t)slot * 1024 * 3072, 3072, MIX, 1024, 1024, 3072, nullptr, tile, rot);
    cvt_T(p->na_wo + (size_t)slot * 1024 * 1024, 1024, (u16*)(p->ws + OFF_WB + WB_NA_WO), 1024, 1024, 1024, nullptr, tile, rot);
  } else {
    const float* mu = p->rw_mu + (size_t)slot * 6 * 1024;
    {
      const float* s0 = p->rw_wr + (size_t)slot * 1024 * 1024; const float* s1 = p->rw_wk + (size_t)slot * 1024 * 1024; const float* s2 = p->rw_wv + (size_t)slot * 1024 * 1024;
      cvt_T(s0, 1024, MIX, 2048, 1024, 1024, nullptr, tile, rot);
      cvt_T(s0, 1024, MIX + 1024, 2048, 1024, 1024, mu + 0 * 1024, tile, rot);
      cvt_T(s1, 1024, MIX + (size_t)1024 * 2048, 2048, 1024, 1024, nullptr, tile, rot);
      cvt_T(s1, 1024, MIX + (size_t)1024 * 2048 + 1024, 2048, 1024, 1024, mu + 2 * 1024, tile, rot);
      cvt_T(s2, 1024, MIX + (size_t)2048 * 2048, 2048, 1024, 1024, nullptr, tile, rot);
      cvt_T(s2, 1024, MIX + (size_t)2048 * 2048 + 1024, 2048, 1024, 1024, mu + 3 * 1024, tile, rot);
    }
    for (int d = 0; d < 2; ++d) {
      const float* w1 = p->rw_w1 + (size_t)(slot * 2 + d) * 1024 * 64;
      cvt_T(w1, 64, MIX + (size_t)(3072 + 64 * d) * 2048, 2048, 1024, 64, nullptr, tile, rot);
      cvt_T(w1, 64, MIX + (size_t)(3072 + 64 * d) * 2048 + 1024, 2048, 1024, 64, mu + 1 * 1024, tile, rot);
      const float* a1 = p->rw_a1 + (size_t)(slot * 2 + d) * 1024 * 64;
      cvt_T(a1, 64, MIX + (size_t)(3200 + 64 * d) * 2048, 2048, 1024, 64, nullptr, tile, rot);
      cvt_T(a1, 64, MIX + (size_t)(3200 + 64 * d) * 2048 + 1024, 2048, 1024, 64, mu + 4 * 1024, tile, rot);
      cvt_T(p->rw_w2 + (size_t)(slot * 2 + d) * 64 * 1024, 1024, (u16*)(p->ws + OFF_WB + WB_RW_W2T) + (size_t)d * 1024 * 64, 64, 64, 1024, nullptr, tile, rot);
      cvt_T(p->rw_a2 + (size_t)(slot * 2 + d) * 64 * 1024, 1024, (u16*)(p->ws + OFF_WB + WB_RW_A2T) + (size_t)d * 1024 * 64, 64, 64, 1024, nullptr, tile, rot);
    }
    const float* g1 = p->rw_g1 + (size_t)slot * 1024 * 128;
    cvt_T(g1, 128, MIX + (size_t)3328 * 2048, 2048, 1024, 128, nullptr, tile, rot);
    cvt_T(g1, 128, MIX + (size_t)3328 * 2048 + 1024, 2048, 1024, 128, mu + 5 * 1024, tile, rot);
    zero_bf16(MIX + (size_t)3456 * 2048, 2048, 128, 0, 2048);
    cvt_T(p->rw_wo + (size_t)slot * 1024 * 1024, 1024, (u16*)(p->ws + OFF_WB + WB_RW_WO), 1024, 1024, 1024, nullptr, tile, rot);
    u16* BG = (u16*)(p->ws + OFF_WB + WB_RW_BG);
    zero_bf16(BG, 384, 1024, 0, 256);
    cvt_T(p->rw_g2 + (size_t)slot * 128 * 1024, 1024, BG + 256, 384, 128, 1024, nullptr, tile, rot);
  }
  (void)WB;
}

__device__ void rowpass(PP p, int src_ln, int mod_layer, int mod_off, u16* H, int ldh, bool final) {
  const int wid = get_tid() >> 6, lane = get_tid() & 63;
  const float* MOD = (const float*)(p->ws + OFF_MOD);
  for (int row = get_bid() * 8 + wid; row < M; row += get_gdim() * 8) {
    const int b = row / TB, t = row - b * TB;
    if (final && t >= SEQ) continue;
    float* xr = xrow(p, row);
    const float* src = src_ln < 0 ? (t < SEQ ? p->x + (size_t)(b * SEQ + t) * D : p->ctx + (size_t)(b * CTXL + t - SEQ) * D) : xr;
    v4f v[4];
#pragma unroll
    for (int q = 0; q < 4; ++q) v[q] = *(const v4f*)(src + q * 256 + lane * 4);
    if (src_ln >= 0) {
      float s = 0.f;
#pragma unroll
      for (int q = 0; q < 4; ++q) s += (v[q][0] + v[q][1]) + (v[q][2] + v[q][3]);
      const float mean = wave_sum(s) * (1.f / 1024.f);
      float sq = 0.f;
#pragma unroll
      for (int q = 0; q < 4; ++q) { v[q] = v[q] - mean; sq += (v[q][0] * v[q][0] + v[q][1] * v[q][1]) + (v[q][2] * v[q][2] + v[q][3] * v[q][3]); }
      const float rstd = 1.0f / sqrtf(wave_sum(sq) * (1.f / 1024.f) + LN_EPS);
      const float* g = p->ln_g + (size_t)src_ln * 1024; const float* bb = p->ln_b + (size_t)src_ln * 1024;
#pragma unroll
      for (int q = 0; q < 4; ++q) v[q] = v[q] * rstd * *(const v4f*)(g + q * 256 + lane * 4) + *(const v4f*)(bb + q * 256 + lane * 4);
    }
#pragma unroll
    for (int q = 0; q < 4; ++q) *(v4f*)(xr + q * 256 + lane * 4) = v[q];
    if (final) continue;
    const float* md = MOD + (size_t)(mod_layer * 9 + (t < SEQ ? b : 8)) * 6144 + mod_off * 1024;
#pragma unroll
    for (int q = 0; q < 4; ++q) {
      const v4f sh = *(const v4f*)(md + q * 256 + lane * 4), scl = *(const v4f*)(md + 1024 + q * 256 + lane * 4);
      const v4f h = v[q] * (scl + 1.f) + sh;
      v2u w; w.x = cvtpk(h[0], h[1]); w.y = cvtpk(h[2], h[3]);
      *(v2u*)(H + (size_t)row * ldh + q * 256 + lane * 4) = w;
    }
  }
}

__device__ void xx_pass(PP p) {
  u16* HX = (u16*)(p->ws + OFF_AR + AR_H);
  for (long idx = (long)get_bid() * 512 + get_tid(); idx < (long)M * 128; idx += (long)get_gdim() * 512) {
    const int row = (int)(idx >> 7), c8 = (int)(idx & 127) * 8;
    const int t = row % TB;
    const bool first = (t == 0) || (t == SEQ), last = (t == SEQ - 1) || (t == TB - 1);
    const v4u z = {0u, 0u, 0u, 0u};
    const v4u h = *(const v4u*)(HX + (size_t)row * 2048 + c8);
    const v4u hp = first ? z : *(const v4u*)(HX + (size_t)(row - 1) * 2048 + c8);
    const v4u hn = last ? z : *(const v4u*)(HX + (size_t)(row + 1) * 2048 + c8);
    v4u o;
#pragma unroll
    for (int j = 0; j < 4; ++j) {
      const float lo = 0.5f * (bflo(hp[j]) + bflo(hn[j])) - bflo(h[j]);
      const float hi = 0.5f * (bfhi(hp[j]) + bfhi(hn[j])) - bfhi(h[j]);
      o[j] = cvtpk(lo, hi);
    }
    *(v4u*)(HX + (size_t)row * 2048 + 1024 + c8) = o;
  }
}

__device__ void qk_prep(PP p, int slot) {
  u16* QKV = (u16*)(p->ws + OFF_AR + AR_QKV);
  const v2f* TAB = (const v2f*)(p->ws + OFF_TAB);
  const int wid = get_tid() >> 6, lane = get_tid() & 63;
  const float* qn = p->att_qn + slot * 128; const float* kn = p->att_kn + slot * 128;
  for (int it = get_bid() * 8 + wid; it < M * 10; it += get_gdim() * 8) {
    const int row = it / 10, hs = it - row * 10;
    u16* base = QKV + (size_t)row * 1536 + hs * 128;
    float e0 = bf2f(base[lane]), e1 = bf2f(base[lane + 64]);
    const float ss = wave_sum(e0 * e0 + e1 * e1);
    const float rn = 1.0f / sqrtf(ss * (1.f / 128.f) + LN_EPS);
    const float* g = hs < 8 ? qn : kn;
    e0 *= rn * g[lane]; e1 *= rn * g[lane + 64];
    const int t = row % TB;
    const float p0 = __shfl_xor(e0, 32), p1 = __shfl_xor(e1, 32);
    if (t < SEQ) {
      const int i = lane & 31; const bool up = lane >= 32;
      const v2f cr = TAB[(t >> 6) * 32 + i], cc = TAB[(t & 63) * 32 + i];
      e0 = e0 * cr.x + (up ? p0 : -p0) * cr.y;
      e1 = e1 * cc.x + (up ? p1 : -p1) * cc.y;
    }
    base[lane] = (u16)(cvtpk(e0, e0) & 0xffffu); base[lane + 64] = (u16)(cvtpk(e1, e1) & 0xffffu);
  }
}

namespace att {
constexpr int DH = 128, NW = 8, QBLK = 32, KVBLK = 64;
constexpr float SCALE = 0.088388347648318440f;
constexpr float THR = 8.f;
constexpr int LDQ = 1536, LDK = 1536, LDO = 1024;
constexpr size_t SHM_V = KVBLK * DH * 2, SHM_K = KVBLK * DH * 2;
#define KSWZ(row, colB) ((row) * 256 + ((colB) ^ (((row) & 7) << 4)))
#define SBAR() __builtin_amdgcn_sched_barrier(0)
__device__ __forceinline__ void partialSM(v16f& p0, v16f& p1, float& m_reg, float& mn, float& alpha) {
  constexpr float C = SCALE * 1.4426950408889634f;
  float pmax = p0[0];
#pragma unroll
  for (int r = 1; r < 16; ++r) pmax = fmaxf(pmax, p0[r]);
#pragma unroll
  for (int r = 0; r < 16; ++r) pmax = fmaxf(pmax, p1[r]);
  { auto rr = __builtin_amdgcn_permlane32_swap(__float_as_uint(pmax), __float_as_uint(pmax), false, false);
    pmax = fmaxf(__uint_as_float(rr[0]), __uint_as_float(rr[1])); }
  if (__builtin_expect(__all(pmax - m_reg <= THR / SCALE), 1)) { mn = m_reg; alpha = 1.f; }
  else { mn = fmaxf(m_reg, pmax); alpha = __builtin_amdgcn_exp2f((m_reg - mn) * C); m_reg = mn; }
  float mnC = -mn * C;
#pragma unroll
  for (int r = 0; r < 16; ++r) p0[r] = fmaf(p0[r], C, mnC);
#pragma unroll
  for (int r = 0; r < 16; ++r) p1[r] = fmaf(p1[r], C, mnC);
#pragma unroll
  for (int r = 0; r < 16; ++r) p0[r] = __builtin_amdgcn_exp2f(p0[r]);
}
__device__ __forceinline__ void finishSM(v16f& p0, v16f& p1, float alpha, float& l_reg, v8s& pa0, v8s& pa1, v8s& pa2, v8s& pa3) {
#pragma unroll
  for (int r = 0; r < 16; ++r) p1[r] = __builtin_amdgcn_exp2f(p1[r]);
  float ps = 0;
#pragma unroll
  for (int r = 0; r < 16; ++r) ps += p0[r];
#pragma unroll
  for (int r = 0; r < 16; ++r) ps += p1[r];
  { auto rr = __builtin_amdgcn_permlane32_swap(__float_as_uint(ps), __float_as_uint(ps), false, false);
    ps = __uint_as_float(rr[0]) + __uint_as_float(rr[1]); }
  l_reg = l_reg * alpha + ps;
#define PK4(Pv, BASE, OUT) do { unsigned a0 = cvtpk(Pv[BASE + 0], Pv[BASE + 1]), a1 = cvtpk(Pv[BASE + 2], Pv[BASE + 3]);   \
    unsigned b0 = cvtpk(Pv[BASE + 4], Pv[BASE + 5]), b1 = cvtpk(Pv[BASE + 6], Pv[BASE + 7]);                              \
    auto r0 = __builtin_amdgcn_permlane32_swap(a0, b0, false, false); auto r1 = __builtin_amdgcn_permlane32_swap(a1, b1, false, false); \
    v4u w = {r0[0], r1[0], r0[1], r1[1]}; OUT = *reinterpret_cast<v8s*>(&w); } while (0)
  PK4(p0, 0, pa0); PK4(p0, 8, pa1); PK4(p1, 0, pa2); PK4(p1, 8, pa3);
#undef PK4
}
__device__ __forceinline__ void qkt(v16f& p0, v16f& p1, const u16* Ks, const v8s* qr, int r32, int hi) {
  p0 = v16f{}; p1 = v16f{};
#pragma unroll
  for (int d0 = 0; d0 < 8; ++d0) { int cb = (d0 * 16 + hi * 8) * 2;
    v8s b0 = *reinterpret_cast<const v8s*>((const char*)Ks + KSWZ(r32, cb));
    v8s b1 = *reinterpret_cast<const v8s*>((const char*)Ks + KSWZ(32 + r32, cb));
    p0 = __builtin_amdgcn_mfma_f32_32x32x16_bf16(b0, qr[d0], p0, 0, 0, 0);
    p1 = __builtin_amdgcn_mfma_f32_32x32x16_bf16(b1, qr[d0], p1, 0, 0, 0); }
}
__device__ __forceinline__ int v_st(int k, int c) { const int kk = (k & ~0xC) | ((k & 4) << 1) | ((k & 8) >> 1); return ((kk >> 3) * 4 + (c >> 5)) * 512 + ((kk & 7) * 32 + (c & 31)) * 2; }
__device__ __forceinline__ int v_rd_base(int lane) { return ((lane & 3) << 3) | (((lane >> 2) & 3) << 6) | (((lane >> 4) & 1) << 5) | (((lane >> 5) & 1) << 8); }
constexpr int v_rd_off(int d0, int ks, int half) { return d0 * 512 + ks * 4096 + half * 2048; }
template <int OFF> __device__ __forceinline__ v4s tr_read(int vb) {
  v4s r; asm volatile("ds_read_b64_tr_b16 %0, %1 offset:%2" : "=&v"(r) : "v"(vb), "i"(OFF) : "memory"); return r;
}
template <int D0> __device__ __forceinline__ void pv_one(v16f& od, int vb, v8s pa0, v8s pa1, v8s pa2, v8s pa3) {
  const v4s l0 = tr_read<v_rd_off(D0, 0, 0)>(vb), h0 = tr_read<v_rd_off(D0, 0, 1)>(vb), l1 = tr_read<v_rd_off(D0, 1, 0)>(vb), h1 = tr_read<v_rd_off(D0, 1, 1)>(vb);
  const v4s l2 = tr_read<v_rd_off(D0, 2, 0)>(vb), h2 = tr_read<v_rd_off(D0, 2, 1)>(vb), l3 = tr_read<v_rd_off(D0, 3, 0)>(vb), h3 = tr_read<v_rd_off(D0, 3, 1)>(vb);
  asm volatile("s_waitcnt lgkmcnt(0)" ::: "memory"); SBAR();
#define PKV(L, H) (v8s){L[0], L[1], L[2], L[3], H[0], H[1], H[2], H[3]}
  od = __builtin_amdgcn_mfma_f32_32x32x16_bf16(pa0, PKV(l0, h0), od, 0, 0, 0);
  od = __builtin_amdgcn_mfma_f32_32x32x16_bf16(pa1, PKV(l1, h1), od, 0, 0, 0);
  od = __builtin_amdgcn_mfma_f32_32x32x16_bf16(pa2, PKV(l2, h2), od, 0, 0, 0);
  od = __builtin_amdgcn_mfma_f32_32x32x16_bf16(pa3, PKV(l3, h3), od, 0, 0, 0);
#undef PKV
}
__device__ __forceinline__ void pv_d0(v16f* o, int vb, v8s pa0, v8s pa1, v8s pa2, v8s pa3) {
  pv_one<0>(o[0], vb, pa0, pa1, pa2, pa3); pv_one<1>(o[1], vb, pa0, pa1, pa2, pa3); pv_one<2>(o[2], vb, pa0, pa1, pa2, pa3); pv_one<3>(o[3], vb, pa0, pa1, pa2, pa3);
}
__device__ __forceinline__ void attn_dense_body(const u16* __restrict__ Qb, const u16* __restrict__ Kh, const u16* __restrict__ Vh,
                                                u16* __restrict__ Ob, int seq, char* lds) {
  const int tid = get_tid(), wid = tid >> 6, lane = tid & 63, r32 = lane & 31, hi = lane >> 5;
  u16* V_lds = (u16*)lds; u16* K_lds = (u16*)(lds + 2 * SHM_V);
  float* ws = (float*)(lds + 2 * SHM_V + 2 * SHM_K) + wid * 64; float* li_l = ws; float* al_l = ws + 32;
  float m_reg = -1e30f, l_reg = 0; v16f o[4] = {}; v8s qr[8];
  const u16* Qw = Qb + (long)(wid * QBLK + r32) * LDQ + hi * 8;
#pragma unroll
  for (int d0 = 0; d0 < 8; ++d0) qr[d0] = *reinterpret_cast<const v8s*>(Qw + d0 * 16);
  const int sr = tid >> 4, sc = (tid & 15) * 8, vst0 = v_st(sr, sc), vst1 = v_st(32 + sr, sc);
  const int vb0 = (int)(uintptr_t)V_lds + v_rd_base(lane);
  struct { v8s vs0, vs1, ks0, ks1; } sr_[2];
#define SLOAD(i, k0) do { sr_[i].vs0 = *(const v8s*)(&Vh[(long)((k0) + sr) * LDK + sc]); sr_[i].vs1 = *(const v8s*)(&Vh[(long)((k0) + 32 + sr) * LDK + sc]); \
    sr_[i].ks0 = *(const v8s*)(&Kh[(long)((k0) + sr) * LDK + sc]); sr_[i].ks1 = *(const v8s*)(&Kh[(long)((k0) + 32 + sr) * LDK + sc]); } while (0)
#define SWRITE(b, i) do { *(v8s*)((char*)V_lds + (b) * SHM_V + vst0) = sr_[i].vs0;          \
    *(v8s*)((char*)V_lds + (b) * SHM_V + vst1) = sr_[i].vs1; int kc = sc * 2;               \
    *(v8s*)((char*)K_lds + (b) * SHM_K + KSWZ(sr, kc)) = sr_[i].ks0;                       \
    *(v8s*)((char*)K_lds + (b) * SHM_K + KSWZ(32 + sr, kc)) = sr_[i].ks1; } while (0)
#define SWAIT() asm volatile("s_waitcnt vmcnt(4)" ::: "memory")
#define RESC(a) do { if (__any((a) < 1.f)) { if (hi == 0) al_l[r32] = (a); asm volatile("s_waitcnt lgkmcnt(0)" ::: "memory"); \
    for (int d = 0; d < 4; ++d) for (int r = 0; r < 16; ++r) o[d][r] *= al_l[crow(r, hi)]; } } while (0)
  v16f pA0, pA1, pB0, pB1; float mnA, mnB, alA, alB; v8s pa0, pa1, pa2, pa3; const int NT = seq / KVBLK;
  constexpr int SE = 0, SO = 1;
  SLOAD(SE, 0); asm volatile("s_waitcnt vmcnt(0)" ::: "memory"); SWRITE(0, SE); __syncthreads();
  qkt(pA0, pA1, K_lds, qr, r32, hi); partialSM(pA0, pA1, m_reg, mnA, alA);
  SLOAD(SO, KVBLK); if (2 < NT) SLOAD(SE, 2 * KVBLK);
  SWAIT(); SWRITE(1, SO); __syncthreads();
  for (int j = 1; j + 1 < NT; j += 2) {
    SBAR(); qkt(pB0, pB1, (u16*)((char*)K_lds + SHM_K), qr, r32, hi);
    finishSM(pA0, pA1, alA, l_reg, pa0, pa1, pa2, pa3); SBAR();
    SLOAD(SO, (j + 2) * KVBLK); SBAR();
    pv_d0(o, vb0, pa0, pa1, pa2, pa3); partialSM(pB0, pB1, m_reg, mnB, alB);
    __syncthreads(); SWAIT(); SWRITE(0, SE);
    RESC(alB); __syncthreads();
    SBAR(); qkt(pA0, pA1, K_lds, qr, r32, hi);
    finishSM(pB0, pB1, alB, l_reg, pa0, pa1, pa2, pa3); SBAR();
    if (j + 3 < NT) SLOAD(SE, (j + 3) * KVBLK); SBAR();
    pv_d0(o, vb0 + (int)SHM_V, pa0, pa1, pa2, pa3); partialSM(pA0, pA1, m_reg, mnA, alA);
    __syncthreads(); SWAIT(); SWRITE(1, SO);
    RESC(alA); __syncthreads();
  }
  SBAR(); qkt(pB0, pB1, (u16*)((char*)K_lds + SHM_K), qr, r32, hi);
  finishSM(pA0, pA1, alA, l_reg, pa0, pa1, pa2, pa3); SBAR();
  pv_d0(o, vb0, pa0, pa1, pa2, pa3); partialSM(pB0, pB1, m_reg, mnB, alB);
  __syncthreads(); RESC(alB);
  finishSM(pB0, pB1, alB, l_reg, pa0, pa1, pa2, pa3); SBAR();
  pv_d0(o, vb0 + (int)SHM_V, pa0, pa1, pa2, pa3);
  if (hi == 0) li_l[r32] = l_reg; asm volatile("s_waitcnt lgkmcnt(0)" ::: "memory");
  float rli[16];
#pragma unroll
  for (int r = 0; r < 16; ++r) rli[r] = __builtin_amdgcn_rcpf(li_l[crow(r, hi)]);
  u16* Ow = Ob + (long)(wid * QBLK) * LDO;
#pragma unroll
  for (int r = 0; r < 16; ++r) { int orow = crow(r, hi);
#pragma unroll
    for (int d0 = 0; d0 < 4; ++d0) { const float val = o[d0][r] * rli[r]; Ow[(long)orow * LDO + d0 * 32 + r32] = (u16)(cvtpk(val, val) & 0xffffu); } }
#undef SLOAD
#undef SWRITE
#undef SWAIT
#undef RESC
}
}

__device__ void gqa_attention(PP p, unsigned char* smem, bool want_ctx) {
  const u16* QKV = (const u16*)(p->ws + OFF_AR + AR_QKV);
  u16* O = (u16*)(p->ws + OFF_AR + AR_ATT_O);
  const int nitems = 1024 + (want_ctx ? 64 : 0);
  for (int item = get_bid(); item < nitems; item += get_gdim()) {
    int b, h, qrow, krow, seq;
    if (item < 1024) { b = item >> 7; const int rem = item & 127; h = rem >> 4; qrow = b * TB + (rem & 15) * 256; krow = b * TB; seq = TB; }
    else { const int ci = item - 1024; b = ci >> 3; h = ci & 7; qrow = b * TB + SEQ; krow = b * TB + SEQ; seq = CTXL; }
    const int kvh = h >> 2;
    att::attn_dense_body(QKV + (size_t)qrow * 1536 + h * 128, QKV + (size_t)krow * 1536 + 1024 + kvh * 128, QKV + (size_t)krow * 1536 + 1280 + kvh * 128,
                         O + (size_t)qrow * 1024 + h * 128, seq, (char*)smem);
    __syncthreads();
  }
}

__device__ void na_attention(PP p, unsigned char* smem, bool want_ctx) {
  const u16* QK = (const u16*)(p->ws + OFF_AR + AR_NA_QK);
  const u16* VT = (const u16*)(p->ws + OFF_AR + AR_NA_VT);
  u16* O = (u16*)(p->ws + OFF_AR + AR_NA_O);
  const int tid = get_tid(), wid = tid >> 6, lane = tid & 63, r32 = lane & 31, hi = lane >> 5;
  float* rpbl = (float*)smem + wid * 480;
  constexpr float C1 = 0.125f * LOG2E;
  const int nrows = 64 + (want_ctx ? 4 : 0);
  for (int item = get_bid(); item < NB * nrows * 2; item += get_gdim()) {
    const int hh = item & 1, rr = (item >> 1) % nrows, b = (item >> 1) / nrows;
    const int h = hh * 8 + wid;
    const bool isctx = rr >= 64;
    const int r = isctx ? 0 : rr;
    for (int e = lane; e < 465; e += 64) rpbl[e] = p->na_rpb[h * 465 + e];
    const int r0 = min(max(r - 4, 0), 56);
    const size_t qrow0 = (size_t)b * TB + (isctx ? SEQ + (rr - 64) * 64 : r * 64);
    v8s qf[2][4];
#pragma unroll
    for (int qb = 0; qb < 2; ++qb)
#pragma unroll
      for (int ks = 0; ks < 4; ++ks) qf[qb][ks] = *(const v8s*)(QK + (qrow0 + qb * 32 + r32) * 2048 + h * 64 + ks * 16 + hi * 8);
    v16f o[2][2];
#pragma unroll
    for (int a = 0; a < 2; ++a)
#pragma unroll
      for (int c = 0; c < 2; ++c) o[a][c] = v16f{};
    float m_run[2] = {-1e30f, -1e30f}, l_run[2] = {0.f, 0.f};
    for (int t = isctx ? 16 : 0; t < 24; ++t) {
      const bool local = t < 16; const int j = t >> 1, hf = t & 1;
      const size_t keyrow0 = (size_t)b * TB + (local ? (r0 + j) * 64 + hf * 32 : SEQ + (t - 16) * 32);
      v8s kf[4];
#pragma unroll
      for (int ks = 0; ks < 4; ++ks) kf[ks] = *(const v8s*)(QK + (keyrow0 + r32) * 2048 + 1024 + h * 64 + ks * 16 + hi * 8);
      v8s vf[2][2];
#pragma unroll
      for (int db = 0; db < 2; ++db)
#pragma unroll
        for (int s = 0; s < 2; ++s) {
          const u16* vp = VT + (size_t)(h * 64 + db * 32 + r32) * M + keyrow0 + 16 * s + 4 * hi;
          const v4s lo = *(const v4s*)vp, hi4 = *(const v4s*)(vp + 8);
          vf[db][s] = (v8s){lo[0], lo[1], lo[2], lo[3], hi4[0], hi4[1], hi4[2], hi4[3]};
        }
      v16f sc[2];
#pragma unroll
      for (int qb = 0; qb < 2; ++qb) {
        sc[qb] = v16f{};
#pragma unroll
        for (int ks = 0; ks < 4; ++ks) sc[qb] = __builtin_amdgcn_mfma_f32_32x32x16_bf16(kf[ks], qf[qb][ks], sc[qb], 0, 0, 0);
      }
      v8s pf[2][2];
#pragma unroll
      for (int qb = 0; qb < 2; ++qb) {
        const int c = qb * 32 + r32; const int cs = min(max(c - 8, 0), 48);
        float mx = -3e38f;
#pragma unroll
        for (int i = 0; i < 16; ++i) {
          float s = sc[qb][i] * C1;
          if (local) {
            const int w = hf * 32 + crow(i, hi);
            const bool valid = (unsigned)(w - cs) < 16u;
            const int dc = min(max(w - c + 15, 0), 30), dr = r0 + j - r + 7;
            const float bias = rpbl[dr * 31 + dc];
            s = valid ? s + bias * LOG2E : -3e38f;
          }
          sc[qb][i] = s; mx = fmaxf(mx, s);
        }
        mx = fmaxf(mx, __shfl_xor(mx, 32));
        const float mnew = fmaxf(m_run[qb], mx);
        const float alpha = __builtin_amdgcn_exp2f(m_run[qb] - mnew);
        m_run[qb] = mnew;
        float ps = 0.f;
#pragma unroll
        for (int i = 0; i < 16; ++i) { const float e = __builtin_amdgcn_exp2f(sc[qb][i] - mnew); sc[qb][i] = e; ps += e; }
        ps += __shfl_xor(ps, 32);
        l_run[qb] = l_run[qb] * alpha + ps;
#pragma unroll
        for (int db = 0; db < 2; ++db)
#pragma unroll
          for (int i = 0; i < 16; ++i) o[db][qb][i] *= alpha;
#pragma unroll
        for (int s = 0; s < 2; ++s) {
          v4u w; w.x = cvtpk(sc[qb][8 * s + 0], sc[qb][8 * s + 1]); w.y = cvtpk(sc[qb][8 * s + 2], sc[qb][8 * s + 3]);
          w.z = cvtpk(sc[qb][8 * s + 4], sc[qb][8 * s + 5]); w.w = cvtpk(sc[qb][8 * s + 6], sc[qb][8 * s + 7]);
          pf[qb][s] = *reinterpret_cast<v8s*>(&w);
        }
      }
#pragma unroll
      for (int db = 0; db < 2; ++db)
#pragma unroll
        for (int qb = 0; qb < 2; ++qb)
#pragma unroll
          for (int s = 0; s < 2; ++s) o[db][qb] = __builtin_amdgcn_mfma_f32_32x32x16_bf16(vf[db][s], pf[qb][s], o[db][qb], 0, 0, 0);
    }
#pragma unroll
    for (int qb = 0; qb < 2; ++qb) {
      const float rl = 1.0f / l_run[qb];
      u16* orow = O + (qrow0 + qb * 32 + r32) * 1024 + h * 64;
#pragma unroll
      for (int db = 0; db < 2; ++db)
#pragma unroll
        for (int g4 = 0; g4 < 4; ++g4) {
          v2u w; w.x = cvtpk(o[db][qb][4 * g4 + 0] * rl, o[db][qb][4 * g4 + 1] * rl); w.y = cvtpk(o[db][qb][4 * g4 + 2] * rl, o[db][qb][4 * g4 + 3] * rl);
          *(v2u*)(orow + db * 32 + 8 * g4 + 4 * hi) = w;
        }
    }
  }
}

__device__ __forceinline__ int scan_row(int b, int dir, int s) {
  const int t = s < CTXL ? (dir ? TB - 1 - s : SEQ + s) : (dir ? SEQ - 1 - (s - CTXL) : s - CTXL);
  return b * TB + t;
}
__device__ __forceinline__ float dot4(v4f a, v4f b) { return (a[0] * b[0] + a[1] * b[1]) + (a[2] * b[2] + a[3] * b[3]); }

__device__ void rwkv_scan(PP p, unsigned char* smem, int slot) {
  constexpr int T = 32, NCH = TB / T;
  float* VEC = (float*)smem; float* VV = (float*)(smem + 40960); float* SC = (float*)(smem + 49152); float* YB = (float*)(smem + 49408); float* TMP = (float*)(smem + 57600);
  const int tid = get_tid(), wid = tid >> 6, lane = tid & 63;
  const u16* Rg = (const u16*)(p->ws + OFF_AR + AR_R); const u16* Kg = (const u16*)(p->ws + OFF_AR + AR_K); const u16* Vg = (const u16*)(p->ws + OFF_AR + AR_V);
  const u16* L1 = (const u16*)(p->ws + OFF_AR + AR_L1);
  float* BON = (float*)(p->ws + OFF_BON);
  for (int item = get_bid(); item < 256; item += get_gdim()) {
    const int dir = item >> 7, b = (item >> 4) & 7, h = item & 15;
    u16* Yd = (u16*)(p->ws + OFF_AR + (dir ? AR_Y1 : AR_Y0));
    const int st = tid >> 4, c0 = (tid & 15) * 4, ch = h * 64 + c0;
    const v4f w0 = *(const v4f*)(p->rw_w0 + (size_t)(slot * 2 + dir) * 1024 + ch), a0 = *(const v4f*)(p->rw_a0 + (size_t)(slot * 2 + dir) * 1024 + ch);
    const v4f kkc = *(const v4f*)(p->rw_kk + (size_t)slot * 1024 + ch), kac = *(const v4f*)(p->rw_ka + (size_t)slot * 1024 + ch), rkc = *(const v4f*)(p->rw_rk + (size_t)slot * 1024 + ch);
    const int qn = wid >> 2, rb = (wid >> 1) & 1, cbp = wid & 1, l16 = lane & 15, lq = lane >> 4;
    const u16* WT = (const u16*)(p->ws + OFF_WB + (qn ? WB_RW_A2T : WB_RW_W2T)) + ((size_t)dir * 1024 + h * 64) * 64;
    v8s bfr[2][2];
#pragma unroll
    for (int cb = 0; cb < 2; ++cb)
#pragma unroll
      for (int ks = 0; ks < 2; ++ks) bfr[cb][ks] = *(const v8s*)(WT + (size_t)((cbp * 2 + cb) * 16 + l16) * 64 + ks * 32 + lq * 8);
    v4f S0 = {0.f, 0.f, 0.f, 0.f}, S1 = {0.f, 0.f, 0.f, 0.f};
    const int i0 = 8 * wid + 2 * (lane >> 4);
    v2u pr_r, pr_k, pr_v; v8s pa[2];
#define RW_PREFETCH(cc) do { const int _row = scan_row(b, dir, (cc) * T + st); \
      pr_r = *(const v2u*)(Rg + (size_t)_row * 1024 + ch); pr_k = *(const v2u*)(Kg + (size_t)_row * 1024 + ch); pr_v = *(const v2u*)(Vg + (size_t)_row * 1024 + ch); \
      const int _rowA = scan_row(b, dir, (cc) * T + rb * 16 + l16); \
      pa[0] = *(const v8s*)(L1 + (size_t)_rowA * 384 + qn * 128 + dir * 64 + lq * 8); pa[1] = *(const v8s*)(L1 + (size_t)_rowA * 384 + qn * 128 + dir * 64 + 32 + lq * 8); } while (0)
    RW_PREFETCH(0);
    for (int c = 0; c < NCH; ++c) {
      const int cur_row = scan_row(b, dir, c * T + st);
#pragma unroll
      for (int cb = 0; cb < 2; ++cb) {
        v4f acc = {0.f, 0.f, 0.f, 0.f};
        acc = __builtin_amdgcn_mfma_f32_16x16x32_bf16(pa[0], bfr[cb][0], acc, 0, 0, 0);
        acc = __builtin_amdgcn_mfma_f32_16x16x32_bf16(pa[1], bfr[cb][1], acc, 0, 0, 0);
#pragma unroll
        for (int jj = 0; jj < 4; ++jj) TMP[(qn * T + rb * 16 + lq * 4 + jj) * 64 + (cbp * 2 + cb) * 16 + l16] = acc[jj];
      }
      __syncthreads();
      {
        const v4f wp = *(const v4f*)(TMP + st * 64 + c0) + w0, ap = *(const v4f*)(TMP + (T + st) * 64 + c0) + a0;
        v4f r, k, v, dec, a, kkr;
        r[0] = bflo(pr_r.x); r[1] = bfhi(pr_r.x); r[2] = bflo(pr_r.y); r[3] = bfhi(pr_r.y);
        k[0] = bflo(pr_k.x); k[1] = bfhi(pr_k.x); k[2] = bflo(pr_k.y); k[3] = bfhi(pr_k.y);
        v[0] = bflo(pr_v.x); v[1] = bfhi(pr_v.x); v[2] = bflo(pr_v.y); v[3] = bfhi(pr_v.y);
#pragma unroll
        for (int e = 0; e < 4; ++e) {
          const float z = -wp[e];
          const float sp = z > 20.f ? z : log1pf(__expf(z));
          dec[e] = __expf(-__expf(-sp - 0.5f));
          a[e] = 1.f / (1.f + __expf(-ap[e]));
          kkr[e] = k[e] * kkc[e];
        }
        const float ss = row_sum16(dot4(kkr, kkr));
        const float rn = 1.0f / sqrtf(fmaxf(ss, 1e-12f));
        const v4f kk = kkr * rn;
        const v4f kd = k * ((a - 1.f) * kac + 1.f);
        const v4f bv = kk * a;
        const float br = row_sum16(dot4(bv, r)), kr = row_sum16(dot4(kd, r)), bon = row_sum16(dot4(r * kd, rkc));
        float* vb = VEC + st * 320 + c0;
        *(v4f*)(vb) = -kk; *(v4f*)(vb + 64) = dec * r; *(v4f*)(vb + 128) = dec; *(v4f*)(vb + 192) = bv; *(v4f*)(vb + 256) = kd;
        *(v4f*)(VV + st * 64 + c0) = v;
        if ((tid & 15) == 0) { SC[st * 2] = br; SC[st * 2 + 1] = kr; BON[((size_t)dir * M + cur_row) * 16 + h] = bon; }
      }
      __syncthreads();
      if (c + 1 < NCH) RW_PREFETCH(c + 1);
      for (int s = 0; s < T; ++s) {
        const float* vb = VEC + s * 320 + (lane & 15) * 4;
        const v4f a4 = *(const v4f*)(vb), wr4 = *(const v4f*)(vb + 64), w4 = *(const v4f*)(vb + 128), b4 = *(const v4f*)(vb + 192), k4 = *(const v4f*)(vb + 256);
        const v2f v2 = *(const v2f*)(VV + s * 64 + i0), sc2 = *(const v2f*)(SC + s * 2);
        float p0 = dot4(S0, a4), p1 = dot4(S1, a4), y0 = dot4(S0, wr4), y1 = dot4(S1, wr4);
        p0 = row_sum16(p0); p1 = row_sum16(p1); y0 = row_sum16(y0); y1 = row_sum16(y1);
        y0 += p0 * sc2.x + v2.x * sc2.y; y1 += p1 * sc2.x + v2.y * sc2.y;
        S0 = S0 * w4 + b4 * p0 + k4 * v2.x; S1 = S1 * w4 + b4 * p1 + k4 * v2.y;
        if ((lane & 15) == 0) *(v2f*)(YB + s * 64 + i0) = (v2f){y0, y1};
      }
      __syncthreads();
      {
        const v4f y4 = *(const v4f*)(YB + st * 64 + c0);
        v2u w; w.x = cvtpk(y4[0], y4[1]); w.y = cvtpk(y4[2], y4[3]);
        *(v2u*)(Yd + (size_t)cur_row * 1024 + ch) = w;
      }
    }
#undef RW_PREFETCH
    __syncthreads();
  }
}

__device__ void rwkv_outprep(PP p, int slot) {
  const u16* Y0 = (const u16*)(p->ws + OFF_AR + AR_Y0); const u16* Y1 = (const u16*)(p->ws + OFF_AR + AR_Y1);
  const u16* Vg = (const u16*)(p->ws + OFF_AR + AR_V); const u16* Gg = (const u16*)(p->ws + OFF_AR + AR_G);
  u16* YG = (u16*)(p->ws + OFF_AR + AR_YG);
  const float* BON = (const float*)(p->ws + OFF_BON);
  for (long idx = (long)get_bid() * 512 + get_tid(); idx < (long)M * 256; idx += (long)get_gdim() * 512) {
    const int row = (int)(idx >> 8), c0 = (int)(idx & 255) * 4, h = c0 >> 6;
    const v2u a = *(const v2u*)(Y0 + (size_t)row * 1024 + c0), bq = *(const v2u*)(Y1 + (size_t)row * 1024 + c0);
    v4f y; y[0] = bflo(a.x) + bflo(bq.x); y[1] = bfhi(a.x) + bfhi(bq.x); y[2] = bflo(a.y) + bflo(bq.y); y[3] = bfhi(a.y) + bfhi(bq.y);
    const float mean = row_sum16((y[0] + y[1]) + (y[2] + y[3])) * (1.f / 64.f);
    const v4f d = y - mean;
    const float var = row_sum16(dot4(d, d)) * (1.f / 64.f);
    const float rstd = 1.0f / sqrtf(var + 64e-5f);
    const v4f yn = d * rstd * *(const v4f*)(p->rw_lng + (size_t)slot * 1024 + c0) + *(const v4f*)(p->rw_lnb + (size_t)slot * 1024 + c0);
    const float bon = BON[(size_t)row * 16 + h] + BON[((size_t)M + row) * 16 + h];
    const v2u vv = *(const v2u*)(Vg + (size_t)row * 1024 + c0), gg = *(const v2u*)(Gg + (size_t)row * 1024 + c0);
    v4f v, g; v[0] = bflo(vv.x); v[1] = bfhi(vv.x); v[2] = bflo(vv.y); v[3] = bfhi(vv.y); g[0] = bflo(gg.x); g[1] = bfhi(gg.x); g[2] = bflo(gg.y); g[3] = bfhi(gg.y);
    const v4f o = (yn + v * bon) * g;
    v2u w; w.x = cvtpk(o[0], o[1]); w.y = cvtpk(o[2], o[3]);
    *(v2u*)(YG + (size_t)row * 1024 + c0) = w;
  }
}

enum { OP_MOD = 0, OP_ROWA, OP_XX, OP_QKV, OP_QKPREP, OP_ATTN, OP_NA, OP_RW1, OP_SCAN, OP_OUTPREP, OP_WO, OP_ROWE, OP_MLP1, OP_MLP2, OP_FINAL };
__device__ __forceinline__ void decode_phase(int ph, int& layer, int& op) {
  if (ph == 0) { layer = 0; op = OP_MOD; return; }
  if (ph >= 33) { layer = 3; op = OP_FINAL; return; }
  int s;
  if (ph < 9) { layer = 0; s = ph - 1; } else if (ph < 16) { layer = 1; s = ph - 9; } else if (ph < 25) { layer = 2; s = ph - 16; } else { layer = 3; s = ph - 25; }
  const int kind = layer % 3;
  if (kind == 0) { op = s == 0 ? OP_ROWA : s == 1 ? OP_QKV : s == 2 ? OP_QKPREP : s == 3 ? OP_ATTN : s == 4 ? OP_WO : s == 5 ? OP_ROWE : s == 6 ? OP_MLP1 : OP_MLP2; }
  else if (kind == 1) op = s == 0 ? OP_ROWA : s == 1 ? OP_QKV : s == 2 ? OP_NA : s == 3 ? OP_WO : s == 4 ? OP_ROWE : s == 5 ? OP_MLP1 : OP_MLP2;
  else op = s == 0 ? OP_ROWA : s == 1 ? OP_XX : s == 2 ? OP_RW1 : s == 3 ? OP_SCAN : s == 4 ? OP_OUTPREP : s == 5 ? OP_WO : s == 6 ? OP_ROWE : s == 7 ? OP_MLP1 : OP_MLP2;
}

__global__ void __launch_bounds__(512, 2) mega(P p_, int lo, int hi) {
  extern __shared__ __attribute__((aligned(16))) unsigned char smem[];
  cg::grid_group grid = cg::this_grid();
  if (lo == 0) {
    PP p0 = (PP)__builtin_amdgcn_kernarg_segment_ptr();
    asm volatile("" : "+s"(p0));
    phase_mod(p0, smem);
    if (hi > 1) grid.sync();
    lo = 1;
  }
  for (int ph = lo; ph < hi; ++ph) {
    PP p = (PP)__builtin_amdgcn_kernarg_segment_ptr();
    asm volatile("" : "+s"(p));
    unsigned char* AR = p->ws + OFF_AR;
    const float* MOD = (const float*)(p->ws + OFF_MOD);
    int layer, op; decode_phase(ph, layer, op);
    const int kind = layer % 3, slot = layer / 3;
    const bool want_ctx = layer < 3;
    if (op == OP_ROWA) {
      convert_layer_weights(p, layer, smem);
      rowpass(p, layer == 0 ? -1 : (layer - 1) * 2 + 1, layer, 0, (u16*)(AR + AR_H), kind == 2 ? 2048 : 1024, false);
    }
    else if (op == OP_ROWE) rowpass(p, layer * 2, layer, 3, (u16*)(AR + AR_H), 1024, false);
    else if (op == OP_FINAL) rowpass(p, 7, 0, 0, nullptr, 0, true);
    else if (op == OP_XX) xx_pass(p);
    else if (op == OP_QKPREP) qk_prep(p, slot);
    else if (op == OP_ATTN) {
#ifndef NO_ATTN
      gqa_attention(p, smem, want_ctx);
#endif
    }
    else if (op == OP_NA) {
#ifndef NO_NA
      na_attention(p, smem, want_ctx);
#endif
    }
    else if (op == OP_OUTPREP) rwkv_outprep(p, slot);
    else if (op == OP_RW1) {
      EpiRw1 E{(u16*)(AR + AR_R), (u16*)(AR + AR_L1)};
#ifndef NO_RW1
      run_gemm(smem, (const u16*)(AR + AR_H), (const u16*)(p->ws + OFF_WB + WB_MIX), M, 3584, 2048, E);
#endif
    }
    else if (op == OP_QKV || op == OP_MLP1 || op == OP_SCAN) {
      int ng = 1;
      const u16 *A0, *B0, *A1 = nullptr, *B1 = nullptr; u16 *O0, *O1 = nullptr; int M0, N0, K0, L0, M1 = 0, N1 = 0, K1 = 0, L1_ = 0, act = 0;
      if (op == OP_MLP1) { A0 = (const u16*)(AR + AR_H); B0 = (const u16*)(p->ws + OFF_WB + WB_W1T); O0 = (u16*)(AR + AR_HID); M0 = M; N0 = 4096; K0 = 1024; L0 = 4096; act = 1; }
      else if (op == OP_SCAN) { A0 = (const u16*)(AR + AR_L1); B0 = (const u16*)(p->ws + OFF_WB + WB_RW_BG); O0 = (u16*)(AR + AR_G); M0 = M; N0 = 1024; K0 = 384; L0 = 1024; }
      else if (kind == 0) { A0 = (const u16*)(AR + AR_H); B0 = (const u16*)(p->ws + OFF_WB + WB_MIX); O0 = (u16*)(AR + AR_QKV); M0 = M; N0 = 1536; K0 = 1024; L0 = 1536; }
      else { A0 = (const u16*)(AR + AR_H); B0 = (const u16*)(p->ws + OFF_WB + WB_MIX); O0 = (u16*)(AR + AR_NA_QK); M0 = M; N0 = 2048; K0 = 1024; L0 = 2048;
             ng = 2; A1 = (const u16*)(p->ws + OFF_WB + WB_MIX) + (size_t)2048 * 1024; B1 = (const u16*)(AR + AR_H); O1 = (u16*)(AR + AR_NA_VT); M1 = 1024; N1 = M; K1 = 1024; L1_ = M; }
      for (int g = 0; g < ng; ++g) {
        EpiStore E{g ? O1 : O0, g ? L1_ : L0, act};
#ifndef NO_GS
        run_gemm(smem, g ? A1 : A0, g ? B1 : B0, g ? M1 : M0, g ? N1 : N0, g ? K1 : K0, E);
#endif
      }
#ifndef NO_SCAN
      if (op == OP_SCAN) rwkv_scan(p, smem, slot);
#endif
    }
    else if (op == OP_WO || op == OP_MLP2) {
      const u16 *A, *B; int K; const float* gate;
      if (op == OP_MLP2) { A = (const u16*)(AR + AR_HID); B = (const u16*)(p->ws + OFF_WB + WB_W2T); K = 4096; gate = MOD + (size_t)layer * 9 * 6144 + 5 * 1024; }
      else { K = 1024; gate = MOD + (size_t)layer * 9 * 6144 + 2 * 1024;
        if (kind == 0) { A = (const u16*)(AR + AR_ATT_O); B = (const u16*)(p->ws + OFF_WB + WB_ATT_WO); }
        else if (kind == 1) { A = (const u16*)(AR + AR_NA_O); B = (const u16*)(p->ws + OFF_WB + WB_NA_WO); }
        else { A = (const u16*)(AR + AR_YG); B = (const u16*)(p->ws + OFF_WB + WB_RW_WO); } }
      EpiResid E{p->out, (float*)(p->ws + OFF_XC), gate};
#ifndef NO_GR
      run_gemm(smem, A, B, M, 1024, K, E);
#endif
    }
    if (ph + 1 < hi) grid.sync();
  }
}

extern "C" void kernel_launch(void* const* d_in, const int* in_sizes, int n_in, void* d_out, int out_size, void* d_ws, size_t ws_size, hipStream_t stream) {
  static int grid_blocks = 0;
  if (!grid_blocks) {
    int dev = 0, cus = 0, per_cu = 0;
    hipGetDevice(&dev);
    hipDeviceGetAttribute(&cus, hipDeviceAttributeMultiprocessorCount, dev);
    hipFuncSetAttribute((const void*)mega, hipFuncAttributeMaxDynamicSharedMemorySize, LDS_BYTES);
    hipOccupancyMaxActiveBlocksPerMultiprocessor(&per_cu, (const void*)mega, 512, LDS_BYTES);
    if (per_cu < 1) per_cu = 1;
    grid_blocks = cus * per_cu;
    if (grid_blocks > 256) grid_blocks = 256;
    if (ws_size < 484 * MiB) fprintf(stderr, "kernel_launch: workspace too small: %zu\n", ws_size);
  }
  P p{};
  const float** pf = (const float**)&p;
  for (int i = 0; i < 35; ++i) pf[i] = (const float*)d_in[i];
  p.out = (float*)d_out; p.ws = (unsigned char*)d_ws;
#if FUSED
  int lo = 0, hi = NPHASE;
  void* args[] = {&p, &lo, &hi};
  hipError_t e = hipLaunchCooperativeKernel((const void*)mega, dim3(grid_blocks), dim3(512), args, LDS_BYTES, stream);
  if (e != hipSuccess) fprintf(stderr, "cooperative launch failed: %s (grid %d)\n", hipGetErrorString(e), grid_blocks);
#else
  for (int ph = 0; ph < NPHASE; ++ph) hipLaunchKernelGGL(mega, dim3(grid_blocks), dim3(512), LDS_BYTES, stream, p, ph, ph + 1);
#endif
}
```

```cpp
#include <hip/hip_runtime.h>
#include <hip/hip_cooperative_groups.h>
#include <cstdio>
#include <cstdint>
namespace cg = cooperative_groups;

#ifndef FUSED
#define FUSED 1
#endif

typedef unsigned short u16;
typedef short v8s __attribute__((ext_vector_type(8)));
typedef short v4s __attribute__((ext_vector_type(4)));
typedef float v2f __attribute__((ext_vector_type(2)));
typedef float v4f __attribute__((ext_vector_type(4)));
typedef float v16f __attribute__((ext_vector_type(16)));
typedef unsigned v4u __attribute__((ext_vector_type(4)));
typedef unsigned v2u __attribute__((ext_vector_type(2)));

constexpr int D = 1024, NB = 8, SEQ = 4096, CTXL = 256, TB = SEQ + CTXL, M = NB * TB;
constexpr float ALPHA = 1.6817928305074292f;
constexpr float LN_EPS = 1e-6f;
constexpr float LOG2E = 1.4426950408889634f;
constexpr size_t MiB = (size_t)1 << 20;
constexpr int LDS_BYTES = 131072 + 1024;
constexpr int NPHASE = 34;

constexpr size_t OFF_WB = 0;
constexpr size_t OFF_XC = 42 * MiB;
constexpr size_t OFF_MOD = 50 * MiB;
constexpr size_t OFF_TAB = 51 * MiB;
constexpr size_t OFF_ONES = 51 * MiB + 64 * 1024;
constexpr size_t OFF_BON = 52 * MiB;
constexpr size_t OFF_STATS = 56 * MiB + 512 * 1024;
constexpr size_t OFF_BARW = 57 * MiB;
constexpr size_t OFF_AR = 58 * MiB;
constexpr size_t WB_W1T = 0, WB_W2T = 8 * MiB, WB_MIX = 16 * MiB, WB_W2T_B = 34 * MiB;
constexpr size_t WB_ATT_WO = 19 * MiB, WB_NA_WO = 22 * MiB, WB_RW_WO = 30 * MiB, WB_RW_BG = 32 * MiB, WB_RW_W2T = 32 * MiB + 768 * 1024, WB_RW_A2T = 33 * MiB;
constexpr size_t AR_H = 0;
constexpr size_t AR_QKV = 68 * MiB, AR_ATT_O = 170 * MiB;
constexpr size_t AR_NA_QK = 68 * MiB, AR_NA_VT = 204 * MiB, AR_NA_O = 272 * MiB;
constexpr size_t AR_PART_WO = 68 * MiB, AR_PART_MLP2 = 340 * MiB;
constexpr size_t AR_HID = 68 * MiB;
constexpr size_t AR_Y0 = 0, AR_Y1 = 68 * MiB, AR_R = 136 * MiB, AR_K = 204 * MiB, AR_V = 272 * MiB, AR_L1 = 340 * MiB, AR_G = 366 * MiB, AR_YG = 136 * MiB;

struct P {
  const float *x, *c, *ctx, *c_ctx, *mod_w, *mod_b, *ln_g, *ln_b, *mlp_w1, *mlp_w2;
  const float *att_wqkv, *att_wo, *att_qn, *att_kn, *na_wqkv, *na_wo, *na_rpb;
  const float *rw_mu, *rw_wr, *rw_wk, *rw_wv, *rw_wo, *rw_w0, *rw_w1, *rw_w2, *rw_a0, *rw_a1, *rw_a2, *rw_g1, *rw_g2, *rw_kk, *rw_ka, *rw_rk, *rw_lng, *rw_lnb;
  float* out; unsigned char* ws;
};

typedef const __attribute__((address_space(4))) P* PP;
__device__ __forceinline__ int get_tid() { int t = threadIdx.x; asm volatile("" : "+v"(t)); return t; }
__device__ __forceinline__ int get_bid() { int t = blockIdx.x; asm volatile("" : "+s"(t)); return t; }
__device__ __forceinline__ int get_gdim() { int t = gridDim.x; asm volatile("" : "+s"(t)); return t; }
__device__ __forceinline__ unsigned cvtpk(float lo, float hi) { unsigned r; asm volatile("v_cvt_pk_bf16_f32 %0, %1, %2" : "=v"(r) : "v"(lo), "v"(hi)); return r; }
__device__ __forceinline__ float bf2f(u16 v) { return __uint_as_float((unsigned)v << 16); }
__device__ __forceinline__ float bflo(unsigned w) { return __uint_as_float(w << 16); }
__device__ __forceinline__ float bfhi(unsigned w) { return __uint_as_float(w & 0xffff0000u); }
__device__ __forceinline__ float wave_sum(float v) {
#pragma unroll
  for (int o = 32; o >= 1; o >>= 1) v += __shfl_xor(v, o);
  return v;
}
template <int CTRL> __device__ __forceinline__ float dppf(float v) { return __int_as_float(__builtin_amdgcn_update_dpp(0, __float_as_int(v), CTRL, 0xF, 0xF, true)); }
__device__ __forceinline__ float row_sum16(float v) { v += dppf<0xB1>(v); v += dppf<0x4E>(v); v += dppf<0x141>(v); v += dppf<0x140>(v); return v; }
__device__ __forceinline__ float* xrow(PP p, int row) {
  const int b = row / TB, t = row - b * TB;
  return t < SEQ ? p->out + (size_t)(b * SEQ + t) * D : (float*)(p->ws + OFF_XC) + (size_t)(b * CTXL + t - SEQ) * D;
}
__device__ __forceinline__ int modidx(int row) { const int b = row / TB, t = row - b * TB; return t < SEQ ? b : 8; }
__device__ __forceinline__ int crow(int r, int hi) { return (r & 3) + 8 * (r >> 2) + 4 * hi; }

namespace pg8 {
#define PG8_LAS __attribute__((address_space(3)))
typedef unsigned short bf16_t;
typedef short bf16x8 __attribute__((ext_vector_type(8)));
typedef float f32x4 __attribute__((ext_vector_type(4)));
typedef unsigned u32x4 __attribute__((ext_vector_type(4)));
constexpr int BM = 256, BK = 64, HALF = 128, HTB = HALF * BK * 2  , STAGE_BYTES = 8 * HTB, NXCD = 8, WGM = 8;

__host__ __device__ __forceinline__ int lds_byte(int r, int c) { const int st = (r >> 4) * 2 + (c >> 5), rr = r & 15, cc = c & 31, ob = rr * 64 + cc * 2; return st * 1024 + (ob ^ (((ob >> 9) & 1) << 5)); }
__host__ __device__ __forceinline__ void stage_rc(int b, int& R, int& C) { const int st = b / 1024, sb = b % 1024, swz = sb ^ (((sb >> 9) & 1) << 5); R = (st >> 1) * 16 + swz / 64; C = (st & 1) * 32 + (swz % 64) / 2; }
__host__ __device__ __forceinline__ int perm32(int rho) { const int n = rho >> 4, i = rho & 15; return 8 * (i >> 2) + 4 * n + (i & 3); }

struct Unit { int pm, pn; };
struct Gemm { const bf16_t* A; const bf16_t* Bt; int M, N, K, ld; };

struct StaticOrder {
    int nM, nN, nwg, G, c, skip, one, one_pm, one_pn;
    __host__ __device__ void init(int M, int N, int G_, int c_, int skip_ = 0) { nM = M / BM; if (skip_) nM = nM / 17 * 16; nN = N / BM; nwg = nM * nN; G = G_; c = c_; skip = skip_; one = 0; one_pm = 0; one_pn = 0; }
    __host__ __device__ bool next(int i, Unit& u) const {
        if (one) { if (one == 1 && i == 0) { u.pm = one_pm; u.pn = one_pn; return true; } return false; }
        const long L = (long)i * G + c; if (L >= nwg) return false;
        int wgid = (int)L; { const int q = nwg / NXCD, r = nwg % NXCD, xcd = wgid % NXCD, off = wgid / NXCD; wgid = (xcd < r ? xcd * (q + 1) : r * (q + 1) + (xcd - r) * q) + off; }
        const int nig = WGM * nN, gid = wgid / nig, fm = gid * WGM, gsz = (nM - fm) < WGM ? (nM - fm) : WGM;
        u.pm = fm + ((wgid % nig) % gsz); u.pn = (wgid % nig) / gsz; if (skip) u.pm += u.pm >> 4; return true;
    }
    __device__ __forceinline__ void a_ready(const Unit&) const {}
    __device__ __forceinline__ void done(const Unit&) const {}
};
__device__ __forceinline__ unsigned cvt_pk_bf16(float lo, float hi) { unsigned r; asm volatile("v_cvt_pk_bf16_f32 %0, %1, %2" : "=v"(r) : "v"(lo), "v"(hi)); return r; }
typedef float f32x2 __attribute__((ext_vector_type(2)));
template <class Epi, class Sched, bool STAMP = false>
__device__ __forceinline__ void gemm_phase(PG8_LAS unsigned char* lds, const Gemm g, const Sched& S, const Epi& E, unsigned long long* stamps) {
    const int tid = get_tid(), wid = __builtin_amdgcn_readfirstlane(tid >> 6), lane = tid & 63, wr = wid >> 2, wc = wid & 3, fr = lane & 15, fq = lane >> 4;
    const int K = g.K, nt = K / BK;
    int ts_lo = 0, ts_hi = 0, nts = 0; const unsigned long long rt_entry = STAMP ? (unsigned long long)wall_clock64() : 0ull;
#define PG8_STAMP() do { if (STAMP && wid == 0 && nts < 64) { const unsigned long long _c = (unsigned long long)clock64(); \
        ts_lo = (lane == nts) ? (int)(unsigned)_c : ts_lo; ts_hi = (lane == nts) ? (int)(unsigned)(_c >> 32) : ts_hi; ++nts; } } while (0)
    PG8_STAMP();
    unsigned voffA[2], voffB[2];
#pragma unroll
    for (int i = 0; i < 2; ++i) { int R, C; stage_rc(tid * 16 + i * 8192, R, C); const int Rb = Epi::PERM ? ((R & ~31) + perm32(R & 31)) : R;
        voffA[i] = (unsigned)(R * g.ld + C) * 2u; voffB[i] = (unsigned)(Rb * g.ld + C) * 2u; }
    const size_t kstep = (size_t)(BK * 2);
    const size_t hstep = (size_t)HALF * g.ld * 2;
    const size_t tstep = 2 * hstep;
    const unsigned ldsw = (unsigned)wid * 1024u;
    const int aoff = lds_byte(wr * 64 + fr, fq * 8), boff = lds_byte(wc * 32 + fr, fq * 8);
#define PG8_SA(b, h) (((b) * 2 + (h)) * HTB)
#define PG8_SB(b, h) ((4 + (b) * 2 + (h)) * HTB)
#define PG8_STAGE(bufoff, gbase, voff) do { _Pragma("unroll") for (int _i = 0; _i < 2; ++_i) \
        __builtin_amdgcn_global_load_lds((const unsigned*)((const char*)(gbase) + (voff)[_i]), (PG8_LAS unsigned*)(lds + (bufoff) + ldsw + _i * 8192), 16, 0, 0); } while (0)
#define PG8_LDA(dst, b, h) do { _Pragma("unroll") for (int m = 0; m < 4; ++m) _Pragma("unroll") for (int k = 0; k < 2; ++k) dst[m][k] = *(const PG8_LAS bf16x8*)(lds + PG8_SA(b, h) + aoff + m * 2048 + k * 1024); } while (0)
#define PG8_LDB(dst, b, h) do { _Pragma("unroll") for (int n = 0; n < 2; ++n) _Pragma("unroll") for (int k = 0; k < 2; ++k) dst[n][k] = *(const PG8_LAS bf16x8*)(lds + PG8_SB(b, h) + boff + n * 2048 + k * 1024); } while (0)
#define PG8_MMA(ai, bj, At, Bt) do { __builtin_amdgcn_s_setprio(1); _Pragma("unroll") for (int m = 0; m < 4; ++m) _Pragma("unroll") for (int n = 0; n < 2; ++n) _Pragma("unroll") for (int k = 0; k < 2; ++k) \
        acc[ai][bj][m][n] = __builtin_amdgcn_mfma_f32_16x16x32_bf16(Bt[n][k], At[m][k], acc[ai][bj][m][n], 0, 0, 0); __builtin_amdgcn_s_setprio(0); } while (0)
#define PG8_WAIT_V(n) asm volatile("s_waitcnt vmcnt(" #n ")" ::: "memory")
#define PG8_WAIT_L(n) asm volatile("s_waitcnt lgkmcnt(" #n ")" ::: "memory")
#define PG8_BAR __builtin_amdgcn_s_barrier()
#define PG8_SCHED __builtin_amdgcn_sched_barrier(0)
    Unit cur, nxt; int ui = 0;
    if (!S.next(0, cur)) return;
    f32x4 acc[2][2][4][2];
#pragma unroll
    for (int a = 0; a < 2; ++a)
#pragma unroll
        for (int b = 0; b < 2; ++b)
#pragma unroll
            for (int m = 0; m < 4; ++m)
#pragma unroll
                for (int n = 0; n < 2; ++n) acc[a][b][m][n] = (f32x4){0.f, 0.f, 0.f, 0.f};
    bf16x8 At[4][2], B0[2][2], B1[2][2];
    const char* cA = (const char*)g.A + (size_t)cur.pm * tstep; const char* cB = (const char*)g.Bt + (size_t)cur.pn * tstep;
    S.a_ready(cur);
    PG8_STAGE(PG8_SB(0, 0), cB, voffB); PG8_STAGE(PG8_SA(0, 0), cA, voffA); PG8_STAGE(PG8_SB(0, 1), cB + hstep, voffB); PG8_STAGE(PG8_SA(0, 1), cA + hstep, voffA);
    if (wr == 1) PG8_BAR;
    PG8_WAIT_V(4); PG8_BAR;
    PG8_STAGE(PG8_SB(1, 0), cB + kstep, voffB); PG8_STAGE(PG8_SA(1, 0), cA + kstep, voffA); PG8_STAGE(PG8_SB(1, 1), cB + hstep + kstep, voffB);
    PG8_WAIT_V(6); PG8_BAR;
    PG8_STAMP();
    for (;;) {
        const bool has_next = S.next(ui + 1, nxt);
        const char* nA = has_next ? (const char*)g.A + (size_t)nxt.pm * tstep : cA; const char* nB = has_next ? (const char*)g.Bt + (size_t)nxt.pn * tstep : cB;
        for (int t = 0; t < nt; t += 2) {
            const bool last = (t == nt - 2);
            const char* a1 = cA + (size_t)(t + 1) * kstep;
            const char* a2 = last ? nA : cA + (size_t)(t + 2) * kstep; const char* b2 = last ? nB : cB + (size_t)(t + 2) * kstep;
            const char* a3 = a2 + kstep; const char* b3 = b2 + kstep;
            if (last && has_next) S.a_ready(nxt);
            PG8_LDB(B0, 0, 0); PG8_SCHED; PG8_LDA(At, 0, 0); PG8_STAGE(PG8_SA(1, 1), a1 + hstep, voffA);
            PG8_WAIT_L(8); PG8_BAR; PG8_WAIT_L(0); PG8_MMA(0, 0, At, B0); PG8_BAR; PG8_SCHED;
            PG8_LDB(B1, 0, 1); PG8_STAGE(PG8_SB(0, 0), b2, voffB);
            PG8_BAR; PG8_WAIT_L(0); PG8_MMA(0, 1, At, B1); PG8_BAR;
            PG8_LDA(At, 0, 1); PG8_STAGE(PG8_SA(0, 0), a2, voffA);
            PG8_BAR; PG8_WAIT_L(0); PG8_MMA(1, 0, At, B0); PG8_BAR; PG8_SCHED;
            PG8_STAGE(PG8_SB(0, 1), b2 + hstep, voffB);
            PG8_WAIT_V(6); PG8_BAR; PG8_MMA(1, 1, At, B1); PG8_BAR;
            PG8_LDB(B0, 1, 0); PG8_SCHED; PG8_LDA(At, 1, 0); PG8_STAGE(PG8_SA(0, 1), a2 + hstep, voffA);
            PG8_WAIT_L(8); PG8_BAR; PG8_WAIT_L(0); PG8_MMA(0, 0, At, B0); PG8_BAR; PG8_SCHED;
            PG8_LDB(B1, 1, 1); PG8_STAGE(PG8_SB(1, 0), b3, voffB);
            PG8_BAR; PG8_WAIT_L(0); PG8_MMA(0, 1, At, B1); PG8_BAR;
            PG8_LDA(At, 1, 1); PG8_STAGE(PG8_SA(1, 0), a3, voffA);
            PG8_BAR; PG8_WAIT_L(0); PG8_MMA(1, 0, At, B0); PG8_BAR; PG8_SCHED;
            PG8_STAGE(PG8_SB(1, 1), b3 + hstep, voffB);
            PG8_WAIT_V(6); PG8_BAR; PG8_MMA(1, 1, At, B1); PG8_BAR;
        }
        PG8_STAMP();
        if constexpr (!Epi::AFTER_DRAIN) { E(acc, cur, wr, wc, fr, fq); S.done(cur); }
        PG8_STAMP();
        if (!has_next) break;
#pragma unroll
        for (int a = 0; a < 2; ++a)
#pragma unroll
            for (int b = 0; b < 2; ++b)
#pragma unroll
                for (int m = 0; m < 4; ++m)
#pragma unroll
                    for (int n = 0; n < 2; ++n) acc[a][b][m][n] = (f32x4){0.f, 0.f, 0.f, 0.f};
        cur = nxt; cA = nA; cB = nB; ++ui;
    }
    PG8_WAIT_V(0);
    if (wr == 0) PG8_BAR;
    PG8_BAR;
    if constexpr (Epi::AFTER_DRAIN) { E.fused(acc, cur, wr, wc, fr, fq, lds, wid, lane); S.done(cur); }
    PG8_STAMP();
    if (STAMP && wid == 0) { stamps[lane] = lane < nts ? (((unsigned long long)(unsigned)ts_hi << 32) | (unsigned)ts_lo) : 0ull;
        if (lane == 62) stamps[62] = rt_entry; if (lane == 63) stamps[63] = (unsigned long long)wall_clock64(); }
#undef PG8_STAMP
#undef PG8_SA
#undef PG8_SB
#undef PG8_STAGE
#undef PG8_LDA
#undef PG8_LDB
#undef PG8_MMA
#undef PG8_WAIT_V
#undef PG8_WAIT_L
#undef PG8_BAR
#undef PG8_SCHED
}
}

struct EpiStore {
  static constexpr bool PERM = true, AFTER_DRAIN = false;
  u16* O; int ldc; int act;
  __device__ __forceinline__ void operator()(const pg8::f32x4 (&acc)[2][2][4][2], const pg8::Unit& u, int wr, int wc, int fr, int fq) const {
    const int row0 = u.pm * 256 + wr * 64 + fr, col0 = u.pn * 256 + wc * 32 + 8 * fq;
#pragma unroll
    for (int ai = 0; ai < 2; ++ai)
#pragma unroll
      for (int m = 0; m < 4; ++m) {
        u16* rowp = O + (size_t)(row0 + ai * 128 + m * 16) * ldc + col0;
#pragma unroll
        for (int bj = 0; bj < 2; ++bj) {
          pg8::f32x4 v0 = acc[ai][bj][m][0], v1 = acc[ai][bj][m][1];
          if (act == 1) {
#pragma unroll
            for (int j = 0; j < 4; ++j) { float a = fmaxf(v0[j], 0.f), b = fmaxf(v1[j], 0.f); v0[j] = a * a; v1[j] = b * b; }
          }
          v4u w; w.x = cvtpk(v0[0], v0[1]); w.y = cvtpk(v0[2], v0[3]); w.z = cvtpk(v1[0], v1[1]); w.w = cvtpk(v1[2], v1[3]);
          *(v4u*)(rowp + bj * 128) = w;
        }
      }
  }
};
struct EpiResid {
  static constexpr bool PERM = false, AFTER_DRAIN = false;
  float* out; float* xc; const float* gate;
  const float* stats; const float* lng; const float* lnb;
  float* part;
  const float* xin_lat; const float* xin_ctx;
  __device__ __forceinline__ void operator()(const pg8::f32x4 (&acc)[2][2][4][2], const pg8::Unit& u, int wr, int wc, int fr, int fq) const {
    const int row0 = u.pm * 256 + wr * 64 + fr, col0 = u.pn * 256 + wc * 32 + 4 * fq;
    if (part) {
      const int ct = u.pm / 17;
#pragma unroll
      for (int ai = 0; ai < 2; ++ai)
#pragma unroll
        for (int m = 0; m < 4; ++m) {
          float* rowp = part + (size_t)(ct * 256 + wr * 64 + fr + ai * 128 + m * 16) * 1024 + col0;
#pragma unroll
          for (int bj = 0; bj < 2; ++bj)
#pragma unroll
            for (int n = 0; n < 2; ++n) *(pg8::f32x4*)(rowp + bj * 128 + n * 16) = acc[ai][bj][m][n];
        }
      return;
    }
#pragma unroll
    for (int ai = 0; ai < 2; ++ai)
#pragma unroll
      for (int m = 0; m < 4; ++m) {
        const int row = row0 + ai * 128 + m * 16; const int b = row / TB, t = row - b * TB;
        const size_t roff = t < SEQ ? (size_t)(b * SEQ + t) * D : (size_t)(b * CTXL + t - SEQ) * D;
        float* xr = (t < SEQ ? out : xc) + roff;
        const float* xi = (t < SEQ ? xin_lat : xin_ctx) + roff;
        const float* g = gate + (t < SEQ ? b : 8) * 6144;
        v2f st_ = {0.f, 1.f}; if (lng) st_ = *(const v2f*)(stats + (size_t)row * 2);
#pragma unroll
        for (int bj = 0; bj < 2; ++bj)
#pragma unroll
          for (int n = 0; n < 2; ++n) {
            const int c = col0 + bj * 128 + n * 16;
            pg8::f32x4 x = *(const pg8::f32x4*)(xi + c); const pg8::f32x4 gg = *(const pg8::f32x4*)(g + c);
            if (lng) x = (x - st_.x) * st_.y * *(const pg8::f32x4*)(lng + c) + *(const pg8::f32x4*)(lnb + c);
            *(pg8::f32x4*)(xr + c) = x * ALPHA + gg * acc[ai][bj][m][n];
          }
      }
  }
};
struct EpiRw1 {
  static constexpr bool PERM = true, AFTER_DRAIN = false;
  u16* RKV; u16* L1;
  __device__ __forceinline__ void operator()(const pg8::f32x4 (&acc)[2][2][4][2], const pg8::Unit& u, int wr, int wc, int fr, int fq) const {
    const int row0 = u.pm * 256 + wr * 64 + fr, lc0 = wc * 32 + 8 * fq;
    if (u.pn < 12) {
      u16* base = RKV + (size_t)(u.pn >> 2) * ((size_t)M * 1024) + (u.pn & 3) * 256 + lc0;
#pragma unroll
      for (int ai = 0; ai < 2; ++ai)
#pragma unroll
        for (int m = 0; m < 4; ++m) {
          u16* rowp = base + (size_t)(row0 + ai * 128 + m * 16) * 1024;
#pragma unroll
          for (int bj = 0; bj < 2; ++bj) {
            const pg8::f32x4 v0 = acc[ai][bj][m][0], v1 = acc[ai][bj][m][1];
            v4u w; w.x = cvtpk(v0[0], v0[1]); w.y = cvtpk(v0[2], v0[3]); w.z = cvtpk(v1[0], v1[1]); w.w = cvtpk(v1[2], v1[3]);
            *(v4u*)(rowp + bj * 128) = w;
          }
        }
    } else {
#pragma unroll
      for (int ai = 0; ai < 2; ++ai)
#pragma unroll
        for (int m = 0; m < 4; ++m) {
          u16* rowp = L1 + (size_t)(row0 + ai * 128 + m * 16) * 384 + (u.pn - 12) * 256 + lc0;
#pragma unroll
          for (int bj = 0; bj < 2; ++bj) {
            if (u.pn == 13 && bj == 1) continue;
            const int mode = (u.pn == 12) ? (bj == 0 ? 1 : 0) : 2;
            float v[8];
#pragma unroll
            for (int j = 0; j < 4; ++j) { v[j] = acc[ai][bj][m][0][j]; v[4 + j] = acc[ai][bj][m][1][j]; }
#pragma unroll
            for (int j = 0; j < 8; ++j) {
              if (mode == 1) v[j] = 1.f - 2.f / (1.f + __expf(2.f * v[j]));
              else if (mode == 2) v[j] = 1.f / (1.f + __expf(-v[j]));
            }
            v4u w; w.x = cvtpk(v[0], v[1]); w.y = cvtpk(v[2], v[3]); w.z = cvtpk(v[4], v[5]); w.w = cvtpk(v[6], v[7]);
            *(v4u*)(rowp + bj * 128) = w;
          }
        }
    }
  }
};

template <class Epi>
__device__ __forceinline__ void run_gemm(unsigned char* smem, const u16* A, const u16* Bt, int Mr, int N, int K, const Epi& E, int skip = 0, int ld = 0, int crot = 0) {
  pg8::Gemm g{A, Bt, Mr, N, K, ld ? ld : K}; pg8::StaticOrder S; S.init(Mr, N, get_gdim(), (get_bid() + crot) & (get_gdim() - 1), skip);
  pg8::gemm_phase<Epi, pg8::StaticOrder, false>((PG8_LAS unsigned char*)smem, g, S, E, nullptr);
  __syncthreads();
}

__device__ __forceinline__ void my_sincos(double x, float& s, float& c) {
  const double kd = rint(x * 0.6366197723675814);
  const int k = (int)kd;
  double r = fma(-kd, 1.5707963267948966, x); r = fma(-kd, 6.123233995736766e-17, r);
  const double r2 = r * r;
  const double sp = r * (1.0 + r2 * (-1.0 / 6.0 + r2 * (1.0 / 120.0 + r2 * (-1.0 / 5040.0 + r2 * (1.0 / 362880.0 + r2 * (-1.0 / 39916800.0 + r2 * (1.0 / 6227020800.0)))))));
  const double cp = 1.0 + r2 * (-0.5 + r2 * (1.0 / 24.0 + r2 * (-1.0 / 720.0 + r2 * (1.0 / 40320.0 + r2 * (-1.0 / 3628800.0 + r2 * (1.0 / 479001600.0 + r2 * (-1.0 / 87178291200.0)))))));
  const int q = k & 3;
  const double ss = (q == 0) ? sp : (q == 1) ? cp : (q == 2) ? -sp : -cp;
  const double cc = (q == 0) ? cp : (q == 1) ? -sp : (q == 2) ? -cp : sp;
  s = (float)ss; c = (float)cc;
}

__device__ void phase_mod(PP p, unsigned char* smem) {
  float* sc = (float*)smem; float* red = sc + 9 * 1024;
  const int tid = get_tid();
  for (int e = tid; e < 9 * 1024; e += 512) { const int j = e >> 10, k = e & 1023; const float v = j < 8 ? p->c[j * 1024 + k] : p->c_ctx[k]; sc[e] = v / (1.f + __expf(-v)); }
  __syncthreads();
  float* MOD = (float*)(p->ws + OFF_MOD);
  for (int item = get_bid(); item < 4 * 48; item += get_gdim()) {
    const int l = item / 48, cb = item % 48, c4 = (tid & 31) * 4, kq = tid >> 5;
    const float* w = p->mod_w + (size_t)l * 1024 * 6144 + cb * 128 + c4;
    v4f acc[9];
#pragma unroll
    for (int j = 0; j < 9; ++j) acc[j] = (v4f){0.f, 0.f, 0.f, 0.f};
#pragma unroll 16
    for (int k = kq * 64; k < kq * 64 + 64; ++k) {
      const v4f wv = *(const v4f*)(w + (size_t)k * 6144);
#pragma unroll
      for (int j = 0; j < 9; ++j) acc[j] += wv * sc[j * 1024 + k];
    }
#pragma unroll
    for (int j = 0; j < 9; ++j) *(v4f*)(red + ((kq * 9 + j) * 128 + c4)) = acc[j];
    __syncthreads();
    for (int o = tid; o < 9 * 128; o += 512) {
      const int j = o >> 7, cl = o & 127;
      float s = p->mod_b[l * 6144 + cb * 128 + cl];
#pragma unroll
      for (int q = 0; q < 16; ++q) s += red[(q * 9 + j) * 128 + cl];
      MOD[(size_t)(l * 9 + j) * 6144 + cb * 128 + cl] = s;
    }
    __syncthreads();
  }
  if (get_bid() == get_gdim() - 1) {
    float* ONES = (float*)(p->ws + OFF_ONES);
    for (int e = tid; e < 2048; e += 512) ONES[e] = e < 1024 ? 1.f : 0.f;
    v2f* TAB = (v2f*)(p->ws + OFF_TAB);
    for (int e = tid; e < 2048; e += 512) {
      const int pos = e >> 5, i = e & 31;
      double f = 1.0; for (int q = 0; q < i; ++q) f *= 0.7498942093324559;
      float s, c; my_sincos((double)pos * f, s, c);
      TAB[e] = (v2f){c, s};
    }
  }
}

__device__ void cvt_T(const float* src, int ldsrc, u16* dst, int ldd, int K, int N, const float* scale, float* tile, int& rot, int bid, int G) {
  const int tid = get_tid();
  const int ntn = N / 64, nt = (K / 64) * ntn;
  const int first = ((bid - rot) % G + G) % G;
  for (int t = first; t < nt; t += G) {
    const int tk = t / ntn, tn = t - tk * ntn;
#pragma unroll
    for (int i = 0; i < 8; ++i) {
      const int e = tid + 512 * i, k = e >> 6, n = e & 63;
      float v = src[(size_t)(tk * 64 + k) * ldsrc + tn * 64 + n];
      if (scale) v *= scale[tk * 64 + k];
      tile[k * 65 + n] = v;
    }
    __syncthreads();
    {
      const int n = tid >> 3, kc = (tid & 7) * 8;
      float v[8];
#pragma unroll
      for (int i = 0; i < 8; ++i) v[i] = tile[(kc + i) * 65 + n];
      v4u w; w.x = cvtpk(v[0], v[1]); w.y = cvtpk(v[2], v[3]); w.z = cvtpk(v[4], v[5]); w.w = cvtpk(v[6], v[7]);
      *(v4u*)(dst + (size_t)(tn * 64 + n) * ldd + tk * 64 + kc) = w;
    }
    __syncthreads();
  }
  rot = (rot + nt) % G;
}
__device__ void zero_bf16(u16* dst, int ldd, int nrows, int c0, int ncols, int bid, int G) {
  const int per = ncols / 8; const long total = (long)nrows * per;
  for (long i = (long)bid * 512 + get_tid(); i < total; i += (long)G * 512) {
    const long r = i / per; const int cc = (int)(i - r * per);
    *(v4u*)(dst + (size_t)r * ldd + c0 + cc * 8) = (v4u){0u, 0u, 0u, 0u};
  }
}

__device__ void convert_layer_weights(PP p, int layer, unsigned char* smem, int bid, int G, int parts = 7) {
  float* tile = (float*)smem; int rot = 0;
  const int kind = layer % 3, slot = layer / 3;
  u16* WB = (u16*)(p->ws + OFF_WB);
  if (parts & 1) cvt_T(p->mlp_w1 + (size_t)layer * 1024 * 4096, 4096, (u16*)(p->ws + OFF_WB + WB_W1T), 1024, 1024, 4096, nullptr, tile, rot, bid, G);
  if (parts & 4) cvt_T(p->mlp_w2 + (size_t)layer * 4096 * 1024, 1024, (u16*)(p->ws + OFF_WB + ((layer & 1) ? WB_W2T_B : WB_W2T)), 4096, 4096, 1024, nullptr, tile, rot, bid, G);
  if (!(parts & 2)) return;
  u16* MIX = (u16*)(p->ws + OFF_WB + WB_MIX);
  if (kind == 0) {
    cvt_T(p->att_wqkv + (size_t)slot * 1024 * 1536, 1536, MIX, 1024, 1024, 1536, nullptr, tile, rot, bid, G);
    cvt_T(p->att_wo + (size_t)slot * 1024 * 1024, 1024, (u16*)(p->ws + OFF_WB + WB_ATT_WO), 1024, 1024, 1024, nullptr, tile, rot, bid, G);
  } else if (kind == 1) {
    cvt_T(p->na_wqkv + (size_t)slot * 1024 * 3072, 3072, MIX, 1024, 1024, 3072, nullptr, tile, rot, bid, G);
    cvt_T(p->na_wo + (size_t)slot * 1024 * 1024, 1024, (u16*)(p->ws + OFF_WB + WB_NA_WO), 1024, 1024, 1024, nullptr, tile, rot, bid, G);
  } else {
    const float* mu = p->rw_mu + (size_t)slot * 6 * 1024;
    {
      const float* s0 = p->rw_wr + (size_t)slot * 1024 * 1024; const float* s1 = p->rw_wk + (size_t)slot * 1024 * 1024; const float* s2 = p->rw_wv + (size_t)slot * 1024 * 1024;
      cvt_T(s0, 1024, MIX, 2048, 1024, 1024, nullptr, tile, rot, bid, G);
      cvt_T(s0, 1024, MIX + 1024, 2048, 1024, 1024, mu + 0 * 1024, tile, rot, bid, G);
      cvt_T(s1, 1024, MIX + (size_t)1024 * 2048, 2048, 1024, 1024, nullptr, tile, rot, bid, G);
      cvt_T(s1, 1024, MIX + (size_t)1024 * 2048 + 1024, 2048, 1024, 1024, mu + 2 * 1024, tile, rot, bid, G);
      cvt_T(s2, 1024, MIX + (size_t)2048 * 2048, 2048, 1024, 1024, nullptr, tile, rot, bid, G);
      cvt_T(s2, 1024, MIX + (size_t)2048 * 2048 + 1024, 2048, 1024, 1024, mu + 3 * 1024, tile, rot, bid, G);
    }
    for (int d = 0; d < 2; ++d) {
      const float* w1 = p->rw_w1 + (size_t)(slot * 2 + d) * 1024 * 64;
      cvt_T(w1, 64, MIX + (size_t)(3072 + 64 * d) * 2048, 2048, 1024, 64, nullptr, tile, rot, bid, G);
      cvt_T(w1, 64, MIX + (size_t)(3072 + 64 * d) * 2048 + 1024, 2048, 1024, 64, mu + 1 * 1024, tile, rot, bid, G);
      const float* a1 = p->rw_a1 + (size_t)(slot * 2 + d) * 1024 * 64;
      cvt_T(a1, 64, MIX + (size_t)(3200 + 64 * d) * 2048, 2048, 1024, 64, nullptr, tile, rot, bid, G);
      cvt_T(a1, 64, MIX + (size_t)(3200 + 64 * d) * 2048 + 1024, 2048, 1024, 64, mu + 4 * 1024, tile, rot, bid, G);
      cvt_T(p->rw_w2 + (size_t)(slot * 2 + d) * 64 * 1024, 1024, (u16*)(p->ws + OFF_WB + WB_RW_W2T) + (size_t)d * 1024 * 64, 64, 64, 1024, nullptr, tile, rot, bid, G);
      cvt_T(p->rw_a2 + (size_t)(slot * 2 + d) * 64 * 1024, 1024, (u16*)(p->ws + OFF_WB + WB_RW_A2T) + (size_t)d * 1024 * 64, 64, 64, 1024, nullptr, tile, rot, bid, G);
    }
    const float* g1 = p->rw_g1 + (size_t)slot * 1024 * 128;
    cvt_T(g1, 128, MIX + (size_t)3328 * 2048, 2048, 1024, 128, nullptr, tile, rot, bid, G);
    cvt_T(g1, 128, MIX + (size_t)3328 * 2048 + 1024, 2048, 1024, 128, mu + 5 * 1024, tile, rot, bid, G);
    zero_bf16(MIX + (size_t)3456 * 2048, 2048, 128, 0, 2048, bid, G);
    cvt_T(p->rw_wo + (size_t)slot * 1024 * 1024, 1024, (u16*)(p->ws + OFF_WB + WB_RW_WO), 1024, 1024, 1024, nullptr, tile, rot, bid, G);
    u16* BG = (u16*)(p->ws + OFF_WB + WB_RW_BG);
    zero_bf16(BG, 384, 1024, 0, 256, bid, G);
    cvt_T(p->rw_g2 + (size_t)slot * 128 * 1024, 1024, BG + 256, 384, 128, 1024, nullptr, tile, rot, bid, G);
  }
  (void)WB;
}

__device__ void rowpass(PP p, int src_ln, int mod_layer, int mod_off, u16* H, int ldh, bool final, bool skipctx = false, int nparts = 0, const float* part = nullptr, int pend_ln = -1, const float* gatec = nullptr, bool ctx_from_input = false) {
  const int wid = get_tid() >> 6, lane = get_tid() & 63;
  const float* MOD = (const float*)(p->ws + OFF_MOD);
  v4f lg_[4], lb_[4];
#pragma unroll
  for (int q = 0; q < 4; ++q) {
    lg_[q] = src_ln >= 0 ? *(const v4f*)(p->ln_g + (size_t)src_ln * 1024 + q * 256 + lane * 4) : (v4f){1.f, 1.f, 1.f, 1.f};
    lb_[q] = src_ln >= 0 ? *(const v4f*)(p->ln_b + (size_t)src_ln * 1024 + q * 256 + lane * 4) : (v4f){0.f, 0.f, 0.f, 0.f};
  }
  for (int row = get_bid() * 8 + wid; row < M; row += get_gdim() * 8) {
    const int b = row / TB, t = row - b * TB;
    if ((final || skipctx) && t >= SEQ) continue;
    float* xr = xrow(p, row);
    const float* src = src_ln < 0 ? (t < SEQ ? p->x + (size_t)(b * SEQ + t) * D : p->ctx + (size_t)(b * CTXL + t - SEQ) * D) : ((ctx_from_input && t >= SEQ) ? p->ctx + (size_t)(b * CTXL + t - SEQ) * D : xr);
    v4f v[4];
#pragma unroll
    for (int q = 0; q < 4; ++q) v[q] = *(const v4f*)(src + q * 256 + lane * 4);
    if (nparts > 0 && t >= SEQ) {
      const v2f ps = *(const v2f*)((const float*)(p->ws + OFF_STATS) + (size_t)row * 2);
      const float* pg_ = pend_ln < 0 ? (const float*)(p->ws + OFF_ONES) : p->ln_g + (size_t)pend_ln * 1024;
      const float* pb_ = pend_ln < 0 ? (const float*)(p->ws + OFF_ONES) + 1024 : p->ln_b + (size_t)pend_ln * 1024;
      const int crow = b * CTXL + t - SEQ;
#pragma unroll
      for (int q = 0; q < 4; ++q) {
        const int c = q * 256 + lane * 4;
        v4f acc = *(const v4f*)(part + (size_t)crow * 1024 + c);
        for (int ks = 1; ks < nparts; ++ks) acc += *(const v4f*)(part + ((size_t)ks * 2048 + crow) * 1024 + c);
        v[q] = ((v[q] - ps.x) * ps.y * *(const v4f*)(pg_ + c) + *(const v4f*)(pb_ + c)) * ALPHA + *(const v4f*)(gatec + c) * acc;
        *(v4f*)(xr + c) = v[q];
      }
    }
    if (src_ln >= 0) {
      float s = 0.f;
#pragma unroll
      for (int q = 0; q < 4; ++q) s += (v[q][0] + v[q][1]) + (v[q][2] + v[q][3]);
      const float mean = wave_sum(s) * (1.f / 1024.f);
      float sq = 0.f;
#pragma unroll
      for (int q = 0; q < 4; ++q) { v[q] = v[q] - mean; sq += (v[q][0] * v[q][0] + v[q][1] * v[q][1]) + (v[q][2] * v[q][2] + v[q][3] * v[q][3]); }
      const float rstd = 1.0f / sqrtf(wave_sum(sq) * (1.f / 1024.f) + LN_EPS);
      if (lane == 0 && !final) *(v2f*)((float*)(p->ws + OFF_STATS) + (size_t)row * 2) = (v2f){mean, rstd};
#pragma unroll
      for (int q = 0; q < 4; ++q) v[q] = v[q] * rstd * lg_[q] + lb_[q];
    }
    if (final) {
#pragma unroll
      for (int q = 0; q < 4; ++q) *(v4f*)(xr + q * 256 + lane * 4) = v[q];
    }
    if (src_ln < 0 && lane == 0) *(v2f*)((float*)(p->ws + OFF_STATS) + (size_t)row * 2) = (v2f){0.f, 1.f};
    if (final) continue;
    const float* md = MOD + (size_t)(mod_layer * 9 + (t < SEQ ? b : 8)) * 6144 + mod_off * 1024;
#pragma unroll
    for (int q = 0; q < 4; ++q) {
      const v4f sh = *(const v4f*)(md + q * 256 + lane * 4), scl = *(const v4f*)(md + 1024 + q * 256 + lane * 4);
      const v4f h = v[q] * (scl + 1.f) + sh;
      v2u w; w.x = cvtpk(h[0], h[1]); w.y = cvtpk(h[2], h[3]);
      *(v2u*)(H + (size_t)row * ldh + q * 256 + lane * 4) = w;
    }
  }
}

__device__ void xx_pass(PP p) {
  u16* HX = (u16*)(p->ws + OFF_AR + AR_H);
  for (long idx = (long)get_bid() * 512 + get_tid(); idx < (long)M * 128; idx += (long)get_gdim() * 512) {
    const int row = (int)(idx >> 7), c8 = (int)(idx & 127) * 8;
    const int t = row % TB;
    const bool first = (t == 0) || (t == SEQ), last = (t == SEQ - 1) || (t == TB - 1);
    const v4u z = {0u, 0u, 0u, 0u};
    const v4u h = *(const v4u*)(HX + (size_t)row * 2048 + c8);
    const v4u hp = first ? z : *(const v4u*)(HX + (size_t)(row - 1) * 2048 + c8);
    const v4u hn = last ? z : *(const v4u*)(HX + (size_t)(row + 1) * 2048 + c8);
    v4u o;
#pragma unroll
    for (int j = 0; j < 4; ++j) {
      const float lo = 0.5f * (bflo(hp[j]) + bflo(hn[j])) - bflo(h[j]);
      const float hi = 0.5f * (bfhi(hp[j]) + bfhi(hn[j])) - bfhi(h[j]);
      o[j] = cvtpk(lo, hi);
    }
    *(v4u*)(HX + (size_t)row * 2048 + 1024 + c8) = o;
  }
}

__device__ void qk_prep(PP p, int slot) {
  u16* QKV = (u16*)(p->ws + OFF_AR + AR_QKV);
  const v2f* TAB = (const v2f*)(p->ws + OFF_TAB);
  const int tid = get_tid(), q = tid & 15, d0 = q * 8;
  const float* qn = p->att_qn + slot * 128; const float* kn = p->att_kn + slot * 128;
  const int pq = q ^ 4, pd0 = pq * 8;
  const bool up = (q & 4) != 0;
  const int i0 = d0 & 31;
  const bool colang = q >= 8;
  float gq_[8], gk_[8], pgq_[8], pgk_[8];
#pragma unroll
  for (int j = 0; j < 8; ++j) { gq_[j] = qn[d0 + j]; gk_[j] = kn[d0 + j]; pgq_[j] = qn[pd0 + j]; pgk_[j] = kn[pd0 + j]; }
  const int total = M * 2, stride = get_gdim() * 32;
  for (int it0 = get_bid() * 32 + (tid >> 4); it0 < total; it0 += stride * 4) {
    v4u raws[4];
#pragma unroll
    for (int uu = 0; uu < 4; ++uu) {
      const int it = it0 + uu * stride;
      if (it < total) { const int row = it >> 1, hs = 8 + (it & 1); raws[uu] = *(const v4u*)(QKV + (size_t)row * 1536 + hs * 128 + d0); }
    }
#pragma unroll
    for (int uu = 0; uu < 4; ++uu) {
      const int it = it0 + uu * stride;
      if (it < total) {
        const int row = it >> 1, hs = 8 + (it & 1);
        u16* base = QKV + (size_t)row * 1536 + hs * 128 + d0;
        const v4u raw = raws[uu];
        v4u praw;
#pragma unroll
        for (int j = 0; j < 4; ++j) praw[j] = (unsigned)__shfl_xor((int)raw[j], 4);
        float e[8], pe[8];
#pragma unroll
        for (int j = 0; j < 4; ++j) { e[2 * j] = bflo(raw[j]); e[2 * j + 1] = bfhi(raw[j]); pe[2 * j] = bflo(praw[j]); pe[2 * j + 1] = bfhi(praw[j]); }
        float ss = 0.f;
#pragma unroll
        for (int j = 0; j < 8; ++j) ss += e[j] * e[j];
        ss = row_sum16(ss);
        const float rn = 1.0f / sqrtf(ss * (1.f / 128.f) + LN_EPS);
        const bool isq = hs < 8;
        const int t = row % TB;
        const bool rope = t < SEQ;
        const int pos = colang ? (t & 63) : (t >> 6);
        float o[8];
        if (rope) {
          const v4f* tp = (const v4f*)(TAB + (pos & 63) * 32 + i0);
          const v4f c01 = tp[0], c23 = tp[1], c45 = tp[2], c67 = tp[3];
          const float cs_[8] = {c01[0], c01[2], c23[0], c23[2], c45[0], c45[2], c67[0], c67[2]};
          const float sn_[8] = {c01[1], c01[3], c23[1], c23[3], c45[1], c45[3], c67[1], c67[3]};
#pragma unroll
          for (int j = 0; j < 8; ++j) {
            const float x = e[j] * rn * (isq ? gq_[j] : gk_[j]);
            const float px = pe[j] * rn * (isq ? pgq_[j] : pgk_[j]);
            o[j] = x * cs_[j] + (up ? px : -px) * sn_[j];
          }
        } else {
#pragma unroll
          for (int j = 0; j < 8; ++j) o[j] = e[j] * rn * (isq ? gq_[j] : gk_[j]);
        }
        v4u w; w.x = cvtpk(o[0], o[1]); w.y = cvtpk(o[2], o[3]); w.z = cvtpk(o[4], o[5]); w.w = cvtpk(o[6], o[7]);
        *(v4u*)base = w;
      }
    }
  }
}

namespace att {
constexpr int DH = 128, NW = 8, QBLK = 32, KVBLK = 64;
constexpr float SCALE = 0.088388347648318440f;
constexpr float THR = 8.f;
constexpr int LDQ = 1536, LDK = 1536, LDO = 1024;
constexpr size_t SHM_V = KVBLK * DH * 2, SHM_K = KVBLK * DH * 2;
#define KSWZ(row, colB) ((row) * 256 + ((colB) ^ (((row) & 7) << 4)))
#define SBAR() __builtin_amdgcn_sched_barrier(0)
__device__ __forceinline__ void partialSM(v16f& p0, v16f& p1, float& m_reg, float& mn, float& alpha) {
  constexpr float C = SCALE * 1.4426950408889634f;
  float pmax = p0[0];
#pragma unroll
  for (int r = 1; r < 16; ++r) pmax = fmaxf(pmax, p0[r]);
#pragma unroll
  for (int r = 0; r < 16; ++r) pmax = fmaxf(pmax, p1[r]);
  { auto rr = __builtin_amdgcn_permlane32_swap(__float_as_uint(pmax), __float_as_uint(pmax), false, false);
    pmax = fmaxf(__uint_as_float(rr[0]), __uint_as_float(rr[1])); }
  if (__builtin_expect(__all(pmax - m_reg <= THR / SCALE), 1)) { mn = m_reg; alpha = 1.f; }
  else { mn = fmaxf(m_reg, pmax); alpha = __builtin_amdgcn_exp2f((m_reg - mn) * C); m_reg = mn; }
  float mnC = -mn * C;
#pragma unroll
  for (int r = 0; r < 16; ++r) p0[r] = fmaf(p0[r], C, mnC);
#pragma unroll
  for (int r = 0; r < 16; ++r) p1[r] = fmaf(p1[r], C, mnC);
#pragma unroll
  for (int r = 0; r < 16; ++r) p0[r] = __builtin_amdgcn_exp2f(p0[r]);
}
__device__ __forceinline__ void finishSM(v16f& p0, v16f& p1, float alpha, float& l_reg, v8s& pa0, v8s& pa1, v8s& pa2, v8s& pa3) {
#pragma unroll
  for (int r = 0; r < 16; ++r) p1[r] = __builtin_amdgcn_exp2f(p1[r]);
  float ps = 0;
#pragma unroll
  for (int r = 0; r < 16; ++r) ps += p0[r];
#pragma unroll
  for (int r = 0; r < 16; ++r) ps += p1[r];
  { auto rr = __builtin_amdgcn_permlane32_swap(__float_as_uint(ps), __float_as_uint(ps), false, false);
    ps = __uint_as_float(rr[0]) + __uint_as_float(rr[1]); }
  l_reg = l_reg * alpha + ps;
#define PK4(Pv, BASE, OUT) do { unsigned a0 = cvtpk(Pv[BASE + 0], Pv[BASE + 1]), a1 = cvtpk(Pv[BASE + 2], Pv[BASE + 3]);   \
    unsigned b0 = cvtpk(Pv[BASE + 4], Pv[BASE + 5]), b1 = cvtpk(Pv[BASE + 6], Pv[BASE + 7]);                              \
    auto r0 = __builtin_amdgcn_permlane32_swap(a0, b0, false, false); auto r1 = __builtin_amdgcn_permlane32_swap(a1, b1, false, false); \
    v4u w = {r0[0], r1[0], r0[1], r1[1]}; OUT = *reinterpret_cast<v8s*>(&w); } while (0)
  PK4(p0, 0, pa0); PK4(p0, 8, pa1); PK4(p1, 0, pa2); PK4(p1, 8, pa3);
#undef PK4
}
__device__ __forceinline__ void qkt(v16f& p0, v16f& p1, const u16* Ks, const v8s* qr, int r32, int hi) {
  p0 = v16f{}; p1 = v16f{};
#pragma unroll
  for (int d0 = 0; d0 < 8; ++d0) { int cb = (d0 * 16 + hi * 8) * 2;
    v8s b0 = *reinterpret_cast<const v8s*>((const char*)Ks + KSWZ(r32, cb));
    v8s b1 = *reinterpret_cast<const v8s*>((const char*)Ks + KSWZ(32 + r32, cb));
    p0 = __builtin_amdgcn_mfma_f32_32x32x16_bf16(b0, qr[d0], p0, 0, 0, 0);
    p1 = __builtin_amdgcn_mfma_f32_32x32x16_bf16(b1, qr[d0], p1, 0, 0, 0); }
}
__device__ __forceinline__ int v_st(int k, int c) { const int kk = (k & ~0xC) | ((k & 4) << 1) | ((k & 8) >> 1); return ((kk >> 3) * 4 + (c >> 5)) * 512 + ((kk & 7) * 32 + (c & 31)) * 2; }
__device__ __forceinline__ int v_rd_base(int lane) { return ((lane & 3) << 3) | (((lane >> 2) & 3) << 6) | (((lane >> 4) & 1) << 5) | (((lane >> 5) & 1) << 8); }
constexpr int v_rd_off(int d0, int ks, int half) { return d0 * 512 + ks * 4096 + half * 2048; }
template <int OFF> __device__ __forceinline__ v4s tr_read(int vb) {
  v4s r; asm volatile("ds_read_b64_tr_b16 %0, %1 offset:%2" : "=&v"(r) : "v"(vb), "i"(OFF) : "memory"); return r;
}
template <int D0> __device__ __forceinline__ void pv_one(v16f& od, int vb, v8s pa0, v8s pa1, v8s pa2, v8s pa3) {
  const v4s l0 = tr_read<v_rd_off(D0, 0, 0)>(vb), h0 = tr_read<v_rd_off(D0, 0, 1)>(vb), l1 = tr_read<v_rd_off(D0, 1, 0)>(vb), h1 = tr_read<v_rd_off(D0, 1, 1)>(vb);
  const v4s l2 = tr_read<v_rd_off(D0, 2, 0)>(vb), h2 = tr_read<v_rd_off(D0, 2, 1)>(vb), l3 = tr_read<v_rd_off(D0, 3, 0)>(vb), h3 = tr_read<v_rd_off(D0, 3, 1)>(vb);
  asm volatile("s_waitcnt lgkmcnt(0)" ::: "memory"); SBAR();
#define PKV(L, H) (v8s){L[0], L[1], L[2], L[3], H[0], H[1], H[2], H[3]}
  od = __builtin_amdgcn_mfma_f32_32x32x16_bf16(pa0, PKV(l0, h0), od, 0, 0, 0);
  od = __builtin_amdgcn_mfma_f32_32x32x16_bf16(pa1, PKV(l1, h1), od, 0, 0, 0);
  od = __builtin_amdgcn_mfma_f32_32x32x16_bf16(pa2, PKV(l2, h2), od, 0, 0, 0);
  od = __builtin_amdgcn_mfma_f32_32x32x16_bf16(pa3, PKV(l3, h3), od, 0, 0, 0);
#undef PKV
}
__device__ __forceinline__ void pv_d0(v16f* o, int vb, v8s pa0, v8s pa1, v8s pa2, v8s pa3) {
  pv_one<0>(o[0], vb, pa0, pa1, pa2, pa3); pv_one<1>(o[1], vb, pa0, pa1, pa2, pa3); pv_one<2>(o[2], vb, pa0, pa1, pa2, pa3); pv_one<3>(o[3], vb, pa0, pa1, pa2, pa3);
}
__device__ __forceinline__ void attn_dense_body(const u16* __restrict__ Qb, const u16* __restrict__ Kh, const u16* __restrict__ Vh,
                                                u16* __restrict__ Ob, int seq, char* lds, const float* __restrict__ qn, const v2f* __restrict__ TAB, int t0, bool rope) {
  const int tid = get_tid(), wid = tid >> 6, lane = tid & 63, r32 = lane & 31, hi = lane >> 5;
  u16* V_lds = (u16*)lds; u16* K_lds = (u16*)(lds + 2 * SHM_V);
  float* ws = (float*)(lds + 2 * SHM_V + 2 * SHM_K) + wid * 64; float* li_l = ws; float* al_l = ws + 32;
  float m_reg = -1e30f, l_reg = 0; v16f o[4] = {}; v8s qr[8];
  const u16* Qw = Qb + (long)(wid * QBLK + r32) * LDQ + hi * 8;
#pragma unroll
  for (int d0 = 0; d0 < 8; ++d0) qr[d0] = *reinterpret_cast<const v8s*>(Qw + d0 * 16);
  {
    float xq[8][8]; float ss = 0.f;
#pragma unroll
    for (int d0 = 0; d0 < 8; ++d0) {
      const v4u w = *reinterpret_cast<const v4u*>(&qr[d0]);
#pragma unroll
      for (int j = 0; j < 4; ++j) { xq[d0][2 * j] = bflo(w[j]); xq[d0][2 * j + 1] = bfhi(w[j]); ss += xq[d0][2 * j] * xq[d0][2 * j] + xq[d0][2 * j + 1] * xq[d0][2 * j + 1]; }
    }
    ss += __shfl_xor(ss, 32);
    const float rn = 1.0f / sqrtf(ss * (1.f / 128.f) + LN_EPS);
#pragma unroll
    for (int d0 = 0; d0 < 8; ++d0) {
      const v4f g0 = *(const v4f*)(qn + d0 * 16 + hi * 8), g1 = *(const v4f*)(qn + d0 * 16 + hi * 8 + 4);
#pragma unroll
      for (int e = 0; e < 4; ++e) { xq[d0][e] *= rn * g0[e]; xq[d0][4 + e] *= rn * g1[e]; }
    }
    if (rope) {
      const int t = t0 + wid * QBLK + r32;
#pragma unroll
      for (int m = 0; m < 2; ++m)
#pragma unroll
        for (int ax = 0; ax < 2; ++ax) {
          const int pos = ax ? (t & 63) : (t >> 6);
          const v4f* tp = (const v4f*)(TAB + pos * 32 + 16 * m + 8 * hi);
          const int da = m + 4 * ax, db = da + 2;
#pragma unroll
          for (int e2 = 0; e2 < 4; ++e2) {
            const v4f cs = tp[e2];
#pragma unroll
            for (int k = 0; k < 2; ++k) {
              const float c_ = cs[2 * k], s_ = cs[2 * k + 1];
              const float xa = xq[da][2 * e2 + k], xb = xq[db][2 * e2 + k];
              xq[da][2 * e2 + k] = xa * c_ - xb * s_;
              xq[db][2 * e2 + k] = xb * c_ + xa * s_;
            }
          }
        }
    }
#pragma unroll
    for (int d0 = 0; d0 < 8; ++d0) {
      v4u w; w.x = cvtpk(xq[d0][0], xq[d0][1]); w.y = cvtpk(xq[d0][2], xq[d0][3]); w.z = cvtpk(xq[d0][4], xq[d0][5]); w.w = cvtpk(xq[d0][6], xq[d0][7]);
      qr[d0] = *reinterpret_cast<v8s*>(&w);
    }
  }
  const int sr = tid >> 4, sc = (tid & 15) * 8, vst0 = v_st(sr, sc), vst1 = v_st(32 + sr, sc);
  const int vb0 = (int)(uintptr_t)V_lds + v_rd_base(lane);
  struct { v8s vs0, vs1, ks0, ks1; } sr_[2];
#define SLOAD(i, k0) do { sr_[i].vs0 = *(const v8s*)(&Vh[(long)((k0) + sr) * LDK + sc]); sr_[i].vs1 = *(const v8s*)(&Vh[(long)((k0) + 32 + sr) * LDK + sc]); \
    sr_[i].ks0 = *(const v8s*)(&Kh[(long)((k0) + sr) * LDK + sc]); sr_[i].ks1 = *(const v8s*)(&Kh[(long)((k0) + 32 + sr) * LDK + sc]); } while (0)
#define SWRITE(b, i) do { *(v8s*)((char*)V_lds + (b) * SHM_V + vst0) = sr_[i].vs0;          \
    *(v8s*)((char*)V_lds + (b) * SHM_V + vst1) = sr_[i].vs1; int kc = sc * 2;               \
    *(v8s*)((char*)K_lds + (b) * SHM_K + KSWZ(sr, kc)) = sr_[i].ks0;                       \
    *(v8s*)((char*)K_lds + (b) * SHM_K + KSWZ(32 + sr, kc)) = sr_[i].ks1; } while (0)
#define SWAIT() asm volatile("s_waitcnt vmcnt(4)" ::: "memory")
#define RESC(a) do { if (__any((a) < 1.f)) { if (hi == 0) al_l[r32] = (a); asm volatile("s_waitcnt lgkmcnt(0)" ::: "memory"); \
    for (int d = 0; d < 4; ++d) for (int r = 0; r < 16; ++r) o[d][r] *= al_l[crow(r, hi)]; } } while (0)
  v16f pA0, pA1, pB0, pB1; float mnA, mnB, alA, alB; v8s pa0, pa1, pa2, pa3; const int NT = seq / KVBLK;
  constexpr int SE = 0, SO = 1;
  SLOAD(SE, 0); asm volatile("s_waitcnt vmcnt(0)" ::: "memory"); SWRITE(0, SE); __syncthreads();
  qkt(pA0, pA1, K_lds, qr, r32, hi); partialSM(pA0, pA1, m_reg, mnA, alA);
  SLOAD(SO, KVBLK); if (2 < NT) SLOAD(SE, 2 * KVBLK);
  SWAIT(); SWRITE(1, SO); __syncthreads();
  for (int j = 1; j + 1 < NT; j += 2) {
    SBAR(); qkt(pB0, pB1, (u16*)((char*)K_lds + SHM_K), qr, r32, hi);
    finishSM(pA0, pA1, alA, l_reg, pa0, pa1, pa2, pa3); SBAR();
    SLOAD(SO, (j + 2) * KVBLK); SBAR();
    pv_d0(o, vb0, pa0, pa1, pa2, pa3); partialSM(pB0, pB1, m_reg, mnB, alB);
    __syncthreads(); SWAIT(); SWRITE(0, SE);
    RESC(alB); __syncthreads();
    SBAR(); qkt(pA0, pA1, K_lds, qr, r32, hi);
    finishSM(pB0, pB1, alB, l_reg, pa0, pa1, pa2, pa3); SBAR();
    if (j + 3 < NT) SLOAD(SE, (j + 3) * KVBLK); SBAR();
    pv_d0(o, vb0 + (int)SHM_V, pa0, pa1, pa2, pa3); partialSM(pA0, pA1, m_reg, mnA, alA);
    __syncthreads(); SWAIT(); SWRITE(1, SO);
    RESC(alA); __syncthreads();
  }
  SBAR(); qkt(pB0, pB1, (u16*)((char*)K_lds + SHM_K), qr, r32, hi);
  finishSM(pA0, pA1, alA, l_reg, pa0, pa1, pa2, pa3); SBAR();
  pv_d0(o, vb0, pa0, pa1, pa2, pa3); partialSM(pB0, pB1, m_reg, mnB, alB);
  __syncthreads(); RESC(alB);
  finishSM(pB0, pB1, alB, l_reg, pa0, pa1, pa2, pa3); SBAR();
  pv_d0(o, vb0 + (int)SHM_V, pa0, pa1, pa2, pa3);
  if (hi == 0) li_l[r32] = l_reg; asm volatile("s_waitcnt lgkmcnt(0)" ::: "memory");
  float rli[16];
#pragma unroll
  for (int r = 0; r < 16; ++r) rli[r] = __builtin_amdgcn_rcpf(li_l[crow(r, hi)]);
  u16* Ow = Ob + (long)(wid * QBLK) * LDO;
#pragma unroll
  for (int r = 0; r < 16; ++r) { int orow = crow(r, hi);
#pragma unroll
    for (int d0 = 0; d0 < 4; ++d0) { const float val = o[d0][r] * rli[r]; Ow[(long)orow * LDO + d0 * 32 + r32] = (u16)(cvtpk(val, val) & 0xffffu); } }
#undef SLOAD
#undef SWRITE
#undef SWAIT
#undef RESC
}
}

__device__ void gqa_attention(PP p, unsigned char* smem, bool want_ctx, int slot) {
  const u16* QKV = (const u16*)(p->ws + OFF_AR + AR_QKV);
  u16* O = (u16*)(p->ws + OFF_AR + AR_ATT_O);
  const int nitems = 1024 + (want_ctx ? 64 : 0);
  for (int item = get_bid(); item < nitems; item += get_gdim()) {
    int b, h, qrow, krow, seq;
    if (item < 1024) { b = item >> 7; const int rem = item & 127; h = rem >> 4; qrow = b * TB + (rem & 15) * 256; krow = b * TB; seq = TB; }
    else { const int ci = item - 1024; b = ci >> 3; h = ci & 7; qrow = b * TB + SEQ; krow = b * TB + SEQ; seq = CTXL; }
    const int kvh = h >> 2;
    att::attn_dense_body(QKV + (size_t)qrow * 1536 + h * 128, QKV + (size_t)krow * 1536 + 1024 + kvh * 128, QKV + (size_t)krow * 1536 + 1280 + kvh * 128,
                         O + (size_t)qrow * 1024 + h * 128, seq, (char*)smem, p->att_qn + slot * 128, (const v2f*)(p->ws + OFF_TAB), qrow - b * TB, item < 1024);
    __syncthreads();
  }
}

__device__ void na_attention(PP p, unsigned char* smem, bool want_ctx) {
  const u16* QK = (const u16*)(p->ws + OFF_AR + AR_NA_QK);
  const u16* VT = (const u16*)(p->ws + OFF_AR + AR_NA_VT);
  u16* O = (u16*)(p->ws + OFF_AR + AR_NA_O);
  const int tid = get_tid(), wid = tid >> 6, lane = tid & 63, r32 = lane & 31, hi = lane >> 5;
  float* rpbl = (float*)smem + wid * 640 + 64;
  u16* Kb = (u16*)(smem + 24576) + wid * 4864;
  u16* Vb = Kb + 32 * 72;
  constexpr float C1 = 0.125f * LOG2E;
  const int nrows = 64 + (want_ctx ? 4 : 0);
  for (int item = get_bid(); item < NB * nrows * 2; item += get_gdim()) {
    int hh, rr, b;
    if (item < NB * 64 * 2) { hh = item & 1; rr = (item >> 1) & 63; b = item >> 7; }
    else { const int ci = item - NB * 64 * 2; hh = ci & 1; rr = 64 + ((ci >> 1) & 3); b = ci >> 3; }
    const int h = hh * 8 + wid;
    const bool isctx = rr >= 64;
    const int r = isctx ? 0 : rr;
    for (int e = lane; e < 465; e += 64) rpbl[e] = p->na_rpb[h * 465 + e] * LOG2E;
    const int r0 = min(max(r - 4, 0), 56);
    const size_t qrow0 = (size_t)b * TB + (isctx ? SEQ + (rr - 64) * 64 : r * 64);
    v8s qf[2][4];
#pragma unroll
    for (int qb = 0; qb < 2; ++qb)
#pragma unroll
      for (int ks = 0; ks < 4; ++ks) qf[qb][ks] = *(const v8s*)(QK + (qrow0 + qb * 32 + r32) * 2048 + h * 64 + ks * 16 + hi * 8);
    v16f o[2][2];
#pragma unroll
    for (int a = 0; a < 2; ++a)
#pragma unroll
      for (int c = 0; c < 2; ++c) o[a][c] = v16f{};
    float m_run[2] = {-1e30f, -1e30f}, l_run[2] = {0.f, 0.f};
    v8s kreg[4], vreg[4];
#define NA_KEYROW(tt) ((size_t)b * TB + ((tt) < 16 ? (r0 + ((tt) >> 1)) * 64 + ((tt) & 1) * 32 : SEQ + ((tt) - 16) * 32))
#define NA_GLOAD_K(tt) do { const size_t _kr0 = NA_KEYROW(tt); \
      _Pragma("unroll") for (int i = 0; i < 4; ++i) kreg[i] = *(const v8s*)(QK + (_kr0 + (lane >> 3) + 8 * i) * 2048 + 1024 + h * 64 + (lane & 7) * 8); } while (0)
#define NA_GLOAD_V(tt) do { const size_t _kr0 = NA_KEYROW(tt); \
      _Pragma("unroll") for (int i = 0; i < 4; ++i) vreg[i] = *(const v8s*)(VT + (size_t)(h * 64 + (lane >> 2) + 16 * i) * M + _kr0 + (lane & 3) * 8); } while (0)
    NA_GLOAD_K(isctx ? 16 : 0); NA_GLOAD_V(isctx ? 16 : 0);
    for (int t = isctx ? 16 : 0; t < 24; ++t) {
      const bool local = t < 16; const int j = t >> 1, hf = t & 1;
#pragma unroll
      for (int i = 0; i < 4; ++i) {
        *(v8s*)(Kb + ((lane >> 3) + 8 * i) * 72 + (lane & 7) * 8) = kreg[i];
        *(v8s*)(Vb + ((lane >> 2) + 16 * i) * 40 + (lane & 3) * 8) = vreg[i];
      }
      if (t + 1 < 24) { NA_GLOAD_K(t + 1); NA_GLOAD_V(t + 1); }
      v8s kf[4];
#pragma unroll
      for (int ks = 0; ks < 4; ++ks) kf[ks] = *(const v8s*)(Kb + r32 * 72 + ks * 16 + hi * 8);
      v8s pf[2][2];
      v16f sc2[2];
#pragma unroll
      for (int qb = 0; qb < 2; ++qb) {
        sc2[qb] = v16f{};
#pragma unroll
        for (int ks = 0; ks < 4; ++ks) sc2[qb] = __builtin_amdgcn_mfma_f32_32x32x16_bf16(kf[ks], qf[qb][ks], sc2[qb], 0, 0, 0);
      }
#pragma unroll
      for (int qb = 0; qb < 2; ++qb) {
        v16f scq = sc2[qb];
        const int c = qb * 32 + r32; const int cs = min(max(c - 8, 0), 48);
        float mx = -3e38f;
        if (local) {
          const float* bp = rpbl + (r0 + j - r + 7) * 31 + (hf * 32 + 4 * hi - c + 15);
          const int vlo = hf * 32 + 4 * hi - cs;
#pragma unroll
          for (int hb = 0; hb < 2; ++hb) {
            float bv[8];
#pragma unroll
            for (int i = 0; i < 8; ++i) bv[i] = bp[8 * (2 * hb + (i >> 2)) + (i & 3)];
            asm volatile("" : "+v"(bv[0]), "+v"(bv[1]), "+v"(bv[2]), "+v"(bv[3]), "+v"(bv[4]), "+v"(bv[5]), "+v"(bv[6]), "+v"(bv[7]));
#pragma unroll
            for (int i = 0; i < 8; ++i) {
              const int K_i = 8 * (2 * hb + (i >> 2)) + (i & 3);
              const bool valid = (unsigned)(vlo + K_i) < 16u;
              const float s = valid ? fmaf(scq[8 * hb + i], C1, bv[i]) : -3e38f;
              scq[8 * hb + i] = s; mx = fmaxf(mx, s);
            }
          }
        } else {
#pragma unroll
          for (int i = 0; i < 16; ++i) { const float s = scq[i] * C1; scq[i] = s; mx = fmaxf(mx, s); }
        }
        mx = fmaxf(mx, __shfl_xor(mx, 32));
        const float mnew = fmaxf(m_run[qb], mx);
        const float alpha = __builtin_amdgcn_exp2f(m_run[qb] - mnew);
        m_run[qb] = mnew;
        float ps = 0.f;
#pragma unroll
        for (int i = 0; i < 16; ++i) { const float e = __builtin_amdgcn_exp2f(scq[i] - mnew); scq[i] = e; ps += e; }
        ps += __shfl_xor(ps, 32);
        l_run[qb] = l_run[qb] * alpha + ps;
#pragma unroll
        for (int db = 0; db < 2; ++db)
#pragma unroll
          for (int i = 0; i < 16; ++i) o[db][qb][i] *= alpha;
#pragma unroll
        for (int s = 0; s < 2; ++s) {
          v4u w; w.x = cvtpk(scq[8 * s + 0], scq[8 * s + 1]); w.y = cvtpk(scq[8 * s + 2], scq[8 * s + 3]);
          w.z = cvtpk(scq[8 * s + 4], scq[8 * s + 5]); w.w = cvtpk(scq[8 * s + 6], scq[8 * s + 7]);
          pf[qb][s] = *reinterpret_cast<v8s*>(&w);
        }
      }
      v8s vf[2][2];
#pragma unroll
      for (int db = 0; db < 2; ++db)
#pragma unroll
        for (int s = 0; s < 2; ++s) {
          const u16* vp = Vb + (db * 32 + r32) * 40 + 16 * s + 4 * hi;
          const v4s lo = *(const v4s*)vp, hi4 = *(const v4s*)(vp + 8);
          vf[db][s] = (v8s){lo[0], lo[1], lo[2], lo[3], hi4[0], hi4[1], hi4[2], hi4[3]};
        }
#pragma unroll
      for (int db = 0; db < 2; ++db)
#pragma unroll
        for (int qb = 0; qb < 2; ++qb)
#pragma unroll
          for (int s = 0; s < 2; ++s) o[db][qb] = __builtin_amdgcn_mfma_f32_32x32x16_bf16(vf[db][s], pf[qb][s], o[db][qb], 0, 0, 0);
    }
#pragma unroll
    for (int qb = 0; qb < 2; ++qb) {
      const float rl = 1.0f / l_run[qb];
      u16* orow = O + (qrow0 + qb * 32 + r32) * 1024 + h * 64;
#pragma unroll
      for (int db = 0; db < 2; ++db)
#pragma unroll
        for (int g4 = 0; g4 < 4; ++g4) {
          v2u w; w.x = cvtpk(o[db][qb][4 * g4 + 0] * rl, o[db][qb][4 * g4 + 1] * rl); w.y = cvtpk(o[db][qb][4 * g4 + 2] * rl, o[db][qb][4 * g4 + 3] * rl);
          *(v2u*)(orow + db * 32 + 8 * g4 + 4 * hi) = w;
        }
    }
  }
}

__device__ __forceinline__ int scan_row(int b, int dir, int s) {
  const int t = s < CTXL ? (dir ? TB - 1 - s : SEQ + s) : (dir ? SEQ - 1 - (s - CTXL) : s - CTXL);
  return b * TB + t;
}
__device__ __forceinline__ float dot4(v4f a, v4f b) { return (a[0] * b[0] + a[1] * b[1]) + (a[2] * b[2] + a[3] * b[3]); }

__device__ void rwkv_scan(PP p, unsigned char* smem, int slot) {
  constexpr int T = 32, NCH = TB / T;
  float* VEC = (float*)smem; float* VV = (float*)(smem + 40960); float* SC = (float*)(smem + 49152); float* YB = (float*)(smem + 49408); float* TMP = (float*)(smem + 57600);
  const int tid = get_tid(), wid = tid >> 6, lane = tid & 63;
  const u16* Rg = (const u16*)(p->ws + OFF_AR + AR_R); const u16* Kg = (const u16*)(p->ws + OFF_AR + AR_K); const u16* Vg = (const u16*)(p->ws + OFF_AR + AR_V);
  const u16* L1 = (const u16*)(p->ws + OFF_AR + AR_L1);
  float* BON = (float*)(p->ws + OFF_BON);
  for (int item = get_bid(); item < 256; item += get_gdim()) {
    const int dir = item >> 7, b = (item >> 4) & 7, h = item & 15;
    u16* Yd = (u16*)(p->ws + OFF_AR + (dir ? AR_Y1 : AR_Y0));
    const int st = tid >> 4, c0 = (tid & 15) * 4, ch = h * 64 + c0;
    const v4f w0 = *(const v4f*)(p->rw_w0 + (size_t)(slot * 2 + dir) * 1024 + ch), a0 = *(const v4f*)(p->rw_a0 + (size_t)(slot * 2 + dir) * 1024 + ch);
    const v4f kkc = *(const v4f*)(p->rw_kk + (size_t)slot * 1024 + ch), kac = *(const v4f*)(p->rw_ka + (size_t)slot * 1024 + ch), rkc = *(const v4f*)(p->rw_rk + (size_t)slot * 1024 + ch);
    const int qn = wid >> 2, rb = (wid >> 1) & 1, cbp = wid & 1, l16 = lane & 15, lq = lane >> 4;
    const u16* WT = (const u16*)(p->ws + OFF_WB + (qn ? WB_RW_A2T : WB_RW_W2T)) + ((size_t)dir * 1024 + h * 64) * 64;
    v8s bfr[2][2];
#pragma unroll
    for (int cb = 0; cb < 2; ++cb)
#pragma unroll
      for (int ks = 0; ks < 2; ++ks) bfr[cb][ks] = *(const v8s*)(WT + (size_t)((cbp * 2 + cb) * 16 + l16) * 64 + ks * 32 + lq * 8);
    v4f S0 = {0.f, 0.f, 0.f, 0.f}, S1 = {0.f, 0.f, 0.f, 0.f};
    const int i0 = 8 * wid + 2 * (lane >> 4);
    v2u pr_r, pr_k, pr_v; v8s pa[2];
#define RW_PREFETCH(cc) do { const int _row = scan_row(b, dir, (cc) * T + st); \
      pr_r = *(const v2u*)(Rg + (size_t)_row * 1024 + ch); pr_k = *(const v2u*)(Kg + (size_t)_row * 1024 + ch); pr_v = *(const v2u*)(Vg + (size_t)_row * 1024 + ch); \
      const int _rowA = scan_row(b, dir, (cc) * T + rb * 16 + l16); \
      pa[0] = *(const v8s*)(L1 + (size_t)_rowA * 384 + qn * 128 + dir * 64 + lq * 8); pa[1] = *(const v8s*)(L1 + (size_t)_rowA * 384 + qn * 128 + dir * 64 + 32 + lq * 8); } while (0)
    RW_PREFETCH(0);
    for (int c = 0; c < NCH; ++c) {
      const int cur_row = scan_row(b, dir, c * T + st);
#pragma unroll
      for (int cb = 0; cb < 2; ++cb) {
        v4f acc = {0.f, 0.f, 0.f, 0.f};
        acc = __builtin_amdgcn_mfma_f32_16x16x32_bf16(pa[0], bfr[cb][0], acc, 0, 0, 0);
        acc = __builtin_amdgcn_mfma_f32_16x16x32_bf16(pa[1], bfr[cb][1], acc, 0, 0, 0);
#pragma unroll
        for (int jj = 0; jj < 4; ++jj) TMP[(qn * T + rb * 16 + lq * 4 + jj) * 64 + (cbp * 2 + cb) * 16 + l16] = acc[jj];
      }
      __syncthreads();
      {
        const v4f wp = *(const v4f*)(TMP + st * 64 + c0) + w0, ap = *(const v4f*)(TMP + (T + st) * 64 + c0) + a0;
        v4f r, k, v, dec, a, kkr;
        r[0] = bflo(pr_r.x); r[1] = bfhi(pr_r.x); r[2] = bflo(pr_r.y); r[3] = bfhi(pr_r.y);
        k[0] = bflo(pr_k.x); k[1] = bfhi(pr_k.x); k[2] = bflo(pr_k.y); k[3] = bfhi(pr_k.y);
        v[0] = bflo(pr_v.x); v[1] = bfhi(pr_v.x); v[2] = bflo(pr_v.y); v[3] = bfhi(pr_v.y);
#pragma unroll
        for (int e = 0; e < 4; ++e) {
          const float z = -wp[e];
          const float sp = z > 20.f ? z : log1pf(__expf(z));
          dec[e] = __expf(-__expf(-sp - 0.5f));
          a[e] = 1.f / (1.f + __expf(-ap[e]));
          kkr[e] = k[e] * kkc[e];
        }
        const float ss = row_sum16(dot4(kkr, kkr));
        const float rn = 1.0f / sqrtf(fmaxf(ss, 1e-12f));
        const v4f kk = kkr * rn;
        const v4f kd = k * ((a - 1.f) * kac + 1.f);
        const v4f bv = kk * a;
        const float br = row_sum16(dot4(bv, r)), kr = row_sum16(dot4(kd, r)), bon = row_sum16(dot4(r * kd, rkc));
        float* vb = VEC + st * 320 + c0;
        *(v4f*)(vb) = -kk; *(v4f*)(vb + 64) = dec * r; *(v4f*)(vb + 128) = dec; *(v4f*)(vb + 192) = bv; *(v4f*)(vb + 256) = kd;
        *(v4f*)(VV + st * 64 + c0) = v;
        if ((tid & 15) == 0) { SC[st * 2] = br; SC[st * 2 + 1] = kr; BON[((size_t)dir * M + cur_row) * 16 + h] = bon; }
      }
      __syncthreads();
      if (c + 1 < NCH) RW_PREFETCH(c + 1);
      for (int s = 0; s < T; ++s) {
        const float* vb = VEC + s * 320 + (lane & 15) * 4;
        const v4f a4 = *(const v4f*)(vb), wr4 = *(const v4f*)(vb + 64), w4 = *(const v4f*)(vb + 128), b4 = *(const v4f*)(vb + 192), k4 = *(const v4f*)(vb + 256);
        const v2f v2 = *(const v2f*)(VV + s * 64 + i0), sc2 = *(const v2f*)(SC + s * 2);
        float p0 = dot4(S0, a4), p1 = dot4(S1, a4), y0 = dot4(S0, wr4), y1 = dot4(S1, wr4);
        p0 = row_sum16(p0); p1 = row_sum16(p1); y0 = row_sum16(y0); y1 = row_sum16(y1);
        y0 += p0 * sc2.x + v2.x * sc2.y; y1 += p1 * sc2.x + v2.y * sc2.y;
        S0 = S0 * w4 + b4 * p0 + k4 * v2.x; S1 = S1 * w4 + b4 * p1 + k4 * v2.y;
        if ((lane & 15) == 0) *(v2f*)(YB + s * 64 + i0) = (v2f){y0, y1};
      }
      __syncthreads();
      {
        const v4f y4 = *(const v4f*)(YB + st * 64 + c0);
        v2u w; w.x = cvtpk(y4[0], y4[1]); w.y = cvtpk(y4[2], y4[3]);
        *(v2u*)(Yd + (size_t)cur_row * 1024 + ch) = w;
      }
    }
#undef RW_PREFETCH
    __syncthreads();
  }
}

#define LBAR() do { asm volatile("s_waitcnt lgkmcnt(0)" ::: "memory"); __builtin_amdgcn_s_barrier(); asm volatile("" ::: "memory"); } while (0)
__device__ void rwkv_scan2(PP p, unsigned char* smem, int slot) {
  constexpr int T = 32, NCH = TB / T;
  float* TMP = (float*)(smem);
  float* LW  = (float*)(smem + 16384);
  float* YB  = (float*)(smem + 24576);
  u16* AT = (u16*)(smem + 32768);
  u16* RT = (u16*)(smem + 32768 + 4608);
  u16* BT = (u16*)(smem + 32768 + 2 * 4608);
  u16* KT = (u16*)(smem + 32768 + 3 * 4608);
  u16* BKT = (u16*)(smem + 51200);
  float* GC = (float*)(smem + 69632);
  unsigned char* UBLK = smem + 107520;
  float* P1 = (float*)(smem + 73728);
  u16* CV = (u16*)(smem + 78848);
  u16* SB = (u16*)(smem + 89088);
  const int x_tid = get_tid();
  const u16* Rg = (const u16*)(p->ws + OFF_AR + AR_R); const u16* Kg = (const u16*)(p->ws + OFF_AR + AR_K); const u16* Vg = (const u16*)(p->ws + OFF_AR + AR_V);
  const u16* L1 = (const u16*)(p->ws + OFF_AR + AR_L1);
  float* BON = (float*)(p->ws + OFF_BON);
  for (int item = get_bid(); item < 256; item += get_gdim()) {
    const int dir = item >> 7, b = (item >> 4) & 7, h = item & 15;
    u16* Yd = (u16*)(p->ws + OFF_AR + (dir ? AR_Y1 : AR_Y0));
#define OPQV(v) ({ int _t = (v); asm volatile("" : "+v"(_t)); _t; })
    const int x_wid = __builtin_amdgcn_readfirstlane(x_tid >> 6);
    int tid = x_tid, wid = x_wid, lane = tid & 63;
    int st = tid >> 4, c0 = (tid & 15) * 4, ch = h * 64 + c0, su = st >> 4, tt = st & 15;
    const v4f w0 = *(const v4f*)(p->rw_w0 + (size_t)(slot * 2 + dir) * 1024 + ch), a0 = *(const v4f*)(p->rw_a0 + (size_t)(slot * 2 + dir) * 1024 + ch);
    const v4f kkc = *(const v4f*)(p->rw_kk + (size_t)slot * 1024 + ch), kac = *(const v4f*)(p->rw_ka + (size_t)slot * 1024 + ch), rkc = *(const v4f*)(p->rw_rk + (size_t)slot * 1024 + ch);
    int qn = wid >> 2, rb_ = (wid >> 1) & 1, cbp = wid & 1, l16 = lane & 15, lq = lane >> 4;
    const u16* WT = (const u16*)(p->ws + OFF_WB + (qn ? WB_RW_A2T : WB_RW_W2T)) + ((size_t)dir * 1024 + h * 64) * 64;
    v8s bfr[2][2];
#pragma unroll
    for (int cb = 0; cb < 2; ++cb)
#pragma unroll
      for (int ks = 0; ks < 2; ++ks) bfr[cb][ks] = *(const v8s*)(WT + (size_t)((cbp * 2 + cb) * 16 + l16) * 64 + ks * 32 + lq * 8);
    v4f S[2]; S[0] = (v4f){0.f, 0.f, 0.f, 0.f}; S[1] = (v4f){0.f, 0.f, 0.f, 0.f};
    for (int e = tid; e < 64 * 72; e += 512) SB[e] = 0;
    for (int e = tid; e < 2 * 64 * 40; e += 512) CV[e] = 0;
    for (int e = tid; e < 2 * 16 * 40; e += 512) { const int uu = e / 640, r = e - uu * 640; ((u16*)(UBLK + uu * 3584 + 1024))[r] = 0; }
    v2u pr_r, pr_k, pr_v; v8s pa[2];
#define RW_PREFETCH(cc) do { const int _row = scan_row(b, dir, (cc) * T + st); \
      pr_r = *(const v2u*)(Rg + (size_t)_row * 1024 + ch); pr_k = *(const v2u*)(Kg + (size_t)_row * 1024 + ch); pr_v = *(const v2u*)(Vg + (size_t)_row * 1024 + ch); \
      const int _rowA = scan_row(b, dir, (cc) * T + rb_ * 16 + l16); \
      pa[0] = *(const v8s*)(L1 + (size_t)_rowA * 384 + qn * 128 + dir * 64 + lq * 8); pa[1] = *(const v8s*)(L1 + (size_t)_rowA * 384 + qn * 128 + dir * 64 + 32 + lq * 8); } while (0)
    RW_PREFETCH(0);
    for (int c = 0; c < NCH; ++c) {
      tid = OPQV(x_tid); lane = tid & 63; st = tid >> 4; c0 = (tid & 15) * 4; ch = h * 64 + c0; su = st >> 4; tt = st & 15; l16 = lane & 15; lq = lane >> 4;
      const int cur_row = scan_row(b, dir, c * T + st);
#pragma unroll
      for (int cb = 0; cb < 2; ++cb) {
        v4f acc = {0.f, 0.f, 0.f, 0.f};
        acc = __builtin_amdgcn_mfma_f32_16x16x32_bf16(pa[0], bfr[cb][0], acc, 0, 0, 0);
        acc = __builtin_amdgcn_mfma_f32_16x16x32_bf16(pa[1], bfr[cb][1], acc, 0, 0, 0);
#pragma unroll
        for (int jj = 0; jj < 4; ++jj) TMP[(qn * T + rb_ * 16 + lq * 4 + jj) * 64 + (cbp * 2 + cb) * 16 + l16] = acc[jj];
      }
      LBAR();
      v4f r, k, v, lwv, a, kkr;
      {
        const v4f wp = *(const v4f*)(TMP + st * 64 + c0) + w0, ap = *(const v4f*)(TMP + (T + st) * 64 + c0) + a0;
        r[0] = bflo(pr_r.x); r[1] = bfhi(pr_r.x); r[2] = bflo(pr_r.y); r[3] = bfhi(pr_r.y);
        k[0] = bflo(pr_k.x); k[1] = bfhi(pr_k.x); k[2] = bflo(pr_k.y); k[3] = bfhi(pr_k.y);
        v[0] = bflo(pr_v.x); v[1] = bfhi(pr_v.x); v[2] = bflo(pr_v.y); v[3] = bfhi(pr_v.y);
#pragma unroll
        for (int e = 0; e < 4; ++e) {
          const float z = -wp[e];
          const float sp = fmaxf(z, 0.f) + __logf(1.f + __expf(-fabsf(z)));
          lwv[e] = -__expf(-sp - 0.5f);
          a[e] = __builtin_amdgcn_rcpf(1.f + __expf(-ap[e]));
          kkr[e] = k[e] * kkc[e];
        }
        *(v4f*)(LW + st * 64 + c0) = lwv;
      }
      if (c + 1 < NCH) RW_PREFETCH(c + 1);
      LBAR();
      {
        const int pu = wid >> 2, pj = wid & 3;
        v4f acc = {0.f, 0.f, 0.f, 0.f};
#pragma unroll
        for (int ks = 0; ks < 4; ++ks) {
          const int s = 4 * ks + lq;
          const float av = (s <= l16) ? 1.f : 0.f;
          const float bv_ = LW[(pu * 16 + s) * 64 + 16 * pj + l16];
          acc = __builtin_amdgcn_mfma_f32_16x16x4f32(av, bv_, acc, 0, 0, 0);
        }
#pragma unroll
        for (int jj = 0; jj < 4; ++jj) TMP[(pu * 16 + 4 * lq + jj) * 64 + 16 * pj + l16] = acc[jj];
      }
      LBAR();
      {
        const float ss = row_sum16(dot4(kkr, kkr));
        const float rn = __builtin_amdgcn_rsqf(fmaxf(ss, 1e-12f));
        const v4f kk = kkr * rn;
        const v4f kd = k * ((a - 1.f) * kac + 1.f);
        const v4f bv = kk * a;
        const float bon = row_sum16(dot4(r * kd, rkc));
        const v4f ci = *(const v4f*)(TMP + st * 64 + c0);
        const v4f ce = ci - lwv;
        v4f eci, ece, eni;
#pragma unroll
        for (int e = 0; e < 4; ++e) { eci[e] = __expf(ci[e]); ece[e] = __expf(ce[e]); eni[e] = __builtin_amdgcn_rcpf(eci[e]); }
        const v4f at = -kk * ece, rt = r * eci, bt = bv * eni, kt = kd * eni;
        const int ro = (su * 16 + tt) * 72 + c0;
        { v2u w; w.x = cvtpk(at[0], at[1]); w.y = cvtpk(at[2], at[3]); *(v2u*)(AT + ro) = w; }
        { v2u w; w.x = cvtpk(rt[0], rt[1]); w.y = cvtpk(rt[2], rt[3]); *(v2u*)(RT + ro) = w; }
        { v2u w; w.x = cvtpk(bt[0], bt[1]); w.y = cvtpk(bt[2], bt[3]); *(v2u*)(BT + ro) = w; }
        { v2u w; w.x = cvtpk(kt[0], kt[1]); w.y = cvtpk(kt[2], kt[3]); *(v2u*)(KT + ro) = w; }
#pragma unroll
        for (int e = 0; e < 4; ++e) {
          u16* bk = BKT + (su * 64 + c0 + e) * 40 + tt;
          bk[0] = (u16)(cvtpk(bt[e], bt[e]) & 0xffffu); bk[16] = (u16)(cvtpk(kt[e], kt[e]) & 0xffffu);
          CV[(su * 64 + c0 + e) * 40 + 16 + tt] = (u16)(cvtpk(v[e], v[e]) & 0xffffu);
        }
        if (tt == 15) *(v4f*)(GC + su * 64 + c0) = eci;
        if ((tid & 15) == 0) BON[((size_t)dir * M + cur_row) * 16 + h] = bon;
      }
      LBAR();
      {
        const int uu = wid >> 2, q = wid & 3;
        const u16* Am = (q & 1) ? KT : BT; const u16* Bm = (q & 2) ? RT : AT;
        v4f acc = {0.f, 0.f, 0.f, 0.f};
#pragma unroll
        for (int ks = 0; ks < 2; ++ks) {
          const v8s A = *(const v8s*)(Am + (uu * 16 + l16) * 72 + ks * 32 + lq * 8);
          const v8s B = *(const v8s*)(Bm + (uu * 16 + l16) * 72 + ks * 32 + lq * 8);
          acc = __builtin_amdgcn_mfma_f32_16x16x32_bf16(A, B, acc, 0, 0, 0);
        }
        float* UBTw = (float*)(UBLK + uu * 3584); u16* UKBw = (u16*)(UBLK + uu * 3584 + 1024); u16* WBKTw = (u16*)(UBLK + uu * 3584 + 2304);
#pragma unroll
        for (int jj = 0; jj < 4; ++jj) {
          const int s = 4 * lq + jj, t = l16;
          if (q == 0) UBTw[t * 16 + (s & 3) * 4 + (s >> 2)] = (s < t) ? acc[jj] : 0.f;
          else if (q == 1) { const float val = (s < t) ? acc[jj] : 0.f; UKBw[t * 40 + 16 + s] = (u16)(cvtpk(val, val) & 0xffffu); }
          else { const float val = (s <= t) ? acc[jj] : 0.f; WBKTw[t * 40 + (q == 3 ? 16 : 0) + s] = (u16)(cvtpk(val, val) & 0xffffu); }
        }
      }
      LBAR();
#pragma unroll
      for (int u = 0; u < 2; ++u) {
        lane = OPQV(x_tid) & 63; l16 = lane & 15; lq = lane >> 4;
        const int rbuf = u, wbuf = u ^ 1;
        float* UBT = (float*)(UBLK + u * 3584); u16* UKB = (u16*)(UBLK + u * 3584 + 1024); u16* WBKT = (u16*)(UBLK + u * 3584 + 2304);
        if (wid < 4) {
          v8s As0 = *(const v8s*)(SB + (rbuf * 64 + 16 * wid + l16) * 72 + lq * 8);
          v8s As1 = *(const v8s*)(SB + (rbuf * 64 + 16 * wid + l16) * 72 + 32 + lq * 8);
          v8s Ba0 = *(const v8s*)(AT + (u * 16 + l16) * 72 + lq * 8);
          v8s Ba1 = *(const v8s*)(AT + (u * 16 + l16) * 72 + 32 + lq * 8);
          v8s A2 = *(const v8s*)(CV + (u * 64 + 16 * wid + l16) * 40 + lq * 8);
          v8s B2 = *(const v8s*)(UKB + l16 * 40 + lq * 8);
          asm volatile("" : "+v"(As0), "+v"(As1), "+v"(Ba0), "+v"(Ba1), "+v"(A2), "+v"(B2));
          v4f accp = {0.f, 0.f, 0.f, 0.f};
          accp = __builtin_amdgcn_mfma_f32_16x16x32_bf16(As0, Ba0, accp, 0, 0, 0);
          accp = __builtin_amdgcn_mfma_f32_16x16x32_bf16(As1, Ba1, accp, 0, 0, 0);
          accp = __builtin_amdgcn_mfma_f32_16x16x32_bf16(A2, B2, accp, 0, 0, 0);
#pragma unroll
          for (int jj = 0; jj < 4; ++jj) P1[(16 * wid + 4 * lq + jj) * 20 + l16] = accp[jj];
        }
        LBAR();
        if (wid < 4) {
          const int gq = lane & 3, irow = 16 * wid + (lane >> 2);
          float p1v[16];
#pragma unroll
          for (int q4 = 0; q4 < 4; ++q4) { const v4f x = *(const v4f*)(P1 + irow * 20 + q4 * 4); p1v[q4 * 4] = x[0]; p1v[q4 * 4 + 1] = x[1]; p1v[q4 * 4 + 2] = x[2]; p1v[q4 * 4 + 3] = x[3]; }
          float cf[16]; float my0 = 0.f, my1 = 0.f, my2 = 0.f, my3 = 0.f;
          cf[0] = p1v[0]; my0 = (gq == 0) ? cf[0] : 0.f;
          v4f ubv[16];
#pragma unroll
          for (int t = 1; t < 16; ++t) ubv[t] = *(const v4f*)(UBT + t * 16 + gq * 4);
#pragma unroll
          for (int t = 1; t < 16; ++t) asm volatile("" : "+v"(ubv[t]));
#pragma unroll
          for (int t = 1; t < 16; ++t) {
            const v4f ub = ubv[t];
            const int kc = (t - 1) >> 2;
            float part = (gq == 0) ? p1v[t] : 0.f;
            if (kc != 0) part += my0 * ub[0];
            if (t > 4 && kc != 1) part += my1 * ub[1];
            if (t > 8 && kc != 2) part += my2 * ub[2];
            if (t > 12 && kc != 3) part += my3 * ub[3];
            part += (kc == 0 ? my0 : kc == 1 ? my1 : kc == 2 ? my2 : my3) * ub[kc];
            part += dppf<0xB1>(part); part += dppf<0x4E>(part);
            cf[t] = part;
            const bool mine = gq == (t & 3);
            if ((t >> 2) == 0) my0 = mine ? part : my0;
            else if ((t >> 2) == 1) my1 = mine ? part : my1;
            else if ((t >> 2) == 2) my2 = mine ? part : my2;
            else my3 = mine ? part : my3;
          }
          if (gq == 0) {
            v4u w0_, w1_;
            w0_.x = cvtpk(cf[0], cf[1]); w0_.y = cvtpk(cf[2], cf[3]); w0_.z = cvtpk(cf[4], cf[5]); w0_.w = cvtpk(cf[6], cf[7]);
            w1_.x = cvtpk(cf[8], cf[9]); w1_.y = cvtpk(cf[10], cf[11]); w1_.z = cvtpk(cf[12], cf[13]); w1_.w = cvtpk(cf[14], cf[15]);
            *(v4u*)(CV + (u * 64 + irow) * 40) = w0_; *(v4u*)(CV + (u * 64 + irow) * 40 + 8) = w1_;
          }
        }
        LBAR();
        {
          const int ib = wid >> 1, jb0 = 2 * (wid & 1);
          v8s Acv = *(const v8s*)(CV + (u * 64 + 16 * ib + l16) * 40 + lq * 8);
          v8s Bk0 = *(const v8s*)(BKT + (u * 64 + 16 * jb0 + l16) * 40 + lq * 8);
          v8s Bk1 = *(const v8s*)(BKT + (u * 64 + 16 * (jb0 + 1) + l16) * 40 + lq * 8);
          float gc0 = GC[u * 64 + 16 * jb0 + l16], gc1 = GC[u * 64 + 16 * (jb0 + 1) + l16];
          if (wid < 4) {
            v8s As0 = *(const v8s*)(SB + (rbuf * 64 + 16 * wid + l16) * 72 + lq * 8);
            v8s As1 = *(const v8s*)(SB + (rbuf * 64 + 16 * wid + l16) * 72 + 32 + lq * 8);
            v8s Br0 = *(const v8s*)(RT + (u * 16 + l16) * 72 + lq * 8);
            v8s Br1 = *(const v8s*)(RT + (u * 16 + l16) * 72 + 32 + lq * 8);
            v8s A2 = *(const v8s*)(CV + (u * 64 + 16 * wid + l16) * 40 + lq * 8);
            v8s B2 = *(const v8s*)(WBKT + l16 * 40 + lq * 8);
            asm volatile("" : "+v"(As0), "+v"(As1), "+v"(Br0), "+v"(Br1), "+v"(A2), "+v"(B2), "+v"(Acv), "+v"(Bk0), "+v"(Bk1), "+v"(gc0), "+v"(gc1));
            v4f acc = {0.f, 0.f, 0.f, 0.f};
            acc = __builtin_amdgcn_mfma_f32_16x16x32_bf16(As0, Br0, acc, 0, 0, 0);
            acc = __builtin_amdgcn_mfma_f32_16x16x32_bf16(As1, Br1, acc, 0, 0, 0);
            acc = __builtin_amdgcn_mfma_f32_16x16x32_bf16(A2, B2, acc, 0, 0, 0);
#pragma unroll
            for (int jj = 0; jj < 4; ++jj) YB[(u * 16 + l16) * 64 + 16 * wid + 4 * lq + jj] = acc[jj];
          } else {
            asm volatile("" : "+v"(Acv), "+v"(Bk0), "+v"(Bk1), "+v"(gc0), "+v"(gc1));
          }
          S[0] = __builtin_amdgcn_mfma_f32_16x16x32_bf16(Acv, Bk0, S[0], 0, 0, 0);
          S[1] = __builtin_amdgcn_mfma_f32_16x16x32_bf16(Acv, Bk1, S[1], 0, 0, 0);
          S[0] = S[0] * gc0; S[1] = S[1] * gc1;
#pragma unroll
          for (int bb = 0; bb < 2; ++bb)
#pragma unroll
            for (int jj = 0; jj < 4; ++jj) SB[(wbuf * 64 + 16 * ib + 4 * lq + jj) * 72 + 16 * (jb0 + bb) + l16] = (u16)(cvtpk(S[bb][jj], S[bb][jj]) & 0xffffu);
        }
        LBAR();
      }
      {
        const v4f y4 = *(const v4f*)(YB + st * 64 + c0);
        v2u w; w.x = cvtpk(y4[0], y4[1]); w.y = cvtpk(y4[2], y4[3]);
        *(v2u*)(Yd + (size_t)cur_row * 1024 + ch) = w;
      }
    }
#undef RW_PREFETCH
    __syncthreads();
  }
}

__device__ __forceinline__ float row_sum8(float v) { v += dppf<0xB1>(v); v += dppf<0x4E>(v); v += dppf<0x141>(v); return v; }
__device__ void rwkv_outprep(PP p, int slot) {
  const u16* Y0 = (const u16*)(p->ws + OFF_AR + AR_Y0); const u16* Y1 = (const u16*)(p->ws + OFF_AR + AR_Y1);
  const u16* Vg = (const u16*)(p->ws + OFF_AR + AR_V); const u16* Gg = (const u16*)(p->ws + OFF_AR + AR_G);
  u16* YG = (u16*)(p->ws + OFF_AR + AR_YG);
  const float* BON = (const float*)(p->ws + OFF_BON);
  for (int idx = get_bid() * 512 + get_tid(); idx < M * 128; idx += get_gdim() * 512) {
    const int row = idx >> 7, c0 = (idx & 127) * 8, h = c0 >> 6;
    const size_t off = (size_t)row * 1024 + c0;
    const v4u a = *(const v4u*)(Y0 + off), bq = *(const v4u*)(Y1 + off), vv = *(const v4u*)(Vg + off), gg = *(const v4u*)(Gg + off);
    float y[8];
#pragma unroll
    for (int j = 0; j < 4; ++j) { y[2 * j] = bflo(a[j]) + bflo(bq[j]); y[2 * j + 1] = bfhi(a[j]) + bfhi(bq[j]); }
    float s = 0.f;
#pragma unroll
    for (int j = 0; j < 8; ++j) s += y[j];
    const float mean = row_sum8(s) * (1.f / 64.f);
    float sq = 0.f;
#pragma unroll
    for (int j = 0; j < 8; ++j) { y[j] -= mean; sq += y[j] * y[j]; }
    const float rstd = 1.0f / sqrtf(row_sum8(sq) * (1.f / 64.f) + 64e-5f);
    const float bon = BON[(size_t)row * 16 + h] + BON[((size_t)M + row) * 16 + h];
    const v4f lg0 = *(const v4f*)(p->rw_lng + (size_t)slot * 1024 + c0), lg1 = *(const v4f*)(p->rw_lng + (size_t)slot * 1024 + c0 + 4);
    const v4f lb0 = *(const v4f*)(p->rw_lnb + (size_t)slot * 1024 + c0), lb1 = *(const v4f*)(p->rw_lnb + (size_t)slot * 1024 + c0 + 4);
    float o[8];
#pragma unroll
    for (int j = 0; j < 8; ++j) {
      const float lg = j < 4 ? lg0[j & 3] : lg1[j & 3], lb = j < 4 ? lb0[j & 3] : lb1[j & 3];
      const float v = (j & 1) ? bfhi(vv[j >> 1]) : bflo(vv[j >> 1]);
      const float g = (j & 1) ? bfhi(gg[j >> 1]) : bflo(gg[j >> 1]);
      o[j] = (y[j] * rstd * lg + lb + v * bon) * g;
    }
    v4u w; w.x = cvtpk(o[0], o[1]); w.y = cvtpk(o[2], o[3]); w.z = cvtpk(o[4], o[5]); w.w = cvtpk(o[6], o[7]);
    *(v4u*)(YG + off) = w;
  }
}

#define XB_TMO      128
#define XB_XCNT(j)  (256  + 64 * (j))
#define XB_XSUB(j)  (1280 + 64 * (j))
#define XB_XGEN(j)  (2304 + 64 * (j))
#define XB_TOP      3328
#define XB_TOPGEN   3392
#define XCD_BAR_WORDS 3456
#define XB_SPIN_CAP (1u << 23)
#ifndef LAS
#define LAS __attribute__((address_space(3)))
#endif

__device__ __forceinline__ unsigned xb_ld(unsigned* p)              { return __hip_atomic_load(p, __ATOMIC_RELAXED, __HIP_MEMORY_SCOPE_AGENT); }
__device__ __forceinline__ unsigned xb_add(unsigned* p, unsigned v) { return __hip_atomic_fetch_add(p, v, __ATOMIC_RELAXED, __HIP_MEMORY_SCOPE_AGENT); }
__device__ __forceinline__ unsigned xb_xcc_id() { return (unsigned)__builtin_amdgcn_s_getreg((3 << 11) | 20) & 0xFu; }
#define XB_SPIN(cond, bar) do { unsigned _sp = 0; while (cond) { __builtin_amdgcn_s_sleep(1); \
    if ((++_sp & 255u) == 0u) { if (xb_ld(&(bar)[XB_TMO])) break; if (_sp > XB_SPIN_CAP) { atomicAdd(&(bar)[XB_TMO], 1u); break; } } } } while (0)

struct XcdBarrier {
    unsigned* bar; unsigned x;
    volatile LAS unsigned* st;
};

__device__ __forceinline__ XcdBarrier xcd_barrier_post(unsigned* bar, volatile LAS unsigned* st) {
    XcdBarrier b; b.bar = bar; b.x = xb_xcc_id(); b.st = st;
    if (get_tid() == 0) (void)xb_add(&bar[XB_XCNT(b.x)], 1u);
    return b;
}
__device__ __forceinline__ void xcd_barrier_complete(unsigned* bar, unsigned x, unsigned& nloc, unsigned& nx) {
    const unsigned G = gridDim.x * gridDim.y * gridDim.z;
    unsigned sum, cnt, mine, sp = 0u;
    for (;;) {
        sum = 0u; cnt = 0u; mine = 0u;
#pragma unroll
        for (unsigned j = 0; j < 16; ++j) { const unsigned c = xb_ld(&bar[XB_XCNT(j)]); sum += c; cnt += (c > 0u) ? 1u : 0u; mine = (j == x) ? c : mine; }
        if (sum == G) break;
        __builtin_amdgcn_s_sleep(1);
        if ((++sp & 255u) == 0u) { if (xb_ld(&bar[XB_TMO])) break; if (sp > XB_SPIN_CAP) { atomicAdd(&bar[XB_TMO], 1u); break; } }
    }
    nloc = mine > 0u ? mine : 1u; nx = cnt > 0u ? cnt : 1u;
}

__device__ __forceinline__ void xcd_barrier(const XcdBarrier& b) {
    asm volatile("s_waitcnt vmcnt(0)" ::: "memory");
    __syncthreads();
    if (get_tid() == 0) {
        unsigned* bar = b.bar;
        __builtin_amdgcn_s_waitcnt(0);
        unsigned nloc = b.st[0], nx = b.st[1];
        if (nloc == 0u) { xcd_barrier_complete(bar, b.x, nloc, nx); b.st[0] = nloc; b.st[1] = nx; }
        const unsigned old = xb_add(&bar[XB_XSUB(b.x)], 1u);
        const unsigned gen = old / nloc;
        if (old + 1u == (gen + 1u) * nloc) {
            __builtin_amdgcn_fence(__ATOMIC_RELEASE, "agent");
            asm volatile("s_waitcnt vmcnt(0)" ::: "memory");
            const unsigned og = xb_add(&bar[XB_TOP], 1u);
            const unsigned tg = og / nx;
            if (og + 1u == (tg + 1u) * nx) xb_add(&bar[XB_TOPGEN], 1u);
            else XB_SPIN(xb_ld(&bar[XB_TOPGEN]) == tg, bar);
            __builtin_amdgcn_fence(__ATOMIC_ACQUIRE, "agent");
            xb_add(&bar[XB_XGEN(b.x)], 1u);
            asm volatile("s_waitcnt vmcnt(0)" ::: "memory");
        } else {
            XB_SPIN(xb_ld(&bar[XB_XGEN(b.x)]) == gen, bar);
            __builtin_amdgcn_fence(__ATOMIC_ACQUIRE, "agent");
            asm volatile("s_waitcnt vmcnt(0)" ::: "memory");
        }
    }
    __syncthreads();
}


enum { OP_MOD = 0, OP_ROWA, OP_XX, OP_QKV, OP_QKPREP, OP_ATTN, OP_NA, OP_RW1, OP_SCAN, OP_OUTPREP, OP_WO, OP_ROWE, OP_MLP1, OP_MLP2, OP_FINAL };
__device__ __forceinline__ void decode_phase(int ph, int& layer, int& op) {
  if (ph == 0) { layer = 0; op = OP_MOD; return; }
  if (ph >= 33) { layer = 3; op = OP_FINAL; return; }
  int s;
  if (ph < 9) { layer = 0; s = ph - 1; } else if (ph < 16) { layer = 1; s = ph - 9; } else if (ph < 25) { layer = 2; s = ph - 16; } else { layer = 3; s = ph - 25; }
  const int kind = layer % 3;
  if (kind == 0) { op = s == 0 ? OP_ROWA : s == 1 ? OP_QKV : s == 2 ? OP_QKPREP : s == 3 ? OP_ATTN : s == 4 ? OP_WO : s == 5 ? OP_ROWE : s == 6 ? OP_MLP1 : OP_MLP2; }
  else if (kind == 1) op = s == 0 ? OP_ROWA : s == 1 ? OP_QKV : s == 2 ? OP_NA : s == 3 ? OP_WO : s == 4 ? OP_ROWE : s == 5 ? OP_MLP1 : OP_MLP2;
  else op = s == 0 ? OP_ROWA : s == 1 ? OP_XX : s == 2 ? OP_RW1 : s == 3 ? OP_SCAN : s == 4 ? OP_OUTPREP : s == 5 ? OP_WO : s == 6 ? OP_ROWE : s == 7 ? OP_MLP1 : OP_MLP2;
}

__global__ void __launch_bounds__(512, 2) mega(P p_, int lo, int hi) {
  extern __shared__ __attribute__((aligned(16))) unsigned char smem[];
  cg::grid_group grid = cg::this_grid();
  volatile LAS unsigned* xst = (volatile LAS unsigned*)(smem + 131072 + 16);
  if (get_tid() == 0) { xst[0] = 0u; xst[1] = 0u; }
  __syncthreads();
  XcdBarrier xbar; xbar.bar = nullptr; xbar.x = 0; xbar.st = xst;
  if (hi - lo > 1) { PP pb = (PP)__builtin_amdgcn_kernarg_segment_ptr(); xbar = xcd_barrier_post((unsigned*)(pb->ws + OFF_BARW), xst); }
  if (lo == 0) {
    PP p0 = (PP)__builtin_amdgcn_kernarg_segment_ptr();
    asm volatile("" : "+s"(p0));
    phase_mod(p0, smem);
    if (hi > 1) grid.sync();
    lo = 1;
  }
  for (int ph = lo; ph < hi; ++ph) {
    PP p = (PP)__builtin_amdgcn_kernarg_segment_ptr();
    asm volatile("" : "+s"(p));
    unsigned char* AR = p->ws + OFF_AR;
    const float* MOD = (const float*)(p->ws + OFF_MOD);
    int layer, op; decode_phase(ph, layer, op);
#ifdef DUP_OP
    for (int rep = 0; rep < ((op == DUP_OP) ? 2 : 1); ++rep) {
#else
    {
#endif
    const int kind = layer % 3, slot = layer / 3;
    const bool want_ctx = layer < 3;
    if (op == OP_ROWA) {
      if (layer == 0) convert_layer_weights(p, layer, smem, get_bid(), get_gdim(), get_gdim() == 256 ? 2 : 7);
      if (layer == 0) rowpass(p, -1, layer, 0, (u16*)(AR + AR_H), 1024, false);
      else rowpass(p, (layer - 1) * 2 + 1, layer, 0, (u16*)(AR + AR_H), kind == 2 ? 2048 : 1024, false, false, 8, (const float*)(AR + AR_PART_MLP2), (layer - 1) * 2, MOD + (size_t)((layer - 1) * 9 + 8) * 6144 + 5 * 1024);
    }
    else if (op == OP_ROWE) {
      if (layer == 3) rowpass(p, layer * 2, layer, 3, (u16*)(AR + AR_H), 1024, false, true);
      else rowpass(p, layer * 2, layer, 3, (u16*)(AR + AR_H), 1024, false, false, 4, (const float*)(AR + AR_PART_WO), layer == 0 ? -1 : (layer - 1) * 2 + 1, MOD + (size_t)(layer * 9 + 8) * 6144 + 2 * 1024, layer == 0);
    }
    else if (op == OP_FINAL) rowpass(p, 7, 0, 0, nullptr, 0, true);
    else if (op == OP_XX) xx_pass(p);
    else if (op == OP_QKPREP) qk_prep(p, slot);
    else if (op == OP_ATTN) {
#ifndef NO_ATTN
      gqa_attention(p, smem, want_ctx, slot);
#endif
    }
    else if (op == OP_NA) {
#ifndef NO_NA
      na_attention(p, smem, want_ctx);
#endif
    }
    else if (op == OP_OUTPREP) rwkv_outprep(p, slot);
    else if (op == OP_RW1) {
      EpiRw1 E{(u16*)(AR + AR_R), (u16*)(AR + AR_L1)};
#ifndef NO_RW1
      run_gemm(smem, (const u16*)(AR + AR_H), (const u16*)(p->ws + OFF_WB + WB_MIX), M, 3584, 2048, E);
#endif
      if (get_gdim() == 256 && get_bid() >= 112) convert_layer_weights(p, layer, smem, get_bid() - 112, 144, 1);
    }
    else if (op == OP_QKV || op == OP_MLP1 || op == OP_SCAN) {
      int ng = 1;
      const u16 *A0, *B0, *A1 = nullptr, *B1 = nullptr; u16 *O0, *O1 = nullptr; int M0, N0, K0, L0, M1 = 0, N1 = 0, K1 = 0, L1_ = 0, act = 0, ld0 = 0;
      if (op == OP_MLP1) { A0 = (const u16*)(AR + AR_H); B0 = (const u16*)(p->ws + OFF_WB + WB_W1T); O0 = (u16*)(AR + AR_HID); M0 = M; N0 = 4096; K0 = 1024; L0 = 4096; act = 1; }
      else if (op == OP_SCAN) { A0 = (const u16*)(AR + AR_L1) + 128; B0 = (const u16*)(p->ws + OFF_WB + WB_RW_BG) + 128; O0 = (u16*)(AR + AR_G); M0 = M; N0 = 1024; K0 = 256; L0 = 1024; ld0 = 384; }
      else if (kind == 0) { A0 = (const u16*)(AR + AR_H); B0 = (const u16*)(p->ws + OFF_WB + WB_MIX); O0 = (u16*)(AR + AR_QKV); M0 = M; N0 = 1536; K0 = 1024; L0 = 1536; }
      else { A0 = (const u16*)(AR + AR_H); B0 = (const u16*)(p->ws + OFF_WB + WB_MIX); O0 = (u16*)(AR + AR_NA_QK); M0 = M; N0 = 2048; K0 = 1024; L0 = 2048;
             ng = 2; A1 = (const u16*)(p->ws + OFF_WB + WB_MIX) + (size_t)2048 * 1024; B1 = (const u16*)(AR + AR_H); O1 = (u16*)(AR + AR_NA_VT); M1 = 1024; N1 = M; K1 = 1024; L1_ = M; }
      for (int g = 0; g < ng; ++g) {
        EpiStore E{g ? O1 : O0, g ? L1_ : L0, act};
#ifndef NO_GS
        run_gemm(smem, g ? A1 : A0, g ? B1 : B0, g ? M1 : M0, g ? N1 : N0, g ? K1 : K0, E, (op == OP_MLP1 && layer == 3) ? 1 : 0, g ? 0 : ld0, (g && get_gdim() == 256) ? 128 : 0);
#endif
      }
#ifndef NO_SCAN
#ifdef SCAN_V1
      if (op == OP_SCAN) rwkv_scan(p, smem, slot);
#else
      if (op == OP_SCAN) rwkv_scan2(p, smem, slot);
#endif
      if (op == OP_MLP1 && layer < 3 && get_gdim() == 256 && get_bid() >= 128) convert_layer_weights(p, layer + 1, smem, get_bid() - 128, 128, 6);
      if (op == OP_QKV && kind == 0 && get_gdim() == 256 && get_bid() >= 48) convert_layer_weights(p, layer, smem, get_bid() - 48, 208, layer == 0 ? 5 : 1);
#endif
    }
    else if (op == OP_WO || op == OP_MLP2) {
      const u16 *A, *B; int K; const float* gate;
      if (op == OP_MLP2) { A = (const u16*)(AR + AR_HID); B = (const u16*)(p->ws + OFF_WB + ((layer & 1) ? WB_W2T_B : WB_W2T)); K = 4096; gate = MOD + (size_t)layer * 9 * 6144 + 5 * 1024; }
      else { K = 1024; gate = MOD + (size_t)layer * 9 * 6144 + 2 * 1024;
        if (kind == 0) { A = (const u16*)(AR + AR_ATT_O); B = (const u16*)(p->ws + OFF_WB + WB_ATT_WO); }
        else if (kind == 1) { A = (const u16*)(AR + AR_NA_O); B = (const u16*)(p->ws + OFF_WB + WB_NA_WO); }
        else { A = (const u16*)(AR + AR_YG); B = (const u16*)(p->ws + OFF_WB + WB_RW_WO); } }
      const int pln = (op == OP_MLP2) ? layer * 2 : (layer == 0 ? -1 : (layer - 1) * 2 + 1);
#ifndef NO_GR
      const int nsplit = op == OP_MLP2 ? 8 : 4, Ksub = K / nsplit;
      for (int pass = 0; pass < (layer < 3 ? 2 : 1); ++pass) {
        const int c = get_bid(), unit = c / nsplit, ks = c - unit * nsplit;
        float* part = pass ? (float*)(AR + (op == OP_MLP2 ? AR_PART_MLP2 : AR_PART_WO)) + (size_t)ks * 2048 * 1024 : nullptr;
        EpiResid E{p->out, (float*)(p->ws + OFF_XC), gate, (const float*)(p->ws + OFF_STATS), pln < 0 ? nullptr : p->ln_g + (size_t)pln * 1024, pln < 0 ? nullptr : p->ln_b + (size_t)pln * 1024, part, (op == OP_WO && layer == 0) ? p->x : (const float*)p->out, (op == OP_WO && layer == 0) ? p->ctx : (const float*)(p->ws + OFF_XC)};
        pg8::Gemm g{pass ? A + (size_t)ks * Ksub : A, pass ? B + (size_t)ks * Ksub : B, M, 1024, pass ? Ksub : K, K};
        pg8::StaticOrder S; S.init(M, 1024, get_gdim(), c, 1);
        if (pass) { S.one = unit < 32 ? 1 : 2; S.one_pm = (unit >> 2) * 17 + 16; S.one_pn = unit & 3; }
        pg8::gemm_phase<EpiResid, pg8::StaticOrder, false>((PG8_LAS unsigned char*)smem, g, S, E, nullptr);
        __syncthreads();
      }
#endif
      if (op == OP_MLP2 && layer < 3 && (get_gdim() != 256 || layer == 0)) convert_layer_weights(p, layer + 1, smem, get_bid(), get_gdim(), get_gdim() == 256 ? 1 : 7);
    }
    }
    if (ph + 1 < hi) xcd_barrier(xbar);
  }
}

extern "C" void kernel_launch(void* const* d_in, const int* in_sizes, int n_in, void* d_out, int out_size, void* d_ws, size_t ws_size, hipStream_t stream) {
  static int grid_blocks = 0;
  if (!grid_blocks) {
    int dev = 0, cus = 0, per_cu = 0;
    hipGetDevice(&dev);
    hipDeviceGetAttribute(&cus, hipDeviceAttributeMultiprocessorCount, dev);
    hipFuncSetAttribute((const void*)mega, hipFuncAttributeMaxDynamicSharedMemorySize, LDS_BYTES);
    hipOccupancyMaxActiveBlocksPerMultiprocessor(&per_cu, (const void*)mega, 512, LDS_BYTES);
    if (per_cu < 1) per_cu = 1;
    grid_blocks = cus * per_cu;
    if (grid_blocks > 256) grid_blocks = 256;
    if (ws_size < 492 * MiB) fprintf(stderr, "kernel_launch: workspace too small: %zu\n", ws_size);
  }
  P p{};
  const float** pf = (const float**)&p;
  for (int i = 0; i < 35; ++i) pf[i] = (const float*)d_in[i];
  p.out = (float*)d_out; p.ws = (unsigned char*)d_ws;
#if FUSED
  hipMemsetAsync((unsigned char*)d_ws + OFF_BARW, 0, XCD_BAR_WORDS * 4, stream);
  int lo = 0, hi = NPHASE;
  void* args[] = {&p, &lo, &hi};
  hipError_t e = hipLaunchCooperativeKernel((const void*)mega, dim3(grid_blocks), dim3(512), args, LDS_BYTES, stream);
  if (e != hipSuccess) fprintf(stderr, "cooperative launch failed: %s (grid %d)\n", hipGetErrorString(e), grid_blocks);
#else
  for (int ph = 0; ph < NPHASE; ++ph) hipLaunchKernelGGL(mega, dim3(grid_blocks), dim3(512), LDS_BYTES, stream, p, ph, ph + 1);
#endif
}
```

```cpp
#include <hip/hip_runtime.h>
#include <hip/hip_cooperative_groups.h>
#include <cstdio>
#include <cstdint>
namespace cg = cooperative_groups;

#ifndef FUSED
#define FUSED 1
#endif

typedef unsigned short u16;
typedef short v8s __attribute__((ext_vector_type(8)));
typedef short v4s __attribute__((ext_vector_type(4)));
typedef float v2f __attribute__((ext_vector_type(2)));
typedef float v4f __attribute__((ext_vector_type(4)));
typedef float v16f __attribute__((ext_vector_type(16)));
typedef unsigned v4u __attribute__((ext_vector_type(4)));
typedef unsigned v2u __attribute__((ext_vector_type(2)));

constexpr int D = 1024, NB = 8, SEQ = 4096, CTXL = 256, TB = SEQ + CTXL, M = NB * TB;
constexpr float ALPHA = 1.6817928305074292f;
constexpr float LN_EPS = 1e-6f;
constexpr float LOG2E = 1.4426950408889634f;
constexpr size_t MiB = (size_t)1 << 20;
constexpr int LDS_BYTES = 131072 + 1024;
constexpr int NPHASE = 34;

constexpr size_t OFF_WB = 0;
constexpr size_t OFF_XC = 42 * MiB;
constexpr size_t OFF_MOD = 50 * MiB;
constexpr size_t OFF_TAB = 51 * MiB;
constexpr size_t OFF_ONES = 51 * MiB + 64 * 1024;
constexpr size_t OFF_BON = 52 * MiB;
constexpr size_t OFF_STATS = 56 * MiB + 512 * 1024;
constexpr size_t OFF_BARW = 57 * MiB;
constexpr size_t OFF_AR = 58 * MiB;
constexpr size_t WB_W1T = 0, WB_W2T = 8 * MiB, WB_MIX = 16 * MiB, WB_W2T_B = 34 * MiB;
constexpr size_t WB_ATT_WO = 19 * MiB, WB_NA_WO = 22 * MiB, WB_RW_WO = 30 * MiB, WB_RW_BG = 32 * MiB, WB_RW_W2T = 32 * MiB + 768 * 1024, WB_RW_A2T = 33 * MiB;
constexpr size_t AR_H = 0;
constexpr size_t AR_QKV = 68 * MiB, AR_ATT_O = 170 * MiB;
constexpr size_t AR_NA_QK = 68 * MiB, AR_NA_VT = 204 * MiB, AR_NA_O = 272 * MiB;
constexpr size_t AR_PART_WO = 68 * MiB, AR_PART_MLP2 = 340 * MiB;
constexpr size_t AR_HID = 68 * MiB;
constexpr size_t AR_Y0 = 0, AR_Y1 = 68 * MiB, AR_R = 136 * MiB, AR_K = 204 * MiB, AR_V = 272 * MiB, AR_L1 = 340 * MiB, AR_G = 366 * MiB, AR_YG = 136 * MiB;

struct P {
  const float *x, *c, *ctx, *c_ctx, *mod_w, *mod_b, *ln_g, *ln_b, *mlp_w1, *mlp_w2;
  const float *att_wqkv, *att_wo, *att_qn, *att_kn, *na_wqkv, *na_wo, *na_rpb;
  const float *rw_mu, *rw_wr, *rw_wk, *rw_wv, *rw_wo, *rw_w0, *rw_w1, *rw_w2, *rw_a0, *rw_a1, *rw_a2, *rw_g1, *rw_g2, *rw_kk, *rw_ka, *rw_rk, *rw_lng, *rw_lnb;
  float* out; unsigned char* ws;
};

typedef const __attribute__((address_space(4))) P* PP;
__device__ __forceinline__ int get_tid() { int t = threadIdx.x; asm volatile("" : "+v"(t)); return t; }
__device__ __forceinline__ int get_bid() { int t = blockIdx.x; asm volatile("" : "+s"(t)); return t; }
__device__ __forceinline__ int get_gdim() { int t = gridDim.x; asm volatile("" : "+s"(t)); return t; }
__device__ __forceinline__ unsigned cvtpk(float lo, float hi) { unsigned r; asm volatile("v_cvt_pk_bf16_f32 %0, %1, %2" : "=v"(r) : "v"(lo), "v"(hi)); return r; }
__device__ __forceinline__ float bf2f(u16 v) { return __uint_as_float((unsigned)v << 16); }
__device__ __forceinline__ float bflo(unsigned w) { return __uint_as_float(w << 16); }
__device__ __forceinline__ float bfhi(unsigned w) { return __uint_as_float(w & 0xffff0000u); }
template <int CTRL> __device__ __forceinline__ float dppf(float v) { return __int_as_float(__builtin_amdgcn_update_dpp(0, __float_as_int(v), CTRL, 0xF, 0xF, true)); }
__device__ __forceinline__ float row_sum16(float v) { v += dppf<0xB1>(v); v += dppf<0x4E>(v); v += dppf<0x141>(v); v += dppf<0x140>(v); return v; }
__device__ __forceinline__ float wave_sum(float v) {
  v = row_sum16(v);
  const float a = __int_as_float(__builtin_amdgcn_readlane(__float_as_int(v), 0)), b = __int_as_float(__builtin_amdgcn_readlane(__float_as_int(v), 16));
  const float c = __int_as_float(__builtin_amdgcn_readlane(__float_as_int(v), 32)), d = __int_as_float(__builtin_amdgcn_readlane(__float_as_int(v), 48));
  return (a + b) + (c + d);
}
__device__ __forceinline__ float* xrow(PP p, int row) {
  const int b = row / TB, t = row - b * TB;
  return t < SEQ ? p->out + (size_t)(b * SEQ + t) * D : (float*)(p->ws + OFF_XC) + (size_t)(b * CTXL + t - SEQ) * D;
}
__device__ __forceinline__ int modidx(int row) { const int b = row / TB, t = row - b * TB; return t < SEQ ? b : 8; }
__device__ __forceinline__ int crow(int r, int hi) { return (r & 3) + 8 * (r >> 2) + 4 * hi; }

namespace pg8 {
#define PG8_LAS __attribute__((address_space(3)))
typedef unsigned short bf16_t;
typedef short bf16x8 __attribute__((ext_vector_type(8)));
typedef float f32x4 __attribute__((ext_vector_type(4)));
typedef unsigned u32x4 __attribute__((ext_vector_type(4)));
constexpr int BM = 256, BK = 64, HALF = 128, HTB = HALF * BK * 2  , STAGE_BYTES = 8 * HTB, NXCD = 8, WGM = 8;

__host__ __device__ __forceinline__ int lds_byte(int r, int c) { const int st = (r >> 4) * 2 + (c >> 5), rr = r & 15, cc = c & 31, ob = rr * 64 + cc * 2; return st * 1024 + (ob ^ (((ob >> 9) & 1) << 5)); }
__host__ __device__ __forceinline__ void stage_rc(int b, int& R, int& C) { const int st = b / 1024, sb = b % 1024, swz = sb ^ (((sb >> 9) & 1) << 5); R = (st >> 1) * 16 + swz / 64; C = (st & 1) * 32 + (swz % 64) / 2; }
__host__ __device__ __forceinline__ int perm32(int rho) { const int n = rho >> 4, i = rho & 15; return 8 * (i >> 2) + 4 * n + (i & 3); }

struct Unit { int pm, pn; };
struct Gemm { const bf16_t* A; const bf16_t* Bt; int M, N, K, ld; };

struct StaticOrder {
    int nM, nN, nwg, G, c, skip, one, one_pm, one_pn;
    __host__ __device__ void init(int M, int N, int G_, int c_, int skip_ = 0) { nM = M / BM; if (skip_) nM = nM / 17 * 16; nN = N / BM; nwg = nM * nN; G = G_; c = c_; skip = skip_; one = 0; one_pm = 0; one_pn = 0; }
    __host__ __device__ bool next(int i, Unit& u) const {
        if (one) { if (one == 1 && i == 0) { u.pm = one_pm; u.pn = one_pn; return true; } return false; }
        const long L = (long)i * G + c; if (L >= nwg) return false;
        int wgid = (int)L; { const int q = nwg / NXCD, r = nwg % NXCD, xcd = wgid % NXCD, off = wgid / NXCD; wgid = (xcd < r ? xcd * (q + 1) : r * (q + 1) + (xcd - r) * q) + off; }
        const int nig = WGM * nN, gid = wgid / nig, fm = gid * WGM, gsz = (nM - fm) < WGM ? (nM - fm) : WGM;
        u.pm = fm + ((wgid % nig) % gsz); u.pn = (wgid % nig) / gsz; if (skip) u.pm += u.pm >> 4; return true;
    }
    __device__ __forceinline__ void a_ready(const Unit&) const {}
    __device__ __forceinline__ void done(const Unit&) const {}
};
__device__ __forceinline__ unsigned cvt_pk_bf16(float lo, float hi) { unsigned r; asm volatile("v_cvt_pk_bf16_f32 %0, %1, %2" : "=v"(r) : "v"(lo), "v"(hi)); return r; }
typedef float f32x2 __attribute__((ext_vector_type(2)));
template <class Epi, class Sched, bool STAMP = false>
__device__ __forceinline__ void gemm_phase(PG8_LAS unsigned char* lds, const Gemm g, const Sched& S, const Epi& E, unsigned long long* stamps) {
    const int tid = get_tid(), wid = __builtin_amdgcn_readfirstlane(tid >> 6), lane = tid & 63, wr = wid >> 2, wc = wid & 3, fr = lane & 15, fq = lane >> 4;
    const int K = g.K, nt = K / BK;
    int ts_lo = 0, ts_hi = 0, nts = 0; const unsigned long long rt_entry = STAMP ? (unsigned long long)wall_clock64() : 0ull;
#define PG8_STAMP() do { if (STAMP && wid == 0 && nts < 64) { const unsigned long long _c = (unsigned long long)clock64(); \
        ts_lo = (lane == nts) ? (int)(unsigned)_c : ts_lo; ts_hi = (lane == nts) ? (int)(unsigned)(_c >> 32) : ts_hi; ++nts; } } while (0)
    PG8_STAMP();
    unsigned voffA[2], voffB[2];
#pragma unroll
    for (int i = 0; i < 2; ++i) { int R, C; stage_rc(tid * 16 + i * 8192, R, C); const int Rb = Epi::PERM ? ((R & ~31) + perm32(R & 31)) : R;
        voffA[i] = (unsigned)(R * g.ld + C) * 2u; voffB[i] = (unsigned)(Rb * g.ld + C) * 2u; }
    const size_t kstep = (size_t)(BK * 2);
    const size_t hstep = (size_t)HALF * g.ld * 2;
    const size_t tstep = 2 * hstep;
    const unsigned ldsw = (unsigned)wid * 1024u;
    const int aoff = lds_byte(wr * 64 + fr, fq * 8), boff = lds_byte(wc * 32 + fr, fq * 8);
#define PG8_SA(b, h) (((b) * 2 + (h)) * HTB)
#define PG8_SB(b, h) ((4 + (b) * 2 + (h)) * HTB)
#define PG8_STAGE(bufoff, gbase, voff) do { _Pragma("unroll") for (int _i = 0; _i < 2; ++_i) \
        __builtin_amdgcn_global_load_lds((const unsigned*)((const char*)(gbase) + (voff)[_i]), (PG8_LAS unsigned*)(lds + (bufoff) + ldsw + _i * 8192), 16, 0, 0); } while (0)
#define PG8_LDA(dst, b, h) do { _Pragma("unroll") for (int m = 0; m < 4; ++m) _Pragma("unroll") for (int k = 0; k < 2; ++k) dst[m][k] = *(const PG8_LAS bf16x8*)(lds + PG8_SA(b, h) + aoff + m * 2048 + k * 1024); } while (0)
#define PG8_LDB(dst, b, h) do { _Pragma("unroll") for (int n = 0; n < 2; ++n) _Pragma("unroll") for (int k = 0; k < 2; ++k) dst[n][k] = *(const PG8_LAS bf16x8*)(lds + PG8_SB(b, h) + boff + n * 2048 + k * 1024); } while (0)
#define PG8_MMA(ai, bj, At, Bt) do { __builtin_amdgcn_s_setprio(1); _Pragma("unroll") for (int m = 0; m < 4; ++m) _Pragma("unroll") for (int n = 0; n < 2; ++n) _Pragma("unroll") for (int k = 0; k < 2; ++k) \
        acc[ai][bj][m][n] = __builtin_amdgcn_mfma_f32_16x16x32_bf16(Bt[n][k], At[m][k], acc[ai][bj][m][n], 0, 0, 0); __builtin_amdgcn_s_setprio(0); } while (0)
#define PG8_WAIT_V(n) asm volatile("s_waitcnt vmcnt(" #n ")" ::: "memory")
#define PG8_WAIT_L(n) asm volatile("s_waitcnt lgkmcnt(" #n ")" ::: "memory")
#define PG8_BAR __builtin_amdgcn_s_barrier()
#define PG8_SCHED __builtin_amdgcn_sched_barrier(0)
    Unit cur, nxt; int ui = 0;
    if (!S.next(0, cur)) return;
    f32x4 acc[2][2][4][2];
#pragma unroll
    for (int a = 0; a < 2; ++a)
#pragma unroll
        for (int b = 0; b < 2; ++b)
#pragma unroll
            for (int m = 0; m < 4; ++m)
#pragma unroll
                for (int n = 0; n < 2; ++n) acc[a][b][m][n] = (f32x4){0.f, 0.f, 0.f, 0.f};
    bf16x8 At[4][2], B0[2][2], B1[2][2];
    const char* cA = (const char*)g.A + (size_t)cur.pm * tstep; const char* cB = (const char*)g.Bt + (size_t)cur.pn * tstep;
    S.a_ready(cur);
    PG8_STAGE(PG8_SB(0, 0), cB, voffB); PG8_STAGE(PG8_SA(0, 0), cA, voffA); PG8_STAGE(PG8_SB(0, 1), cB + hstep, voffB); PG8_STAGE(PG8_SA(0, 1), cA + hstep, voffA);
    if (wr == 1) PG8_BAR;
    PG8_WAIT_V(4); PG8_BAR;
    PG8_STAGE(PG8_SB(1, 0), cB + kstep, voffB); PG8_STAGE(PG8_SA(1, 0), cA + kstep, voffA); PG8_STAGE(PG8_SB(1, 1), cB + hstep + kstep, voffB);
    PG8_WAIT_V(6); PG8_BAR;
    PG8_STAMP();
    for (;;) {
        const bool has_next = S.next(ui + 1, nxt);
        const char* nA = has_next ? (const char*)g.A + (size_t)nxt.pm * tstep : cA; const char* nB = has_next ? (const char*)g.Bt + (size_t)nxt.pn * tstep : cB;
        for (int t = 0; t < nt; t += 2) {
            const bool last = (t == nt - 2);
            const char* a1 = cA + (size_t)(t + 1) * kstep;
            const char* a2 = last ? nA : cA + (size_t)(t + 2) * kstep; const char* b2 = last ? nB : cB + (size_t)(t + 2) * kstep;
            const char* a3 = a2 + kstep; const char* b3 = b2 + kstep;
            if (last && has_next) S.a_ready(nxt);
            PG8_LDB(B0, 0, 0); PG8_SCHED; PG8_LDA(At, 0, 0); PG8_STAGE(PG8_SA(1, 1), a1 + hstep, voffA);
            PG8_WAIT_L(8); PG8_BAR; PG8_WAIT_L(0); PG8_MMA(0, 0, At, B0); PG8_BAR; PG8_SCHED;
            PG8_LDB(B1, 0, 1); PG8_STAGE(PG8_SB(0, 0), b2, voffB);
            PG8_BAR; PG8_WAIT_L(0); PG8_MMA(0, 1, At, B1); PG8_BAR;
            PG8_LDA(At, 0, 1); PG8_STAGE(PG8_SA(0, 0), a2, voffA);
            PG8_BAR; PG8_WAIT_L(0); PG8_MMA(1, 0, At, B0); PG8_BAR; PG8_SCHED;
            PG8_STAGE(PG8_SB(0, 1), b2 + hstep, voffB);
            PG8_WAIT_V(6); PG8_BAR; PG8_MMA(1, 1, At, B1); PG8_BAR;
            PG8_LDB(B0, 1, 0); PG8_SCHED; PG8_LDA(At, 1, 0); PG8_STAGE(PG8_SA(0, 1), a2 + hstep, voffA);
            PG8_WAIT_L(8); PG8_BAR; PG8_WAIT_L(0); PG8_MMA(0, 0, At, B0); PG8_BAR; PG8_SCHED;
            PG8_LDB(B1, 1, 1); PG8_STAGE(PG8_SB(1, 0), b3, voffB);
            PG8_BAR; PG8_WAIT_L(0); PG8_MMA(0, 1, At, B1); PG8_BAR;
            PG8_LDA(At, 1, 1); PG8_STAGE(PG8_SA(1, 0), a3, voffA);
            PG8_BAR; PG8_WAIT_L(0); PG8_MMA(1, 0, At, B0); PG8_BAR; PG8_SCHED;
            PG8_STAGE(PG8_SB(1, 1), b3 + hstep, voffB);
            PG8_WAIT_V(6); PG8_BAR; PG8_MMA(1, 1, At, B1); PG8_BAR;
        }
        PG8_STAMP();
        if constexpr (!Epi::AFTER_DRAIN) { E(acc, cur, wr, wc, fr, fq); S.done(cur); }
        PG8_STAMP();
        if (!has_next) break;
#pragma unroll
        for (int a = 0; a < 2; ++a)
#pragma unroll
            for (int b = 0; b < 2; ++b)
#pragma unroll
                for (int m = 0; m < 4; ++m)
#pragma unroll
                    for (int n = 0; n < 2; ++n) acc[a][b][m][n] = (f32x4){0.f, 0.f, 0.f, 0.f};
        cur = nxt; cA = nA; cB = nB; ++ui;
    }
    PG8_WAIT_V(0);
    if (wr == 0) PG8_BAR;
    PG8_BAR;
    if constexpr (Epi::AFTER_DRAIN) { E.fused(acc, cur, wr, wc, fr, fq, lds, wid, lane); S.done(cur); }
    PG8_STAMP();
    if (STAMP && wid == 0) { stamps[lane] = lane < nts ? (((unsigned long long)(unsigned)ts_hi << 32) | (unsigned)ts_lo) : 0ull;
        if (lane == 62) stamps[62] = rt_entry; if (lane == 63) stamps[63] = (unsigned long long)wall_clock64(); }
#undef PG8_STAMP
#undef PG8_SA
#undef PG8_SB
#undef PG8_STAGE
#undef PG8_LDA
#undef PG8_LDB
#undef PG8_MMA
#undef PG8_WAIT_V
#undef PG8_WAIT_L
#undef PG8_BAR
#undef PG8_SCHED
}
}

struct EpiStore {
  static constexpr bool PERM = true, AFTER_DRAIN = false;
  u16* O; int ldc; int act;
  __device__ __forceinline__ void operator()(const pg8::f32x4 (&acc)[2][2][4][2], const pg8::Unit& u, int wr, int wc, int fr, int fq) const {
    const int row0 = u.pm * 256 + wr * 64 + fr, col0 = u.pn * 256 + wc * 32 + 8 * fq;
#pragma unroll
    for (int ai = 0; ai < 2; ++ai)
#pragma unroll
      for (int m = 0; m < 4; ++m) {
        u16* rowp = O + (size_t)(row0 + ai * 128 + m * 16) * ldc + col0;
#pragma unroll
        for (int bj = 0; bj < 2; ++bj) {
          pg8::f32x4 v0 = acc[ai][bj][m][0], v1 = acc[ai][bj][m][1];
          if (act == 1) {
#pragma unroll
            for (int j = 0; j < 4; ++j) { float a = fmaxf(v0[j], 0.f), b = fmaxf(v1[j], 0.f); v0[j] = a * a; v1[j] = b * b; }
          }
          v4u w; w.x = cvtpk(v0[0], v0[1]); w.y = cvtpk(v0[2], v0[3]); w.z = cvtpk(v1[0], v1[1]); w.w = cvtpk(v1[2], v1[3]);
          *(v4u*)(rowp + bj * 128) = w;
        }
      }
  }
};
struct EpiResid {
  static constexpr bool PERM = false, AFTER_DRAIN = false;
  float* out; float* xc; const float* gate;
  const float* stats; const float* lng; const float* lnb;
  float* part;
  const float* xin_lat; const float* xin_ctx;
  __device__ __forceinline__ void operator()(const pg8::f32x4 (&acc)[2][2][4][2], const pg8::Unit& u, int wr, int wc, int fr, int fq) const {
    const int row0 = u.pm * 256 + wr * 64 + fr, col0 = u.pn * 256 + wc * 32 + 4 * fq;
    if (part) {
      const int ct = u.pm / 17;
#pragma unroll
      for (int ai = 0; ai < 2; ++ai)
#pragma unroll
        for (int m = 0; m < 4; ++m) {
          float* rowp = part + (size_t)(ct * 256 + wr * 64 + fr + ai * 128 + m * 16) * 1024 + col0;
#pragma unroll
          for (int bj = 0; bj < 2; ++bj)
#pragma unroll
            for (int n = 0; n < 2; ++n) *(pg8::f32x4*)(rowp + bj * 128 + n * 16) = acc[ai][bj][m][n];
        }
      return;
    }
#pragma unroll
    for (int ai = 0; ai < 2; ++ai)
#pragma unroll
      for (int m = 0; m < 4; ++m) {
        const int row = row0 + ai * 128 + m * 16; const int b = row / TB, t = row - b * TB;
        const size_t roff = t < SEQ ? (size_t)(b * SEQ + t) * D : (size_t)(b * CTXL + t - SEQ) * D;
        float* xr = (t < SEQ ? out : xc) + roff;
        const float* xi = (t < SEQ ? xin_lat : xin_ctx) + roff;
        const float* g = gate + (t < SEQ ? b : 8) * 6144;
        v2f st_ = {0.f, 1.f}; if (lng) st_ = *(const v2f*)(stats + (size_t)row * 2);
#pragma unroll
        for (int bj = 0; bj < 2; ++bj)
#pragma unroll
          for (int n = 0; n < 2; ++n) {
            const int c = col0 + bj * 128 + n * 16;
            pg8::f32x4 x = *(const pg8::f32x4*)(xi + c); const pg8::f32x4 gg = *(const pg8::f32x4*)(g + c);
            if (lng) x = (x - st_.x) * st_.y * *(const pg8::f32x4*)(lng + c) + *(const pg8::f32x4*)(lnb + c);
            *(pg8::f32x4*)(xr + c) = x * ALPHA + gg * acc[ai][bj][m][n];
          }
      }
  }
};
struct EpiRw1 {
  static constexpr bool PERM = true, AFTER_DRAIN = false;
  u16* RKV; u16* L1;
  __device__ __forceinline__ void operator()(const pg8::f32x4 (&acc)[2][2][4][2], const pg8::Unit& u, int wr, int wc, int fr, int fq) const {
    const int row0 = u.pm * 256 + wr * 64 + fr, lc0 = wc * 32 + 8 * fq;
    if (u.pn < 12) {
      u16* base = RKV + (size_t)(u.pn >> 2) * ((size_t)M * 1024) + (u.pn & 3) * 256 + lc0;
#pragma unroll
      for (int ai = 0; ai < 2; ++ai)
#pragma unroll
        for (int m = 0; m < 4; ++m) {
          u16* rowp = base + (size_t)(row0 + ai * 128 + m * 16) * 1024;
#pragma unroll
          for (int bj = 0; bj < 2; ++bj) {
            const pg8::f32x4 v0 = acc[ai][bj][m][0], v1 = acc[ai][bj][m][1];
            v4u w; w.x = cvtpk(v0[0], v0[1]); w.y = cvtpk(v0[2], v0[3]); w.z = cvtpk(v1[0], v1[1]); w.w = cvtpk(v1[2], v1[3]);
            *(v4u*)(rowp + bj * 128) = w;
          }
        }
    } else {
#pragma unroll
      for (int ai = 0; ai < 2; ++ai)
#pragma unroll
        for (int m = 0; m < 4; ++m) {
          u16* rowp = L1 + (size_t)(row0 + ai * 128 + m * 16) * 384 + (u.pn - 12) * 256 + lc0;
#pragma unroll
          for (int bj = 0; bj < 2; ++bj) {
            if (u.pn == 13 && bj == 1) continue;
            const int mode = (u.pn == 12) ? (bj == 0 ? 1 : 0) : 2;
            float v[8];
#pragma unroll
            for (int j = 0; j < 4; ++j) { v[j] = acc[ai][bj][m][0][j]; v[4 + j] = acc[ai][bj][m][1][j]; }
#pragma unroll
            for (int j = 0; j < 8; ++j) {
              if (mode == 1) v[j] = 1.f - 2.f / (1.f + __expf(2.f * v[j]));
              else if (mode == 2) v[j] = 1.f / (1.f + __expf(-v[j]));
            }
            v4u w; w.x = cvtpk(v[0], v[1]); w.y = cvtpk(v[2], v[3]); w.z = cvtpk(v[4], v[5]); w.w = cvtpk(v[6], v[7]);
            *(v4u*)(rowp + bj * 128) = w;
          }
        }
    }
  }
};

template <class Epi>
__device__ __forceinline__ void run_gemm(unsigned char* smem, const u16* A, const u16* Bt, int Mr, int N, int K, const Epi& E, int skip = 0, int ld = 0, int crot = 0) {
  pg8::Gemm g{A, Bt, Mr, N, K, ld ? ld : K}; pg8::StaticOrder S; S.init(Mr, N, get_gdim(), (get_bid() + crot) & (get_gdim() - 1), skip);
  pg8::gemm_phase<Epi, pg8::StaticOrder, false>((PG8_LAS unsigned char*)smem, g, S, E, nullptr);
  __syncthreads();
}

__device__ __forceinline__ void my_sincos(double x, float& s, float& c) {
  const double kd = rint(x * 0.6366197723675814);
  const int k = (int)kd;
  double r = fma(-kd, 1.5707963267948966, x); r = fma(-kd, 6.123233995736766e-17, r);
  const double r2 = r * r;
  const double sp = r * (1.0 + r2 * (-1.0 / 6.0 + r2 * (1.0 / 120.0 + r2 * (-1.0 / 5040.0 + r2 * (1.0 / 362880.0 + r2 * (-1.0 / 39916800.0 + r2 * (1.0 / 6227020800.0)))))));
  const double cp = 1.0 + r2 * (-0.5 + r2 * (1.0 / 24.0 + r2 * (-1.0 / 720.0 + r2 * (1.0 / 40320.0 + r2 * (-1.0 / 3628800.0 + r2 * (1.0 / 479001600.0 + r2 * (-1.0 / 87178291200.0)))))));
  const int q = k & 3;
  const double ss = (q == 0) ? sp : (q == 1) ? cp : (q == 2) ? -sp : -cp;
  const double cc = (q == 0) ? cp : (q == 1) ? -sp : (q == 2) ? -cp : sp;
  s = (float)ss; c = (float)cc;
}

__device__ void phase_mod(PP p, unsigned char* smem) {
  float* sc = (float*)smem; float* red = sc + 9 * 1024;
  const int tid = get_tid();
  for (int e = tid; e < 9 * 1024; e += 512) { const int j = e >> 10, k = e & 1023; const float v = j < 8 ? p->c[j * 1024 + k] : p->c_ctx[k]; sc[e] = v / (1.f + __expf(-v)); }
  __syncthreads();
  float* MOD = (float*)(p->ws + OFF_MOD);
  for (int item = get_bid(); item < 4 * 48; item += get_gdim()) {
    const int l = item / 48, cb = item % 48, c4 = (tid & 31) * 4, kq = tid >> 5;
    const float* w = p->mod_w + (size_t)l * 1024 * 6144 + cb * 128 + c4;
    v4f acc[9];
#pragma unroll
    for (int j = 0; j < 9; ++j) acc[j] = (v4f){0.f, 0.f, 0.f, 0.f};
#pragma unroll 8
    for (int k = kq * 64; k < kq * 64 + 64; ++k) {
      const v4f wv = *(const v4f*)(w + (size_t)k * 6144);
#pragma unroll
      for (int j = 0; j < 9; ++j) acc[j] += wv * sc[j * 1024 + k];
    }
#pragma unroll
    for (int j = 0; j < 9; ++j) *(v4f*)(red + ((kq * 9 + j) * 128 + c4)) = acc[j];
    __syncthreads();
    for (int o = tid; o < 9 * 128; o += 512) {
      const int j = o >> 7, cl = o & 127;
      float s = p->mod_b[l * 6144 + cb * 128 + cl];
#pragma unroll
      for (int q = 0; q < 16; ++q) s += red[(q * 9 + j) * 128 + cl];
      MOD[(size_t)(l * 9 + j) * 6144 + cb * 128 + cl] = s;
    }
    __syncthreads();
  }
  if (get_bid() == get_gdim() - 1) {
    float* ONES = (float*)(p->ws + OFF_ONES);
    for (int e = tid; e < 2048; e += 512) ONES[e] = e < 1024 ? 1.f : 0.f;
    v2f* TAB = (v2f*)(p->ws + OFF_TAB);
    for (int e = tid; e < 2048; e += 512) {
      const int pos = e >> 5, i = e & 31;
      double f = 1.0; for (int q = 0; q < i; ++q) f *= 0.7498942093324559;
      float s, c; my_sincos((double)pos * f, s, c);
      TAB[e] = (v2f){c, s};
    }
  }
}

__device__ void cvt_T(const float* src, int ldsrc, u16* dst, int ldd, int K, int N, const float* scale, float* tile, int& rot, int bid, int G) {
  const int tid = get_tid();
  const int ntn = N / 64, nt = (K / 64) * ntn;
  const int first = ((bid - rot) % G + G) % G;
  for (int t = first; t < nt; t += G) {
    const int tk = t / ntn, tn = t - tk * ntn;
#pragma unroll
    for (int i = 0; i < 8; ++i) {
      const int e = tid + 512 * i, k = e >> 6, n = e & 63;
      float v = src[(size_t)(tk * 64 + k) * ldsrc + tn * 64 + n];
      if (scale) v *= scale[tk * 64 + k];
      tile[k * 65 + n] = v;
    }
    __syncthreads();
    {
      const int n = tid >> 3, kc = (tid & 7) * 8;
      float v[8];
#pragma unroll
      for (int i = 0; i < 8; ++i) v[i] = tile[(kc + i) * 65 + n];
      v4u w; w.x = cvtpk(v[0], v[1]); w.y = cvtpk(v[2], v[3]); w.z = cvtpk(v[4], v[5]); w.w = cvtpk(v[6], v[7]);
      *(v4u*)(dst + (size_t)(tn * 64 + n) * ldd + tk * 64 + kc) = w;
    }
    __syncthreads();
  }
  rot = (rot + nt) % G;
}
__device__ void zero_bf16(u16* dst, int ldd, int nrows, int c0, int ncols, int bid, int G) {
  const int per = ncols / 8; const long total = (long)nrows * per;
  for (long i = (long)bid * 512 + get_tid(); i < total; i += (long)G * 512) {
    const long r = i / per; const int cc = (int)(i - r * per);
    *(v4u*)(dst + (size_t)r * ldd + c0 + cc * 8) = (v4u){0u, 0u, 0u, 0u};
  }
}

__device__ void convert_layer_weights(PP p, int layer, unsigned char* smem, int bid, int G, int parts = 7) {
  float* tile = (float*)smem; int rot = 0;
  const int kind = layer % 3, slot = layer / 3;
  u16* WB = (u16*)(p->ws + OFF_WB);
  if (parts & 1) cvt_T(p->mlp_w1 + (size_t)layer * 1024 * 4096, 4096, (u16*)(p->ws + OFF_WB + WB_W1T), 1024, 1024, 4096, nullptr, tile, rot, bid, G);
  if (parts & 4) cvt_T(p->mlp_w2 + (size_t)layer * 4096 * 1024, 1024, (u16*)(p->ws + OFF_WB + ((layer & 1) ? WB_W2T_B : WB_W2T)), 4096, 4096, 1024, nullptr, tile, rot, bid, G);
  if (!(parts & 2)) return;
  u16* MIX = (u16*)(p->ws + OFF_WB + WB_MIX);
  if (kind == 0) {
    cvt_T(p->att_wqkv + (size_t)slot * 1024 * 1536, 1536, MIX, 1024, 1024, 1536, nullptr, tile, rot, bid, G);
    cvt_T(p->att_wo + (size_t)slot * 1024 * 1024, 1024, (u16*)(p->ws + OFF_WB + WB_ATT_WO), 1024, 1024, 1024, nullptr, tile, rot, bid, G);
  } else if (kind == 1) {
    cvt_T(p->na_wqkv + (size_t)slot * 1024 * 3072, 3072, MIX, 1024, 1024, 3072, nullptr, tile, rot, bid, G);
    cvt_T(p->na_wo + (size_t)slot * 1024 * 1024, 1024, (u16*)(p->ws + OFF_WB + WB_NA_WO), 1024, 1024, 1024, nullptr, tile, rot, bid, G);
  } else {
    const float* mu = p->rw_mu + (size_t)slot * 6 * 1024;
    {
      const float* s0 = p->rw_wr + (size_t)slot * 1024 * 1024; const float* s1 = p->rw_wk + (size_t)slot * 1024 * 1024; const float* s2 = p->rw_wv + (size_t)slot * 1024 * 1024;
      cvt_T(s0, 1024, MIX, 2048, 1024, 1024, nullptr, tile, rot, bid, G);
      cvt_T(s0, 1024, MIX + 1024, 2048, 1024, 1024, mu + 0 * 1024, tile, rot, bid, G);
      cvt_T(s1, 1024, MIX + (size_t)1024 * 2048, 2048, 1024, 1024, nullptr, tile, rot, bid, G);
      cvt_T(s1, 1024, MIX + (size_t)1024 * 2048 + 1024, 2048, 1024, 1024, mu + 2 * 1024, tile, rot, bid, G);
      cvt_T(s2, 1024, MIX + (size_t)2048 * 2048, 2048, 1024, 1024, nullptr, tile, rot, bid, G);
      cvt_T(s2, 1024, MIX + (size_t)2048 * 2048 + 1024, 2048, 1024, 1024, mu + 3 * 1024, tile, rot, bid, G);
    }
    for (int d = 0; d < 2; ++d) {
      const float* w1 = p->rw_w1 + (size_t)(slot * 2 + d) * 1024 * 64;
      cvt_T(w1, 64, MIX + (size_t)(3072 + 64 * d) * 2048, 2048, 1024, 64, nullptr, tile, rot, bid, G);
      cvt_T(w1, 64, MIX + (size_t)(3072 + 64 * d) * 2048 + 1024, 2048, 1024, 64, mu + 1 * 1024, tile, rot, bid, G);
      const float* a1 = p->rw_a1 + (size_t)(slot * 2 + d) * 1024 * 64;
      cvt_T(a1, 64, MIX + (size_t)(3200 + 64 * d) * 2048, 2048, 1024, 64, nullptr, tile, rot, bid, G);
      cvt_T(a1, 64, MIX + (size_t)(3200 + 64 * d) * 2048 + 1024, 2048, 1024, 64, mu + 4 * 1024, tile, rot, bid, G);
      cvt_T(p->rw_w2 + (size_t)(slot * 2 + d) * 64 * 1024, 1024, (u16*)(p->ws + OFF_WB + WB_RW_W2T) + (size_t)d * 1024 * 64, 64, 64, 1024, nullptr, tile, rot, bid, G);
      cvt_T(p->rw_a2 + (size_t)(slot * 2 + d) * 64 * 1024, 1024, (u16*)(p->ws + OFF_WB + WB_RW_A2T) + (size_t)d * 1024 * 64, 64, 64, 1024, nullptr, tile, rot, bid, G);
    }
    const float* g1 = p->rw_g1 + (size_t)slot * 1024 * 128;
    cvt_T(g1, 128, MIX + (size_t)3328 * 2048, 2048, 1024, 128, nullptr, tile, rot, bid, G);
    cvt_T(g1, 128, MIX + (size_t)3328 * 2048 + 1024, 2048, 1024, 128, mu + 5 * 1024, tile, rot, bid, G);
    zero_bf16(MIX + (size_t)3456 * 2048, 2048, 128, 0, 2048, bid, G);
    cvt_T(p->rw_wo + (size_t)slot * 1024 * 1024, 1024, (u16*)(p->ws + OFF_WB + WB_RW_WO), 1024, 1024, 1024, nullptr, tile, rot, bid, G);
    u16* BG = (u16*)(p->ws + OFF_WB + WB_RW_BG);
    zero_bf16(BG, 384, 1024, 0, 256, bid, G);
    cvt_T(p->rw_g2 + (size_t)slot * 128 * 1024, 1024, BG + 256, 384, 128, 1024, nullptr, tile, rot, bid, G);
  }
  (void)WB;
}

__device__ void rowpass(PP p, int src_ln, int mod_layer, int mod_off, u16* H, int ldh, bool final, bool skipctx = false, int nparts = 0, const float* part = nullptr, int pend_ln = -1, const float* gatec = nullptr, bool ctx_from_input = false) {
  const int wid = get_tid() >> 6, lane = get_tid() & 63;
  const float* MOD = (const float*)(p->ws + OFF_MOD);
  v4f lg_[4], lb_[4];
#pragma unroll
  for (int q = 0; q < 4; ++q) {
    lg_[q] = src_ln >= 0 ? *(const v4f*)(p->ln_g + (size_t)src_ln * 1024 + q * 256 + lane * 4) : (v4f){1.f, 1.f, 1.f, 1.f};
    lb_[q] = src_ln >= 0 ? *(const v4f*)(p->ln_b + (size_t)src_ln * 1024 + q * 256 + lane * 4) : (v4f){0.f, 0.f, 0.f, 0.f};
  }
  for (int row = get_bid() * 8 + wid; row < M; row += get_gdim() * 8) {
    const int b = row / TB, t = row - b * TB;
    if ((final || skipctx) && t >= SEQ) continue;
    float* xr = xrow(p, row);
    const float* src = src_ln < 0 ? (t < SEQ ? p->x + (size_t)(b * SEQ + t) * D : p->ctx + (size_t)(b * CTXL + t - SEQ) * D) : ((ctx_from_input && t >= SEQ) ? p->ctx + (size_t)(b * CTXL + t - SEQ) * D : xr);
    v4f v[4];
#pragma unroll
    for (int q = 0; q < 4; ++q) v[q] = *(const v4f*)(src + q * 256 + lane * 4);
    if (nparts > 0 && t >= SEQ) {
      const v2f ps = *(const v2f*)((const float*)(p->ws + OFF_STATS) + (size_t)row * 2);
      const float* pg_ = pend_ln < 0 ? (const float*)(p->ws + OFF_ONES) : p->ln_g + (size_t)pend_ln * 1024;
      const float* pb_ = pend_ln < 0 ? (const float*)(p->ws + OFF_ONES) + 1024 : p->ln_b + (size_t)pend_ln * 1024;
      const int crow = b * CTXL + t - SEQ;
#pragma unroll
      for (int q = 0; q < 4; ++q) {
        const int c = q * 256 + lane * 4;
        v4f acc = *(const v4f*)(part + (size_t)crow * 1024 + c);
        for (int ks = 1; ks < nparts; ++ks) acc += *(const v4f*)(part + ((size_t)ks * 2048 + crow) * 1024 + c);
        v[q] = ((v[q] - ps.x) * ps.y * *(const v4f*)(pg_ + c) + *(const v4f*)(pb_ + c)) * ALPHA + *(const v4f*)(gatec + c) * acc;
        *(v4f*)(xr + c) = v[q];
      }
    }
    if (src_ln >= 0) {
      float s = 0.f;
#pragma unroll
      for (int q = 0; q < 4; ++q) s += (v[q][0] + v[q][1]) + (v[q][2] + v[q][3]);
      const float mean = wave_sum(s) * (1.f / 1024.f);
      float sq = 0.f;
#pragma unroll
      for (int q = 0; q < 4; ++q) { v[q] = v[q] - mean; sq += (v[q][0] * v[q][0] + v[q][1] * v[q][1]) + (v[q][2] * v[q][2] + v[q][3] * v[q][3]); }
      const float rstd = 1.0f / sqrtf(wave_sum(sq) * (1.f / 1024.f) + LN_EPS);
      if (lane == 0 && !final) *(v2f*)((float*)(p->ws + OFF_STATS) + (size_t)row * 2) = (v2f){mean, rstd};
#pragma unroll
      for (int q = 0; q < 4; ++q) v[q] = v[q] * rstd * lg_[q] + lb_[q];
    }
    if (final) {
#pragma unroll
      for (int q = 0; q < 4; ++q) *(v4f*)(xr + q * 256 + lane * 4) = v[q];
    }
    if (src_ln < 0 && lane == 0) *(v2f*)((float*)(p->ws + OFF_STATS) + (size_t)row * 2) = (v2f){0.f, 1.f};
    if (final) continue;
    const float* md = MOD + (size_t)(mod_layer * 9 + (t < SEQ ? b : 8)) * 6144 + mod_off * 1024;
#pragma unroll
    for (int q = 0; q < 4; ++q) {
      const v4f sh = *(const v4f*)(md + q * 256 + lane * 4), scl = *(const v4f*)(md + 1024 + q * 256 + lane * 4);
      const v4f h = v[q] * (scl + 1.f) + sh;
      v2u w; w.x = cvtpk(h[0], h[1]); w.y = cvtpk(h[2], h[3]);
      *(v2u*)(H + (size_t)row * ldh + q * 256 + lane * 4) = w;
    }
  }
}

__device__ void xx_pass(PP p) {
  u16* HX = (u16*)(p->ws + OFF_AR + AR_H);
  for (long idx = (long)get_bid() * 512 + get_tid(); idx < (long)M * 128; idx += (long)get_gdim() * 512) {
    const int row = (int)(idx >> 7), c8 = (int)(idx & 127) * 8;
    const int t = row % TB;
    const bool first = (t == 0) || (t == SEQ), last = (t == SEQ - 1) || (t == TB - 1);
    const v4u z = {0u, 0u, 0u, 0u};
    const v4u h = *(const v4u*)(HX + (size_t)row * 2048 + c8);
    const v4u hp = first ? z : *(const v4u*)(HX + (size_t)(row - 1) * 2048 + c8);
    const v4u hn = last ? z : *(const v4u*)(HX + (size_t)(row + 1) * 2048 + c8);
    v4u o;
#pragma unroll
    for (int j = 0; j < 4; ++j) {
      const float lo = 0.5f * (bflo(hp[j]) + bflo(hn[j])) - bflo(h[j]);
      const float hi = 0.5f * (bfhi(hp[j]) + bfhi(hn[j])) - bfhi(h[j]);
      o[j] = cvtpk(lo, hi);
    }
    *(v4u*)(HX + (size_t)row * 2048 + 1024 + c8) = o;
  }
}

__device__ void qk_prep(PP p, int slot) {
  u16* QKV = (u16*)(p->ws + OFF_AR + AR_QKV);
  const v2f* TAB = (const v2f*)(p->ws + OFF_TAB);
  const int tid = get_tid(), q = tid & 15, d0 = q * 8;
  const float* qn = p->att_qn + slot * 128; const float* kn = p->att_kn + slot * 128;
  const int pq = q ^ 4, pd0 = pq * 8;
  const bool up = (q & 4) != 0;
  const int i0 = d0 & 31;
  const bool colang = q >= 8;
  float gq_[8], gk_[8], pgq_[8], pgk_[8];
#pragma unroll
  for (int j = 0; j < 8; ++j) { gq_[j] = qn[d0 + j]; gk_[j] = kn[d0 + j]; pgq_[j] = qn[pd0 + j]; pgk_[j] = kn[pd0 + j]; }
  const int total = M * 2, stride = get_gdim() * 32;
  for (int it0 = get_bid() * 32 + (tid >> 4); it0 < total; it0 += stride * 4) {
    v4u raws[4];
#pragma unroll
    for (int uu = 0; uu < 4; ++uu) {
      const int it = it0 + uu * stride;
      if (it < total) { const int row = it >> 1, hs = 8 + (it & 1); raws[uu] = *(const v4u*)(QKV + (size_t)row * 1536 + hs * 128 + d0); }
    }
#pragma unroll
    for (int uu = 0; uu < 4; ++uu) {
      const int it = it0 + uu * stride;
      if (it < total) {
        const int row = it >> 1, hs = 8 + (it & 1);
        u16* base = QKV + (size_t)row * 1536 + hs * 128 + d0;
        const v4u raw = raws[uu];
        v4u praw;
#pragma unroll
        for (int j = 0; j < 4; ++j) praw[j] = (unsigned)__shfl_xor((int)raw[j], 4);
        float e[8], pe[8];
#pragma unroll
        for (int j = 0; j < 4; ++j) { e[2 * j] = bflo(raw[j]); e[2 * j + 1] = bfhi(raw[j]); pe[2 * j] = bflo(praw[j]); pe[2 * j + 1] = bfhi(praw[j]); }
        float ss = 0.f;
#pragma unroll
        for (int j = 0; j < 8; ++j) ss += e[j] * e[j];
        ss = row_sum16(ss);
        const float rn = 1.0f / sqrtf(ss * (1.f / 128.f) + LN_EPS);
        const bool isq = hs < 8;
        const int t = row % TB;
        const bool rope = t < SEQ;
        const int pos = colang ? (t & 63) : (t >> 6);
        float o[8];
        if (rope) {
          const v4f* tp = (const v4f*)(TAB + (pos & 63) * 32 + i0);
          const v4f c01 = tp[0], c23 = tp[1], c45 = tp[2], c67 = tp[3];
          const float cs_[8] = {c01[0], c01[2], c23[0], c23[2], c45[0], c45[2], c67[0], c67[2]};
          const float sn_[8] = {c01[1], c01[3], c23[1], c23[3], c45[1], c45[3], c67[1], c67[3]};
#pragma unroll
          for (int j = 0; j < 8; ++j) {
            const float x = e[j] * rn * (isq ? gq_[j] : gk_[j]);
            const float px = pe[j] * rn * (isq ? pgq_[j] : pgk_[j]);
            o[j] = x * cs_[j] + (up ? px : -px) * sn_[j];
          }
        } else {
#pragma unroll
          for (int j = 0; j < 8; ++j) o[j] = e[j] * rn * (isq ? gq_[j] : gk_[j]);
        }
        v4u w; w.x = cvtpk(o[0], o[1]); w.y = cvtpk(o[2], o[3]); w.z = cvtpk(o[4], o[5]); w.w = cvtpk(o[6], o[7]);
        *(v4u*)base = w;
      }
    }
  }
}

namespace att {
constexpr int DH = 128, NW = 8, QBLK = 32, KVBLK = 64;
constexpr float SCALE = 0.088388347648318440f;
constexpr float THR = 8.f;
constexpr int LDQ = 1536, LDK = 1536, LDO = 1024;
constexpr size_t SHM_V = KVBLK * DH * 2, SHM_K = KVBLK * DH * 2;
#define KSWZ(row, colB) ((row) * 256 + ((colB) ^ (((row) & 7) << 4)))
#define SBAR() __builtin_amdgcn_sched_barrier(0)
__device__ __forceinline__ void partialSM(v16f& p0, v16f& p1, float& m_reg, float& mn, float& alpha) {
  constexpr float C = SCALE * 1.4426950408889634f;
  float pmax = p0[0];
#pragma unroll
  for (int r = 1; r < 16; ++r) pmax = fmaxf(pmax, p0[r]);
#pragma unroll
  for (int r = 0; r < 16; ++r) pmax = fmaxf(pmax, p1[r]);
  { auto rr = __builtin_amdgcn_permlane32_swap(__float_as_uint(pmax), __float_as_uint(pmax), false, false);
    pmax = fmaxf(__uint_as_float(rr[0]), __uint_as_float(rr[1])); }
  if (__builtin_expect(__all(pmax - m_reg <= THR / SCALE), 1)) { mn = m_reg; alpha = 1.f; }
  else { mn = fmaxf(m_reg, pmax); alpha = __builtin_amdgcn_exp2f((m_reg - mn) * C); m_reg = mn; }
  float mnC = -mn * C;
#pragma unroll
  for (int r = 0; r < 16; ++r) p0[r] = fmaf(p0[r], C, mnC);
#pragma unroll
  for (int r = 0; r < 16; ++r) p1[r] = fmaf(p1[r], C, mnC);
#pragma unroll
  for (int r = 0; r < 16; ++r) p0[r] = __builtin_amdgcn_exp2f(p0[r]);
}
__device__ __forceinline__ void finishSM(v16f& p0, v16f& p1, float alpha, float& l_reg, v8s& pa0, v8s& pa1, v8s& pa2, v8s& pa3) {
#pragma unroll
  for (int r = 0; r < 16; ++r) p1[r] = __builtin_amdgcn_exp2f(p1[r]);
  float ps = 0;
#pragma unroll
  for (int r = 0; r < 16; ++r) ps += p0[r];
#pragma unroll
  for (int r = 0; r < 16; ++r) ps += p1[r];
  { auto rr = __builtin_amdgcn_permlane32_swap(__float_as_uint(ps), __float_as_uint(ps), false, false);
    ps = __uint_as_float(rr[0]) + __uint_as_float(rr[1]); }
  l_reg = l_reg * alpha + ps;
#define PK4(Pv, BASE, OUT) do { unsigned a0 = cvtpk(Pv[BASE + 0], Pv[BASE + 1]), a1 = cvtpk(Pv[BASE + 2], Pv[BASE + 3]);   \
    unsigned b0 = cvtpk(Pv[BASE + 4], Pv[BASE + 5]), b1 = cvtpk(Pv[BASE + 6], Pv[BASE + 7]);                              \
    auto r0 = __builtin_amdgcn_permlane32_swap(a0, b0, false, false); auto r1 = __builtin_amdgcn_permlane32_swap(a1, b1, false, false); \
    v4u w = {r0[0], r1[0], r0[1], r1[1]}; OUT = *reinterpret_cast<v8s*>(&w); } while (0)
  PK4(p0, 0, pa0); PK4(p0, 8, pa1); PK4(p1, 0, pa2); PK4(p1, 8, pa3);
#undef PK4
}
__device__ __forceinline__ void qkt(v16f& p0, v16f& p1, const u16* Ks, const v8s* qr, int r32, int hi) {
  p0 = v16f{}; p1 = v16f{};
#pragma unroll
  for (int d0 = 0; d0 < 8; ++d0) { int cb = (d0 * 16 + hi * 8) * 2;
    v8s b0 = *reinterpret_cast<const v8s*>((const char*)Ks + KSWZ(r32, cb));
    v8s b1 = *reinterpret_cast<const v8s*>((const char*)Ks + KSWZ(32 + r32, cb));
    p0 = __builtin_amdgcn_mfma_f32_32x32x16_bf16(b0, qr[d0], p0, 0, 0, 0);
    p1 = __builtin_amdgcn_mfma_f32_32x32x16_bf16(b1, qr[d0], p1, 0, 0, 0); }
}
__device__ __forceinline__ int v_st(int k, int c) { const int kk = (k & ~0xC) | ((k & 4) << 1) | ((k & 8) >> 1); return ((kk >> 3) * 4 + (c >> 5)) * 512 + ((kk & 7) * 32 + (c & 31)) * 2; }
__device__ __forceinline__ int v_rd_base(int lane) { return ((lane & 3) << 3) | (((lane >> 2) & 3) << 6) | (((lane >> 4) & 1) << 5) | (((lane >> 5) & 1) << 8); }
constexpr int v_rd_off(int d0, int ks, int half) { return d0 * 512 + ks * 4096 + half * 2048; }
template <int OFF> __device__ __forceinline__ v4s tr_read(int vb) {
  v4s r; asm volatile("ds_read_b64_tr_b16 %0, %1 offset:%2" : "=&v"(r) : "v"(vb), "i"(OFF) : "memory"); return r;
}
template <int D0> __device__ __forceinline__ void pv_one(v16f& od, int vb, v8s pa0, v8s pa1, v8s pa2, v8s pa3) {
  const v4s l0 = tr_read<v_rd_off(D0, 0, 0)>(vb), h0 = tr_read<v_rd_off(D0, 0, 1)>(vb), l1 = tr_read<v_rd_off(D0, 1, 0)>(vb), h1 = tr_read<v_rd_off(D0, 1, 1)>(vb);
  const v4s l2 = tr_read<v_rd_off(D0, 2, 0)>(vb), h2 = tr_read<v_rd_off(D0, 2, 1)>(vb), l3 = tr_read<v_rd_off(D0, 3, 0)>(vb), h3 = tr_read<v_rd_off(D0, 3, 1)>(vb);
  asm volatile("s_waitcnt lgkmcnt(0)" ::: "memory"); SBAR();
#define PKV(L, H) (v8s){L[0], L[1], L[2], L[3], H[0], H[1], H[2], H[3]}
  od = __builtin_amdgcn_mfma_f32_32x32x16_bf16(pa0, PKV(l0, h0), od, 0, 0, 0);
  od = __builtin_amdgcn_mfma_f32_32x32x16_bf16(pa1, PKV(l1, h1), od, 0, 0, 0);
  od = __builtin_amdgcn_mfma_f32_32x32x16_bf16(pa2, PKV(l2, h2), od, 0, 0, 0);
  od = __builtin_amdgcn_mfma_f32_32x32x16_bf16(pa3, PKV(l3, h3), od, 0, 0, 0);
#undef PKV
}
__device__ __forceinline__ void pv_d0(v16f* o, int vb, v8s pa0, v8s pa1, v8s pa2, v8s pa3) {
  pv_one<0>(o[0], vb, pa0, pa1, pa2, pa3); pv_one<1>(o[1], vb, pa0, pa1, pa2, pa3); pv_one<2>(o[2], vb, pa0, pa1, pa2, pa3); pv_one<3>(o[3], vb, pa0, pa1, pa2, pa3);
}
__device__ __forceinline__ void attn_dense_body(const u16* __restrict__ Qb, const u16* __restrict__ Kh, const u16* __restrict__ Vh,
                                                u16* __restrict__ Ob, int seq, char* lds, const float* __restrict__ qn, const v2f* __restrict__ TAB, int t0, bool rope) {
  const int tid = get_tid(), wid = tid >> 6, lane = tid & 63, r32 = lane & 31, hi = lane >> 5;
  u16* V_lds = (u16*)lds; u16* K_lds = (u16*)(lds + 2 * SHM_V);
  float* ws = (float*)(lds + 2 * SHM_V + 2 * SHM_K) + wid * 64; float* li_l = ws; float* al_l = ws + 32;
  float m_reg = -1e30f, l_reg = 0; v16f o[4] = {}; v8s qr[8];
  const u16* Qw = Qb + (long)(wid * QBLK + r32) * LDQ + hi * 8;
#pragma unroll
  for (int d0 = 0; d0 < 8; ++d0) qr[d0] = *reinterpret_cast<const v8s*>(Qw + d0 * 16);
  {
    float xq[8][8]; float ss = 0.f;
#pragma unroll
    for (int d0 = 0; d0 < 8; ++d0) {
      const v4u w = *reinterpret_cast<const v4u*>(&qr[d0]);
#pragma unroll
      for (int j = 0; j < 4; ++j) { xq[d0][2 * j] = bflo(w[j]); xq[d0][2 * j + 1] = bfhi(w[j]); ss += xq[d0][2 * j] * xq[d0][2 * j] + xq[d0][2 * j + 1] * xq[d0][2 * j + 1]; }
    }
    ss += __shfl_xor(ss, 32);
    const float rn = 1.0f / sqrtf(ss * (1.f / 128.f) + LN_EPS);
#pragma unroll
    for (int d0 = 0; d0 < 8; ++d0) {
      const v4f g0 = *(const v4f*)(qn + d0 * 16 + hi * 8), g1 = *(const v4f*)(qn + d0 * 16 + hi * 8 + 4);
#pragma unroll
      for (int e = 0; e < 4; ++e) { xq[d0][e] *= rn * g0[e]; xq[d0][4 + e] *= rn * g1[e]; }
    }
    if (rope) {
      const int t = t0 + wid * QBLK + r32;
#pragma unroll
      for (int m = 0; m < 2; ++m)
#pragma unroll
        for (int ax = 0; ax < 2; ++ax) {
          const int pos = ax ? (t & 63) : (t >> 6);
          const v4f* tp = (const v4f*)(TAB + pos * 32 + 16 * m + 8 * hi);
          const int da = m + 4 * ax, db = da + 2;
#pragma unroll
          for (int e2 = 0; e2 < 4; ++e2) {
            const v4f cs = tp[e2];
#pragma unroll
            for (int k = 0; k < 2; ++k) {
              const float c_ = cs[2 * k], s_ = cs[2 * k + 1];
              const float xa = xq[da][2 * e2 + k], xb = xq[db][2 * e2 + k];
              xq[da][2 * e2 + k] = xa * c_ - xb * s_;
              xq[db][2 * e2 + k] = xb * c_ + xa * s_;
            }
          }
        }
    }
#pragma unroll
    for (int d0 = 0; d0 < 8; ++d0) {
      v4u w; w.x = cvtpk(xq[d0][0], xq[d0][1]); w.y = cvtpk(xq[d0][2], xq[d0][3]); w.z = cvtpk(xq[d0][4], xq[d0][5]); w.w = cvtpk(xq[d0][6], xq[d0][7]);
      qr[d0] = *reinterpret_cast<v8s*>(&w);
    }
  }
  const int sr = tid >> 4, sc = (tid & 15) * 8, vst0 = v_st(sr, sc), vst1 = v_st(32 + sr, sc);
  const int vb0 = (int)(uintptr_t)V_lds + v_rd_base(lane);
  struct { v8s vs0, vs1, ks0, ks1; } sr_[2];
#define SLOAD(i, k0) do { sr_[i].vs0 = *(const v8s*)(&Vh[(long)((k0) + sr) * LDK + sc]); sr_[i].vs1 = *(const v8s*)(&Vh[(long)((k0) + 32 + sr) * LDK + sc]); \
    sr_[i].ks0 = *(const v8s*)(&Kh[(long)((k0) + sr) * LDK + sc]); sr_[i].ks1 = *(const v8s*)(&Kh[(long)((k0) + 32 + sr) * LDK + sc]); } while (0)
#define SWRITE(b, i) do { *(v8s*)((char*)V_lds + (b) * SHM_V + vst0) = sr_[i].vs0;          \
    *(v8s*)((char*)V_lds + (b) * SHM_V + vst1) = sr_[i].vs1; int kc = sc * 2;               \
    *(v8s*)((char*)K_lds + (b) * SHM_K + KSWZ(sr, kc)) = sr_[i].ks0;                       \
    *(v8s*)((char*)K_lds + (b) * SHM_K + KSWZ(32 + sr, kc)) = sr_[i].ks1; } while (0)
#define SWAIT() asm volatile("s_waitcnt vmcnt(4)" ::: "memory")
#define RESC(a) do { if (__any((a) < 1.f)) { if (hi == 0) al_l[r32] = (a); asm volatile("s_waitcnt lgkmcnt(0)" ::: "memory"); \
    for (int d = 0; d < 4; ++d) for (int r = 0; r < 16; ++r) o[d][r] *= al_l[crow(r, hi)]; } } while (0)
  v16f pA0, pA1, pB0, pB1; float mnA, mnB, alA, alB; v8s pa0, pa1, pa2, pa3; const int NT = seq / KVBLK;
  constexpr int SE = 0, SO = 1;
  SLOAD(SE, 0); asm volatile("s_waitcnt vmcnt(0)" ::: "memory"); SWRITE(0, SE); __syncthreads();
  qkt(pA0, pA1, K_lds, qr, r32, hi); partialSM(pA0, pA1, m_reg, mnA, alA);
  SLOAD(SO, KVBLK); if (2 < NT) SLOAD(SE, 2 * KVBLK);
  SWAIT(); SWRITE(1, SO); __syncthreads();
  for (int j = 1; j + 1 < NT; j += 2) {
    SBAR(); qkt(pB0, pB1, (u16*)((char*)K_lds + SHM_K), qr, r32, hi);
    finishSM(pA0, pA1, alA, l_reg, pa0, pa1, pa2, pa3); SBAR();
    SLOAD(SO, (j + 2) * KVBLK); SBAR();
    pv_d0(o, vb0, pa0, pa1, pa2, pa3); partialSM(pB0, pB1, m_reg, mnB, alB);
    __syncthreads(); SWAIT(); SWRITE(0, SE);
    RESC(alB); __syncthreads();
    SBAR(); qkt(pA0, pA1, K_lds, qr, r32, hi);
    finishSM(pB0, pB1, alB, l_reg, pa0, pa1, pa2, pa3); SBAR();
    if (j + 3 < NT) SLOAD(SE, (j + 3) * KVBLK); SBAR();
    pv_d0(o, vb0 + (int)SHM_V, pa0, pa1, pa2, pa3); partialSM(pA0, pA1, m_reg, mnA, alA);
    __syncthreads(); SWAIT(); SWRITE(1, SO);
    RESC(alA); __syncthreads();
  }
  SBAR(); qkt(pB0, pB1, (u16*)((char*)K_lds + SHM_K), qr, r32, hi);
  finishSM(pA0, pA1, alA, l_reg, pa0, pa1, pa2, pa3); SBAR();
  pv_d0(o, vb0, pa0, pa1, pa2, pa3); partialSM(pB0, pB1, m_reg, mnB, alB);
  __syncthreads(); RESC(alB);
  finishSM(pB0, pB1, alB, l_reg, pa0, pa1, pa2, pa3); SBAR();
  pv_d0(o, vb0 + (int)SHM_V, pa0, pa1, pa2, pa3);
  if (hi == 0) li_l[r32] = l_reg; asm volatile("s_waitcnt lgkmcnt(0)" ::: "memory");
  float rli[16];
#pragma unroll
  for (int r = 0; r < 16; ++r) rli[r] = __builtin_amdgcn_rcpf(li_l[crow(r, hi)]);
  u16* Ow = Ob + (long)(wid * QBLK) * LDO;
#pragma unroll
  for (int r = 0; r < 16; ++r) { int orow = crow(r, hi);
#pragma unroll
    for (int d0 = 0; d0 < 4; ++d0) { const float val = o[d0][r] * rli[r]; Ow[(long)orow * LDO + d0 * 32 + r32] = (u16)(cvtpk(val, val) & 0xffffu); } }
#undef SLOAD
#undef SWRITE
#undef SWAIT
#undef RESC
}
}

__device__ void gqa_attention(PP p, unsigned char* smem, bool want_ctx, int slot) {
  const u16* QKV = (const u16*)(p->ws + OFF_AR + AR_QKV);
  u16* O = (u16*)(p->ws + OFF_AR + AR_ATT_O);
  const int nitems = 1024 + (want_ctx ? 64 : 0);
  for (int item = get_bid(); item < nitems; item += get_gdim()) {
    int b, h, qrow, krow, seq;
    if (item < 1024) { b = item >> 7; const int rem = item & 127; h = rem >> 4; qrow = b * TB + (rem & 15) * 256; krow = b * TB; seq = TB; }
    else { const int ci = item - 1024; b = ci >> 3; h = ci & 7; qrow = b * TB + SEQ; krow = b * TB + SEQ; seq = CTXL; }
    const int kvh = h >> 2;
    att::attn_dense_body(QKV + (size_t)qrow * 1536 + h * 128, QKV + (size_t)krow * 1536 + 1024 + kvh * 128, QKV + (size_t)krow * 1536 + 1280 + kvh * 128,
                         O + (size_t)qrow * 1024 + h * 128, seq, (char*)smem, p->att_qn + slot * 128, (const v2f*)(p->ws + OFF_TAB), qrow - b * TB, item < 1024);
    __syncthreads();
  }
}

__device__ void na_attention(PP p, unsigned char* smem, bool want_ctx) {
  const u16* QK = (const u16*)(p->ws + OFF_AR + AR_NA_QK);
  const u16* VT = (const u16*)(p->ws + OFF_AR + AR_NA_VT);
  u16* O = (u16*)(p->ws + OFF_AR + AR_NA_O);
  const int tid = get_tid(), wid = tid >> 6, lane = tid & 63, r32 = lane & 31, hi = lane >> 5;
  float* rpbl = (float*)smem + wid * 640 + 64;
  u16* Kb = (u16*)(smem + 24576) + wid * 4864;
  u16* Vb = Kb + 32 * 72;
  constexpr float C1 = 0.125f * LOG2E;
  const int nrows = 64 + (want_ctx ? 4 : 0);
  for (int item = get_bid(); item < NB * nrows * 2; item += get_gdim()) {
    int hh, rr, b;
    if (item < NB * 64 * 2) { hh = item & 1; rr = (item >> 1) & 63; b = item >> 7; }
    else { const int ci = item - NB * 64 * 2; hh = ci & 1; rr = 64 + ((ci >> 1) & 3); b = ci >> 3; }
    const int h = hh * 8 + wid;
    const bool isctx = rr >= 64;
    const int r = isctx ? 0 : rr;
    for (int e = lane; e < 465; e += 64) rpbl[e] = p->na_rpb[h * 465 + e] * LOG2E;
    const int r0 = min(max(r - 4, 0), 56);
    const size_t qrow0 = (size_t)b * TB + (isctx ? SEQ + (rr - 64) * 64 : r * 64);
    v8s qf[2][4];
#pragma unroll
    for (int qb = 0; qb < 2; ++qb)
#pragma unroll
      for (int ks = 0; ks < 4; ++ks) qf[qb][ks] = *(const v8s*)(QK + (qrow0 + qb * 32 + r32) * 2048 + h * 64 + ks * 16 + hi * 8);
    v16f o[2][2];
#pragma unroll
    for (int a = 0; a < 2; ++a)
#pragma unroll
      for (int c = 0; c < 2; ++c) o[a][c] = v16f{};
    float m_run[2] = {-1e30f, -1e30f}, l_run[2] = {0.f, 0.f};
    v8s kreg[4], vreg[4];
#define NA_KEYROW(tt) ((size_t)b * TB + ((tt) < 16 ? (r0 + ((tt) >> 1)) * 64 + ((tt) & 1) * 32 : SEQ + ((tt) - 16) * 32))
#define NA_GLOAD_K(tt) do { const size_t _kr0 = NA_KEYROW(tt); \
      _Pragma("unroll") for (int i = 0; i < 4; ++i) kreg[i] = *(const v8s*)(QK + (_kr0 + (lane >> 3) + 8 * i) * 2048 + 1024 + h * 64 + (lane & 7) * 8); } while (0)
#define NA_GLOAD_V(tt) do { const size_t _kr0 = NA_KEYROW(tt); \
      _Pragma("unroll") for (int i = 0; i < 4; ++i) vreg[i] = *(const v8s*)(VT + (size_t)(h * 64 + (lane >> 2) + 16 * i) * M + _kr0 + (lane & 3) * 8); } while (0)
    NA_GLOAD_K(isctx ? 16 : 0); NA_GLOAD_V(isctx ? 16 : 0);
    for (int t = isctx ? 16 : 0; t < 24; ++t) {
      const bool local = t < 16; const int j = t >> 1, hf = t & 1;
#pragma unroll
      for (int i = 0; i < 4; ++i) {
        *(v8s*)(Kb + ((lane >> 3) + 8 * i) * 72 + (lane & 7) * 8) = kreg[i];
        *(v8s*)(Vb + ((lane >> 2) + 16 * i) * 40 + (lane & 3) * 8) = vreg[i];
      }
      if (t + 1 < 24) { NA_GLOAD_K(t + 1); NA_GLOAD_V(t + 1); }
      v8s kf[4];
#pragma unroll
      for (int ks = 0; ks < 4; ++ks) kf[ks] = *(const v8s*)(Kb + r32 * 72 + ks * 16 + hi * 8);
      v8s pf[2][2];
      v16f sc2[2];
#pragma unroll
      for (int qb = 0; qb < 2; ++qb) {
        sc2[qb] = v16f{};
#pragma unroll
        for (int ks = 0; ks < 4; ++ks) sc2[qb] = __builtin_amdgcn_mfma_f32_32x32x16_bf16(kf[ks], qf[qb][ks], sc2[qb], 0, 0, 0);
      }
#pragma unroll
      for (int qb = 0; qb < 2; ++qb) {
        v16f scq = sc2[qb];
        const int c = qb * 32 + r32; const int cs = min(max(c - 8, 0), 48);
        float mx = -3e38f;
        if (local) {
          const float* bp = rpbl + (r0 + j - r + 7) * 31 + (hf * 32 + 4 * hi - c + 15);
          const int vlo = hf * 32 + 4 * hi - cs;
#pragma unroll
          for (int hb = 0; hb < 2; ++hb) {
            float bv[8];
#pragma unroll
            for (int i = 0; i < 8; ++i) bv[i] = bp[8 * (2 * hb + (i >> 2)) + (i & 3)];
            asm volatile("" : "+v"(bv[0]), "+v"(bv[1]), "+v"(bv[2]), "+v"(bv[3]), "+v"(bv[4]), "+v"(bv[5]), "+v"(bv[6]), "+v"(bv[7]));
#pragma unroll
            for (int i = 0; i < 8; ++i) {
              const int K_i = 8 * (2 * hb + (i >> 2)) + (i & 3);
              const bool valid = (unsigned)(vlo + K_i) < 16u;
              const float s = valid ? fmaf(scq[8 * hb + i], C1, bv[i]) : -3e38f;
              scq[8 * hb + i] = s; mx = fmaxf(mx, s);
            }
          }
        } else {
#pragma unroll
          for (int i = 0; i < 16; ++i) { const float s = scq[i] * C1; scq[i] = s; mx = fmaxf(mx, s); }
        }
        { auto rr = __builtin_amdgcn_permlane32_swap(__float_as_uint(mx), __float_as_uint(mx), false, false); mx = fmaxf(__uint_as_float(rr[0]), __uint_as_float(rr[1])); }
        const float mnew = fmaxf(m_run[qb], mx);
        const float alpha = __builtin_amdgcn_exp2f(m_run[qb] - mnew);
        m_run[qb] = mnew;
        float ps = 0.f;
#pragma unroll
        for (int i = 0; i < 16; ++i) { const float e = __builtin_amdgcn_exp2f(scq[i] - mnew); scq[i] = e; ps += e; }
        { auto rr = __builtin_amdgcn_permlane32_swap(__float_as_uint(ps), __float_as_uint(ps), false, false); ps = __uint_as_float(rr[0]) + __uint_as_float(rr[1]); }
        l_run[qb] = l_run[qb] * alpha + ps;
#pragma unroll
        for (int db = 0; db < 2; ++db)
#pragma unroll
          for (int i = 0; i < 16; ++i) o[db][qb][i] *= alpha;
#pragma unroll
        for (int s = 0; s < 2; ++s) {
          v4u w; w.x = cvtpk(scq[8 * s + 0], scq[8 * s + 1]); w.y = cvtpk(scq[8 * s + 2], scq[8 * s + 3]);
          w.z = cvtpk(scq[8 * s + 4], scq[8 * s + 5]); w.w = cvtpk(scq[8 * s + 6], scq[8 * s + 7]);
          pf[qb][s] = *reinterpret_cast<v8s*>(&w);
        }
      }
      v8s vf[2][2];
#pragma unroll
      for (int db = 0; db < 2; ++db)
#pragma unroll
        for (int s = 0; s < 2; ++s) {
          const u16* vp = Vb + (db * 32 + r32) * 40 + 16 * s + 4 * hi;
          const v4s lo = *(const v4s*)vp, hi4 = *(const v4s*)(vp + 8);
          vf[db][s] = (v8s){lo[0], lo[1], lo[2], lo[3], hi4[0], hi4[1], hi4[2], hi4[3]};
        }
#pragma unroll
      for (int db = 0; db < 2; ++db)
#pragma unroll
        for (int qb = 0; qb < 2; ++qb)
#pragma unroll
          for (int s = 0; s < 2; ++s) o[db][qb] = __builtin_amdgcn_mfma_f32_32x32x16_bf16(vf[db][s], pf[qb][s], o[db][qb], 0, 0, 0);
    }
#pragma unroll
    for (int qb = 0; qb < 2; ++qb) {
      const float rl = 1.0f / l_run[qb];
      u16* orow = O + (qrow0 + qb * 32 + r32) * 1024 + h * 64;
#pragma unroll
      for (int db = 0; db < 2; ++db)
#pragma unroll
        for (int g4 = 0; g4 < 4; ++g4) {
          v2u w; w.x = cvtpk(o[db][qb][4 * g4 + 0] * rl, o[db][qb][4 * g4 + 1] * rl); w.y = cvtpk(o[db][qb][4 * g4 + 2] * rl, o[db][qb][4 * g4 + 3] * rl);
          *(v2u*)(orow + db * 32 + 8 * g4 + 4 * hi) = w;
        }
    }
  }
}

__device__ __forceinline__ int scan_row(int b, int dir, int s) {
  const int t = s < CTXL ? (dir ? TB - 1 - s : SEQ + s) : (dir ? SEQ - 1 - (s - CTXL) : s - CTXL);
  return b * TB + t;
}
__device__ __forceinline__ float dot4(v4f a, v4f b) { return (a[0] * b[0] + a[1] * b[1]) + (a[2] * b[2] + a[3] * b[3]); }

__device__ void rwkv_scan(PP p, unsigned char* smem, int slot) {
  constexpr int T = 32, NCH = TB / T;
  float* VEC = (float*)smem; float* VV = (float*)(smem + 40960); float* SC = (float*)(smem + 49152); float* YB = (float*)(smem + 49408); float* TMP = (float*)(smem + 57600);
  const int tid = get_tid(), wid = tid >> 6, lane = tid & 63;
  const u16* Rg = (const u16*)(p->ws + OFF_AR + AR_R); const u16* Kg = (const u16*)(p->ws + OFF_AR + AR_K); const u16* Vg = (const u16*)(p->ws + OFF_AR + AR_V);
  const u16* L1 = (const u16*)(p->ws + OFF_AR + AR_L1);
  float* BON = (float*)(p->ws + OFF_BON);
  for (int item = get_bid(); item < 256; item += get_gdim()) {
    const int dir = item >> 7, b = (item >> 4) & 7, h = item & 15;
    u16* Yd = (u16*)(p->ws + OFF_AR + (dir ? AR_Y1 : AR_Y0));
    const int st = tid >> 4, c0 = (tid & 15) * 4, ch = h * 64 + c0;
    const v4f w0 = *(const v4f*)(p->rw_w0 + (size_t)(slot * 2 + dir) * 1024 + ch), a0 = *(const v4f*)(p->rw_a0 + (size_t)(slot * 2 + dir) * 1024 + ch);
    const v4f kkc = *(const v4f*)(p->rw_kk + (size_t)slot * 1024 + ch), kac = *(const v4f*)(p->rw_ka + (size_t)slot * 1024 + ch), rkc = *(const v4f*)(p->rw_rk + (size_t)slot * 1024 + ch);
    const int qn = wid >> 2, rb = (wid >> 1) & 1, cbp = wid & 1, l16 = lane & 15, lq = lane >> 4;
    const u16* WT = (const u16*)(p->ws + OFF_WB + (qn ? WB_RW_A2T : WB_RW_W2T)) + ((size_t)dir * 1024 + h * 64) * 64;
    v8s bfr[2][2];
#pragma unroll
    for (int cb = 0; cb < 2; ++cb)
#pragma unroll
      for (int ks = 0; ks < 2; ++ks) bfr[cb][ks] = *(const v8s*)(WT + (size_t)((cbp * 2 + cb) * 16 + l16) * 64 + ks * 32 + lq * 8);
    v4f S0 = {0.f, 0.f, 0.f, 0.f}, S1 = {0.f, 0.f, 0.f, 0.f};
    const int i0 = 8 * wid + 2 * (lane >> 4);
    v2u pr_r, pr_k, pr_v; v8s pa[2];
#define RW_PREFETCH(cc) do { const int _row = scan_row(b, dir, (cc) * T + st); \
      pr_r = *(const v2u*)(Rg + (size_t)_row * 1024 + ch); pr_k = *(const v2u*)(Kg + (size_t)_row * 1024 + ch); pr_v = *(const v2u*)(Vg + (size_t)_row * 1024 + ch); \
      const int _rowA = scan_row(b, dir, (cc) * T + rb * 16 + l16); \
      pa[0] = *(const v8s*)(L1 + (size_t)_rowA * 384 + qn * 128 + dir * 64 + lq * 8); pa[1] = *(const v8s*)(L1 + (size_t)_rowA * 384 + qn * 128 + dir * 64 + 32 + lq * 8); } while (0)
    RW_PREFETCH(0);
    for (int c = 0; c < NCH; ++c) {
      const int cur_row = scan_row(b, dir, c * T + st);
#pragma unroll
      for (int cb = 0; cb < 2; ++cb) {
        v4f acc = {0.f, 0.f, 0.f, 0.f};
        acc = __builtin_amdgcn_mfma_f32_16x16x32_bf16(pa[0], bfr[cb][0], acc, 0, 0, 0);
        acc = __builtin_amdgcn_mfma_f32_16x16x32_bf16(pa[1], bfr[cb][1], acc, 0, 0, 0);
#pragma unroll
        for (int jj = 0; jj < 4; ++jj) TMP[(qn * T + rb * 16 + lq * 4 + jj) * 64 + (cbp * 2 + cb) * 16 + l16] = acc[jj];
      }
      __syncthreads();
      {
        const v4f wp = *(const v4f*)(TMP + st * 64 + c0) + w0, ap = *(const v4f*)(TMP + (T + st) * 64 + c0) + a0;
        v4f r, k, v, dec, a, kkr;
        r[0] = bflo(pr_r.x); r[1] = bfhi(pr_r.x); r[2] = bflo(pr_r.y); r[3] = bfhi(pr_r.y);
        k[0] = bflo(pr_k.x); k[1] = bfhi(pr_k.x); k[2] = bflo(pr_k.y); k[3] = bfhi(pr_k.y);
        v[0] = bflo(pr_v.x); v[1] = bfhi(pr_v.x); v[2] = bflo(pr_v.y); v[3] = bfhi(pr_v.y);
#pragma unroll
        for (int e = 0; e < 4; ++e) {
          const float z = -wp[e];
          const float sp = z > 20.f ? z : log1pf(__expf(z));
          dec[e] = __expf(-__expf(-sp - 0.5f));
          a[e] = 1.f / (1.f + __expf(-ap[e]));
          kkr[e] = k[e] * kkc[e];
        }
        const float ss = row_sum16(dot4(kkr, kkr));
        const float rn = 1.0f / sqrtf(fmaxf(ss, 1e-12f));
        const v4f kk = kkr * rn;
        const v4f kd = k * ((a - 1.f) * kac + 1.f);
        const v4f bv = kk * a;
        const float br = row_sum16(dot4(bv, r)), kr = row_sum16(dot4(kd, r)), bon = row_sum16(dot4(r * kd, rkc));
        float* vb = VEC + st * 320 + c0;
        *(v4f*)(vb) = -kk; *(v4f*)(vb + 64) = dec * r; *(v4f*)(vb + 128) = dec; *(v4f*)(vb + 192) = bv; *(v4f*)(vb + 256) = kd;
        *(v4f*)(VV + st * 64 + c0) = v;
        if ((tid & 15) == 0) { SC[st * 2] = br; SC[st * 2 + 1] = kr; BON[((size_t)dir * M + cur_row) * 16 + h] = bon; }
      }
      __syncthreads();
      if (c + 1 < NCH) RW_PREFETCH(c + 1);
      for (int s = 0; s < T; ++s) {
        const float* vb = VEC + s * 320 + (lane & 15) * 4;
        const v4f a4 = *(const v4f*)(vb), wr4 = *(const v4f*)(vb + 64), w4 = *(const v4f*)(vb + 128), b4 = *(const v4f*)(vb + 192), k4 = *(const v4f*)(vb + 256);
        const v2f v2 = *(const v2f*)(VV + s * 64 + i0), sc2 = *(const v2f*)(SC + s * 2);
        float p0 = dot4(S0, a4), p1 = dot4(S1, a4), y0 = dot4(S0, wr4), y1 = dot4(S1, wr4);
        p0 = row_sum16(p0); p1 = row_sum16(p1); y0 = row_sum16(y0); y1 = row_sum16(y1);
        y0 += p0 * sc2.x + v2.x * sc2.y; y1 += p1 * sc2.x + v2.y * sc2.y;
        S0 = S0 * w4 + b4 * p0 + k4 * v2.x; S1 = S1 * w4 + b4 * p1 + k4 * v2.y;
        if ((lane & 15) == 0) *(v2f*)(YB + s * 64 + i0) = (v2f){y0, y1};
      }
      __syncthreads();
      {
        const v4f y4 = *(const v4f*)(YB + st * 64 + c0);
        v2u w; w.x = cvtpk(y4[0], y4[1]); w.y = cvtpk(y4[2], y4[3]);
        *(v2u*)(Yd + (size_t)cur_row * 1024 + ch) = w;
      }
    }
#undef RW_PREFETCH
    __syncthreads();
  }
}

#define LBAR() do { asm volatile("s_waitcnt lgkmcnt(0)" ::: "memory"); __builtin_amdgcn_s_barrier(); asm volatile("" ::: "memory"); } while (0)
__device__ void rwkv_scan2(PP p, unsigned char* smem, int slot) {
  constexpr int T = 32, NCH = TB / T;
  float* TMP = (float*)(smem);
  float* LW  = (float*)(smem + 16384);
  float* YB  = (float*)(smem + 24576);
  u16* AT = (u16*)(smem + 32768);
  u16* RT = (u16*)(smem + 32768 + 4608);
  u16* BT = (u16*)(smem + 32768 + 2 * 4608);
  u16* KT = (u16*)(smem + 32768 + 3 * 4608);
  u16* BKT = (u16*)(smem + 51200);
  float* GC = (float*)(smem + 69632);
  unsigned char* UBLK = smem + 107520;
  float* P1 = (float*)(smem + 73728);
  u16* CV = (u16*)(smem + 78848);
  u16* SB = (u16*)(smem + 89088);
  const int x_tid = get_tid();
  const u16* Rg = (const u16*)(p->ws + OFF_AR + AR_R); const u16* Kg = (const u16*)(p->ws + OFF_AR + AR_K); const u16* Vg = (const u16*)(p->ws + OFF_AR + AR_V);
  const u16* L1 = (const u16*)(p->ws + OFF_AR + AR_L1);
  float* BON = (float*)(p->ws + OFF_BON);
  for (int item = get_bid(); item < 256; item += get_gdim()) {
    const int dir = item >> 7, b = (item >> 4) & 7, h = item & 15;
    u16* Yd = (u16*)(p->ws + OFF_AR + (dir ? AR_Y1 : AR_Y0));
#define OPQV(v) ({ int _t = (v); asm volatile("" : "+v"(_t)); _t; })
    const int x_wid = __builtin_amdgcn_readfirstlane(x_tid >> 6);
    int tid = x_tid, wid = x_wid, lane = tid & 63;
    int st = tid >> 4, c0 = (tid & 15) * 4, ch = h * 64 + c0, su = st >> 4, tt = st & 15;
    const v4f w0 = *(const v4f*)(p->rw_w0 + (size_t)(slot * 2 + dir) * 1024 + ch), a0 = *(const v4f*)(p->rw_a0 + (size_t)(slot * 2 + dir) * 1024 + ch);
    const v4f kkc = *(const v4f*)(p->rw_kk + (size_t)slot * 1024 + ch), kac = *(const v4f*)(p->rw_ka + (size_t)slot * 1024 + ch), rkc = *(const v4f*)(p->rw_rk + (size_t)slot * 1024 + ch);
    int qn = wid >> 2, rb_ = (wid >> 1) & 1, cbp = wid & 1, l16 = lane & 15, lq = lane >> 4;
    const u16* WT = (const u16*)(p->ws + OFF_WB + (qn ? WB_RW_A2T : WB_RW_W2T)) + ((size_t)dir * 1024 + h * 64) * 64;
    v8s bfr[2][2];
#pragma unroll
    for (int cb = 0; cb < 2; ++cb)
#pragma unroll
      for (int ks = 0; ks < 2; ++ks) bfr[cb][ks] = *(const v8s*)(WT + (size_t)((cbp * 2 + cb) * 16 + l16) * 64 + ks * 32 + lq * 8);
    v4f S[2]; S[0] = (v4f){0.f, 0.f, 0.f, 0.f}; S[1] = (v4f){0.f, 0.f, 0.f, 0.f};
    for (int e = tid; e < 64 * 72; e += 512) SB[e] = 0;
    for (int e = tid; e < 2 * 64 * 40; e += 512) CV[e] = 0;
    for (int e = tid; e < 2 * 16 * 40; e += 512) { const int uu = e / 640, r = e - uu * 640; ((u16*)(UBLK + uu * 3584 + 1024))[r] = 0; }
    v2u pr_r, pr_k, pr_v; v8s pa[2];
#define RW_PREFETCH(cc) do { const int _row = scan_row(b, dir, (cc) * T + st); \
      pr_r = *(const v2u*)(Rg + (size_t)_row * 1024 + ch); pr_k = *(const v2u*)(Kg + (size_t)_row * 1024 + ch); pr_v = *(const v2u*)(Vg + (size_t)_row * 1024 + ch); \
      const int _rowA = scan_row(b, dir, (cc) * T + rb_ * 16 + l16); \
      pa[0] = *(const v8s*)(L1 + (size_t)_rowA * 384 + qn * 128 + dir * 64 + lq * 8); pa[1] = *(const v8s*)(L1 + (size_t)_rowA * 384 + qn * 128 + dir * 64 + 32 + lq * 8); } while (0)
    RW_PREFETCH(0);
    for (int c = 0; c < NCH; ++c) {
      tid = OPQV(x_tid); lane = tid & 63; st = tid >> 4; c0 = (tid & 15) * 4; ch = h * 64 + c0; su = st >> 4; tt = st & 15; l16 = lane & 15; lq = lane >> 4;
      const int cur_row = scan_row(b, dir, c * T + st);
#pragma unroll
      for (int cb = 0; cb < 2; ++cb) {
        v4f acc = {0.f, 0.f, 0.f, 0.f};
        acc = __builtin_amdgcn_mfma_f32_16x16x32_bf16(pa[0], bfr[cb][0], acc, 0, 0, 0);
        acc = __builtin_amdgcn_mfma_f32_16x16x32_bf16(pa[1], bfr[cb][1], acc, 0, 0, 0);
#pragma unroll
        for (int jj = 0; jj < 4; ++jj) TMP[(qn * T + rb_ * 16 + lq * 4 + jj) * 64 + (cbp * 2 + cb) * 16 + l16] = acc[jj];
      }
      LBAR();
      v4f r, k, v, lwv, a, kkr;
      {
        const v4f wp = *(const v4f*)(TMP + st * 64 + c0) + w0, ap = *(const v4f*)(TMP + (T + st) * 64 + c0) + a0;
        r[0] = bflo(pr_r.x); r[1] = bfhi(pr_r.x); r[2] = bflo(pr_r.y); r[3] = bfhi(pr_r.y);
        k[0] = bflo(pr_k.x); k[1] = bfhi(pr_k.x); k[2] = bflo(pr_k.y); k[3] = bfhi(pr_k.y);
        v[0] = bflo(pr_v.x); v[1] = bfhi(pr_v.x); v[2] = bflo(pr_v.y); v[3] = bfhi(pr_v.y);
#pragma unroll
        for (int e = 0; e < 4; ++e) {
          const float z = -wp[e];
          const float sp = fmaxf(z, 0.f) + __logf(1.f + __expf(-fabsf(z)));
          lwv[e] = -__expf(-sp - 0.5f);
          a[e] = __builtin_amdgcn_rcpf(1.f + __expf(-ap[e]));
          kkr[e] = k[e] * kkc[e];
        }
        *(v4f*)(LW + st * 64 + c0) = lwv;
      }
      if (c + 1 < NCH) RW_PREFETCH(c + 1);
      LBAR();
      {
        const int pu = wid >> 2, pj = wid & 3;
        v4f acc = {0.f, 0.f, 0.f, 0.f};
#pragma unroll
        for (int ks = 0; ks < 4; ++ks) {
          const int s = 4 * ks + lq;
          const float av = (s <= l16) ? 1.f : 0.f;
          const float bv_ = LW[(pu * 16 + s) * 64 + 16 * pj + l16];
          acc = __builtin_amdgcn_mfma_f32_16x16x4f32(av, bv_, acc, 0, 0, 0);
        }
#pragma unroll
        for (int jj = 0; jj < 4; ++jj) TMP[(pu * 16 + 4 * lq + jj) * 64 + 16 * pj + l16] = acc[jj];
      }
      LBAR();
      {
        const float ss = row_sum16(dot4(kkr, kkr));
        const float rn = __builtin_amdgcn_rsqf(fmaxf(ss, 1e-12f));
        const v4f kk = kkr * rn;
        const v4f kd = k * ((a - 1.f) * kac + 1.f);
        const v4f bv = kk * a;
        const float bon = row_sum16(dot4(r * kd, rkc));
        const v4f ci = *(const v4f*)(TMP + st * 64 + c0);
        const v4f ce = ci - lwv;
        v4f eci, ece, eni;
#pragma unroll
        for (int e = 0; e < 4; ++e) { eci[e] = __expf(ci[e]); ece[e] = __expf(ce[e]); eni[e] = __builtin_amdgcn_rcpf(eci[e]); }
        const v4f at = -kk * ece, rt = r * eci, bt = bv * eni, kt = kd * eni;
        const int ro = (su * 16 + tt) * 72 + c0;
        { v2u w; w.x = cvtpk(at[0], at[1]); w.y = cvtpk(at[2], at[3]); *(v2u*)(AT + ro) = w; }
        { v2u w; w.x = cvtpk(rt[0], rt[1]); w.y = cvtpk(rt[2], rt[3]); *(v2u*)(RT + ro) = w; }
        { v2u w; w.x = cvtpk(bt[0], bt[1]); w.y = cvtpk(bt[2], bt[3]); *(v2u*)(BT + ro) = w; }
        { v2u w; w.x = cvtpk(kt[0], kt[1]); w.y = cvtpk(kt[2], kt[3]); *(v2u*)(KT + ro) = w; }
#pragma unroll
        for (int e = 0; e < 4; ++e) {
          u16* bk = BKT + (su * 64 + c0 + e) * 40 + tt;
          bk[0] = (u16)(cvtpk(bt[e], bt[e]) & 0xffffu); bk[16] = (u16)(cvtpk(kt[e], kt[e]) & 0xffffu);
          CV[(su * 64 + c0 + e) * 40 + 16 + tt] = (u16)(cvtpk(v[e], v[e]) & 0xffffu);
        }
        if (tt == 15) *(v4f*)(GC + su * 64 + c0) = eci;
        if ((tid & 15) == 0) BON[((size_t)dir * M + cur_row) * 16 + h] = bon;
      }
      LBAR();
      {
        const int uu = wid >> 2, q = wid & 3;
        const u16* Am = (q & 1) ? KT : BT; const u16* Bm = (q & 2) ? RT : AT;
        v4f acc = {0.f, 0.f, 0.f, 0.f};
#pragma unroll
        for (int ks = 0; ks < 2; ++ks) {
          const v8s A = *(const v8s*)(Am + (uu * 16 + l16) * 72 + ks * 32 + lq * 8);
          const v8s B = *(const v8s*)(Bm + (uu * 16 + l16) * 72 + ks * 32 + lq * 8);
          acc = __builtin_amdgcn_mfma_f32_16x16x32_bf16(A, B, acc, 0, 0, 0);
        }
        float* UBTw = (float*)(UBLK + uu * 3584); u16* UKBw = (u16*)(UBLK + uu * 3584 + 1024); u16* WBKTw = (u16*)(UBLK + uu * 3584 + 2304);
#pragma unroll
        for (int jj = 0; jj < 4; ++jj) {
          const int s = 4 * lq + jj, t = l16;
          if (q == 0) UBTw[t * 16 + (s & 3) * 4 + (s >> 2)] = (s < t) ? acc[jj] : 0.f;
          else if (q == 1) { const float val = (s < t) ? acc[jj] : 0.f; UKBw[t * 40 + 16 + s] = (u16)(cvtpk(val, val) & 0xffffu); }
          else { const float val = (s <= t) ? acc[jj] : 0.f; WBKTw[t * 40 + (q == 3 ? 16 : 0) + s] = (u16)(cvtpk(val, val) & 0xffffu); }
        }
      }
      LBAR();
#pragma unroll
      for (int u = 0; u < 2; ++u) {
        lane = OPQV(x_tid) & 63; l16 = lane & 15; lq = lane >> 4;
        const int rbuf = u, wbuf = u ^ 1;
        float* UBT = (float*)(UBLK + u * 3584); u16* UKB = (u16*)(UBLK + u * 3584 + 1024); u16* WBKT = (u16*)(UBLK + u * 3584 + 2304);
        if (wid < 4) {
          v8s As0 = *(const v8s*)(SB + (rbuf * 64 + 16 * wid + l16) * 72 + lq * 8);
          v8s As1 = *(const v8s*)(SB + (rbuf * 64 + 16 * wid + l16) * 72 + 32 + lq * 8);
          v8s Ba0 = *(const v8s*)(AT + (u * 16 + l16) * 72 + lq * 8);
          v8s Ba1 = *(const v8s*)(AT + (u * 16 + l16) * 72 + 32 + lq * 8);
          v8s A2 = *(const v8s*)(CV + (u * 64 + 16 * wid + l16) * 40 + lq * 8);
          v8s B2 = *(const v8s*)(UKB + l16 * 40 + lq * 8);
          asm volatile("" : "+v"(As0), "+v"(As1), "+v"(Ba0), "+v"(Ba1), "+v"(A2), "+v"(B2));
          v4f accp = {0.f, 0.f, 0.f, 0.f};
          accp = __builtin_amdgcn_mfma_f32_16x16x32_bf16(As0, Ba0, accp, 0, 0, 0);
          accp = __builtin_amdgcn_mfma_f32_16x16x32_bf16(As1, Ba1, accp, 0, 0, 0);
          accp = __builtin_amdgcn_mfma_f32_16x16x32_bf16(A2, B2, accp, 0, 0, 0);
#pragma unroll
          for (int jj = 0; jj < 4; ++jj) P1[(16 * wid + 4 * lq + jj) * 20 + l16] = accp[jj];
        }
        LBAR();
        if (wid < 4) {
          const int gq = lane & 3, irow = 16 * wid + (lane >> 2);
          float p1v[16];
#pragma unroll
          for (int q4 = 0; q4 < 4; ++q4) { const v4f x = *(const v4f*)(P1 + irow * 20 + q4 * 4); p1v[q4 * 4] = x[0]; p1v[q4 * 4 + 1] = x[1]; p1v[q4 * 4 + 2] = x[2]; p1v[q4 * 4 + 3] = x[3]; }
          float cf[16]; float my0 = 0.f, my1 = 0.f, my2 = 0.f, my3 = 0.f;
          cf[0] = p1v[0]; my0 = (gq == 0) ? cf[0] : 0.f;
          v4f ubv[16];
#pragma unroll
          for (int t = 1; t < 16; ++t) ubv[t] = *(const v4f*)(UBT + t * 16 + gq * 4);
#pragma unroll
          for (int t = 1; t < 16; ++t) asm volatile("" : "+v"(ubv[t]));
#pragma unroll
          for (int t = 1; t < 16; ++t) {
            const v4f ub = ubv[t];
            const int kc = (t - 1) >> 2;
            float part = (gq == 0) ? p1v[t] : 0.f;
            if (kc != 0) part += my0 * ub[0];
            if (t > 4 && kc != 1) part += my1 * ub[1];
            if (t > 8 && kc != 2) part += my2 * ub[2];
            if (t > 12 && kc != 3) part += my3 * ub[3];
            part += (kc == 0 ? my0 : kc == 1 ? my1 : kc == 2 ? my2 : my3) * ub[kc];
            part += dppf<0xB1>(part); part += dppf<0x4E>(part);
            cf[t] = part;
            const bool mine = gq == (t & 3);
            if ((t >> 2) == 0) my0 = mine ? part : my0;
            else if ((t >> 2) == 1) my1 = mine ? part : my1;
            else if ((t >> 2) == 2) my2 = mine ? part : my2;
            else my3 = mine ? part : my3;
          }
          if (gq == 0) {
            v4u w0_, w1_;
            w0_.x = cvtpk(cf[0], cf[1]); w0_.y = cvtpk(cf[2], cf[3]); w0_.z = cvtpk(cf[4], cf[5]); w0_.w = cvtpk(cf[6], cf[7]);
            w1_.x = cvtpk(cf[8], cf[9]); w1_.y = cvtpk(cf[10], cf[11]); w1_.z = cvtpk(cf[12], cf[13]); w1_.w = cvtpk(cf[14], cf[15]);
            *(v4u*)(CV + (u * 64 + irow) * 40) = w0_; *(v4u*)(CV + (u * 64 + irow) * 40 + 8) = w1_;
          }
        }
        LBAR();
        {
          const int ib = wid >> 1, jb0 = 2 * (wid & 1);
          v8s Acv = *(const v8s*)(CV + (u * 64 + 16 * ib + l16) * 40 + lq * 8);
          v8s Bk0 = *(const v8s*)(BKT + (u * 64 + 16 * jb0 + l16) * 40 + lq * 8);
          v8s Bk1 = *(const v8s*)(BKT + (u * 64 + 16 * (jb0 + 1) + l16) * 40 + lq * 8);
          float gc0 = GC[u * 64 + 16 * jb0 + l16], gc1 = GC[u * 64 + 16 * (jb0 + 1) + l16];
          if (wid < 4) {
            v8s As0 = *(const v8s*)(SB + (rbuf * 64 + 16 * wid + l16) * 72 + lq * 8);
            v8s As1 = *(const v8s*)(SB + (rbuf * 64 + 16 * wid + l16) * 72 + 32 + lq * 8);
            v8s Br0 = *(const v8s*)(RT + (u * 16 + l16) * 72 + lq * 8);
            v8s Br1 = *(const v8s*)(RT + (u * 16 + l16) * 72 + 32 + lq * 8);
            v8s A2 = *(const v8s*)(CV + (u * 64 + 16 * wid + l16) * 40 + lq * 8);
            v8s B2 = *(const v8s*)(WBKT + l16 * 40 + lq * 8);
            asm volatile("" : "+v"(As0), "+v"(As1), "+v"(Br0), "+v"(Br1), "+v"(A2), "+v"(B2), "+v"(Acv), "+v"(Bk0), "+v"(Bk1), "+v"(gc0), "+v"(gc1));
            v4f acc = {0.f, 0.f, 0.f, 0.f};
            acc = __builtin_amdgcn_mfma_f32_16x16x32_bf16(As0, Br0, acc, 0, 0, 0);
            acc = __builtin_amdgcn_mfma_f32_16x16x32_bf16(As1, Br1, acc, 0, 0, 0);
            acc = __builtin_amdgcn_mfma_f32_16x16x32_bf16(A2, B2, acc, 0, 0, 0);
#pragma unroll
            for (int jj = 0; jj < 4; ++jj) YB[(u * 16 + l16) * 64 + 16 * wid + 4 * lq + jj] = acc[jj];
          } else {
            asm volatile("" : "+v"(Acv), "+v"(Bk0), "+v"(Bk1), "+v"(gc0), "+v"(gc1));
          }
          S[0] = __builtin_amdgcn_mfma_f32_16x16x32_bf16(Acv, Bk0, S[0], 0, 0, 0);
          S[1] = __builtin_amdgcn_mfma_f32_16x16x32_bf16(Acv, Bk1, S[1], 0, 0, 0);
          S[0] = S[0] * gc0; S[1] = S[1] * gc1;
#pragma unroll
          for (int bb = 0; bb < 2; ++bb)
#pragma unroll
            for (int jj = 0; jj < 4; ++jj) SB[(wbuf * 64 + 16 * ib + 4 * lq + jj) * 72 + 16 * (jb0 + bb) + l16] = (u16)(cvtpk(S[bb][jj], S[bb][jj]) & 0xffffu);
        }
        LBAR();
      }
      {
        const v4f y4 = *(const v4f*)(YB + st * 64 + c0);
        v2u w; w.x = cvtpk(y4[0], y4[1]); w.y = cvtpk(y4[2], y4[3]);
        *(v2u*)(Yd + (size_t)cur_row * 1024 + ch) = w;
      }
    }
#undef RW_PREFETCH
    __syncthreads();
  }
}

__device__ __forceinline__ float row_sum8(float v) { v += dppf<0xB1>(v); v += dppf<0x4E>(v); v += dppf<0x141>(v); return v; }
__device__ void rwkv_outprep(PP p, int slot) {
  const u16* Y0 = (const u16*)(p->ws + OFF_AR + AR_Y0); const u16* Y1 = (const u16*)(p->ws + OFF_AR + AR_Y1);
  const u16* Vg = (const u16*)(p->ws + OFF_AR + AR_V); const u16* Gg = (const u16*)(p->ws + OFF_AR + AR_G);
  u16* YG = (u16*)(p->ws + OFF_AR + AR_YG);
  const float* BON = (const float*)(p->ws + OFF_BON);
  for (int idx = get_bid() * 512 + get_tid(); idx < M * 128; idx += get_gdim() * 512) {
    const int row = idx >> 7, c0 = (idx & 127) * 8, h = c0 >> 6;
    const size_t off = (size_t)row * 1024 + c0;
    const v4u a = *(const v4u*)(Y0 + off), bq = *(const v4u*)(Y1 + off), vv = *(const v4u*)(Vg + off), gg = *(const v4u*)(Gg + off);
    float y[8];
#pragma unroll
    for (int j = 0; j < 4; ++j) { y[2 * j] = bflo(a[j]) + bflo(bq[j]); y[2 * j + 1] = bfhi(a[j]) + bfhi(bq[j]); }
    float s = 0.f;
#pragma unroll
    for (int j = 0; j < 8; ++j) s += y[j];
    const float mean = row_sum8(s) * (1.f / 64.f);
    float sq = 0.f;
#pragma unroll
    for (int j = 0; j < 8; ++j) { y[j] -= mean; sq += y[j] * y[j]; }
    const float rstd = 1.0f / sqrtf(row_sum8(sq) * (1.f / 64.f) + 64e-5f);
    const float bon = BON[(size_t)row * 16 + h] + BON[((size_t)M + row) * 16 + h];
    const v4f lg0 = *(const v4f*)(p->rw_lng + (size_t)slot * 1024 + c0), lg1 = *(const v4f*)(p->rw_lng + (size_t)slot * 1024 + c0 + 4);
    const v4f lb0 = *(const v4f*)(p->rw_lnb + (size_t)slot * 1024 + c0), lb1 = *(const v4f*)(p->rw_lnb + (size_t)slot * 1024 + c0 + 4);
    float o[8];
#pragma unroll
    for (int j = 0; j < 8; ++j) {
      const float lg = j < 4 ? lg0[j & 3] : lg1[j & 3], lb = j < 4 ? lb0[j & 3] : lb1[j & 3];
      const float v = (j & 1) ? bfhi(vv[j >> 1]) : bflo(vv[j >> 1]);
      const float g = (j & 1) ? bfhi(gg[j >> 1]) : bflo(gg[j >> 1]);
      o[j] = (y[j] * rstd * lg + lb + v * bon) * g;
    }
    v4u w; w.x = cvtpk(o[0], o[1]); w.y = cvtpk(o[2], o[3]); w.z = cvtpk(o[4], o[5]); w.w = cvtpk(o[6], o[7]);
    *(v4u*)(YG + off) = w;
  }
}

#define XB_TMO      128
#define XB_XCNT(j)  (256  + 64 * (j))
#define XB_XSUB(j)  (1280 + 64 * (j))
#define XB_XGEN(j)  (2304 + 64 * (j))
#define XB_TOP      3328
#define XB_TOPGEN   3392
#define XCD_BAR_WORDS 3456
#define XB_SPIN_CAP (1u << 23)
#ifndef LAS
#define LAS __attribute__((address_space(3)))
#endif

__device__ __forceinline__ unsigned xb_ld(unsigned* p)              { return __hip_atomic_load(p, __ATOMIC_RELAXED, __HIP_MEMORY_SCOPE_AGENT); }
__device__ __forceinline__ unsigned xb_add(unsigned* p, unsigned v) { return __hip_atomic_fetch_add(p, v, __ATOMIC_RELAXED, __HIP_MEMORY_SCOPE_AGENT); }
__device__ __forceinline__ unsigned xb_xcc_id() { return (unsigned)__builtin_amdgcn_s_getreg((3 << 11) | 20) & 0xFu; }
#define XB_SPIN(cond, bar) do { unsigned _sp = 0; while (cond) { __builtin_amdgcn_s_sleep(1); \
    if ((++_sp & 255u) == 0u) { if (xb_ld(&(bar)[XB_TMO])) break; if (_sp > XB_SPIN_CAP) { atomicAdd(&(bar)[XB_TMO], 1u); break; } } } } while (0)

struct XcdBarrier {
    unsigned* bar; unsigned x;
    volatile LAS unsigned* st;
};

__device__ __forceinline__ XcdBarrier xcd_barrier_post(unsigned* bar, volatile LAS unsigned* st) {
    XcdBarrier b; b.bar = bar; b.x = xb_xcc_id(); b.st = st;
    if (get_tid() == 0) (void)xb_add(&bar[XB_XCNT(b.x)], 1u);
    return b;
}
__device__ __forceinline__ void xcd_barrier_complete(unsigned* bar, unsigned x, unsigned& nloc, unsigned& nx) {
    const unsigned G = gridDim.x * gridDim.y * gridDim.z;
    unsigned sum, cnt, mine, sp = 0u;
    for (;;) {
        sum = 0u; cnt = 0u; mine = 0u;
#pragma unroll
        for (unsigned j = 0; j < 16; ++j) { const unsigned c = xb_ld(&bar[XB_XCNT(j)]); sum += c; cnt += (c > 0u) ? 1u : 0u; mine = (j == x) ? c : mine; }
        if (sum == G) break;
        __builtin_amdgcn_s_sleep(1);
        if ((++sp & 255u) == 0u) { if (xb_ld(&bar[XB_TMO])) break; if (sp > XB_SPIN_CAP) { atomicAdd(&bar[XB_TMO], 1u); break; } }
    }
    nloc = mine > 0u ? mine : 1u; nx = cnt > 0u ? cnt : 1u;
}

__device__ __forceinline__ void xcd_barrier(const XcdBarrier& b) {
    asm volatile("s_waitcnt vmcnt(0)" ::: "memory");
    __syncthreads();
    if (get_tid() == 0) {
        unsigned* bar = b.bar;
        __builtin_amdgcn_s_waitcnt(0);
        unsigned nloc = b.st[0], nx = b.st[1];
        if (nloc == 0u) { xcd_barrier_complete(bar, b.x, nloc, nx); b.st[0] = nloc; b.st[1] = nx; }
        const unsigned old = xb_add(&bar[XB_XSUB(b.x)], 1u);
        const unsigned gen = old / nloc;
        if (old + 1u == (gen + 1u) * nloc) {
            __builtin_amdgcn_fence(__ATOMIC_RELEASE, "agent");
            asm volatile("s_waitcnt vmcnt(0)" ::: "memory");
            const unsigned og = xb_add(&bar[XB_TOP], 1u);
            const unsigned tg = og / nx;
            if (og + 1u == (tg + 1u) * nx) xb_add(&bar[XB_TOPGEN], 1u);
            else XB_SPIN(xb_ld(&bar[XB_TOPGEN]) == tg, bar);
            __builtin_amdgcn_fence(__ATOMIC_ACQUIRE, "agent");
            xb_add(&bar[XB_XGEN(b.x)], 1u);
            asm volatile("s_waitcnt vmcnt(0)" ::: "memory");
        } else {
            XB_SPIN(xb_ld(&bar[XB_XGEN(b.x)]) == gen, bar);
            __builtin_amdgcn_fence(__ATOMIC_ACQUIRE, "agent");
            asm volatile("s_waitcnt vmcnt(0)" ::: "memory");
        }
    }
    __syncthreads();
}


enum { OP_MOD = 0, OP_ROWA, OP_XX, OP_QKV, OP_QKPREP, OP_ATTN, OP_NA, OP_RW1, OP_SCAN, OP_OUTPREP, OP_WO, OP_ROWE, OP_MLP1, OP_MLP2, OP_FINAL };
__device__ __forceinline__ void decode_phase(int ph, int& layer, int& op) {
  if (ph == 0) { layer = 0; op = OP_MOD; return; }
  if (ph >= 33) { layer = 3; op = OP_FINAL; return; }
  int s;
  if (ph < 9) { layer = 0; s = ph - 1; } else if (ph < 16) { layer = 1; s = ph - 9; } else if (ph < 25) { layer = 2; s = ph - 16; } else { layer = 3; s = ph - 25; }
  const int kind = layer % 3;
  if (kind == 0) { op = s == 0 ? OP_ROWA : s == 1 ? OP_QKV : s == 2 ? OP_QKPREP : s == 3 ? OP_ATTN : s == 4 ? OP_WO : s == 5 ? OP_ROWE : s == 6 ? OP_MLP1 : OP_MLP2; }
  else if (kind == 1) op = s == 0 ? OP_ROWA : s == 1 ? OP_QKV : s == 2 ? OP_NA : s == 3 ? OP_WO : s == 4 ? OP_ROWE : s == 5 ? OP_MLP1 : OP_MLP2;
  else op = s == 0 ? OP_ROWA : s == 1 ? OP_XX : s == 2 ? OP_RW1 : s == 3 ? OP_SCAN : s == 4 ? OP_OUTPREP : s == 5 ? OP_WO : s == 6 ? OP_ROWE : s == 7 ? OP_MLP1 : OP_MLP2;
}

__global__ void __launch_bounds__(512, 2) mega(P p_, int lo, int hi) {
  extern __shared__ __attribute__((aligned(16))) unsigned char smem[];
  cg::grid_group grid = cg::this_grid();
  volatile LAS unsigned* xst = (volatile LAS unsigned*)(smem + 131072 + 16);
  if (get_tid() == 0) { xst[0] = 0u; xst[1] = 0u; }
  __syncthreads();
  XcdBarrier xbar; xbar.bar = nullptr; xbar.x = 0; xbar.st = xst;
  if (hi - lo > 1) { PP pb = (PP)__builtin_amdgcn_kernarg_segment_ptr(); xbar = xcd_barrier_post((unsigned*)(pb->ws + OFF_BARW), xst); }
  if (lo == 0) {
    PP p0 = (PP)__builtin_amdgcn_kernarg_segment_ptr();
    asm volatile("" : "+s"(p0));
    phase_mod(p0, smem);
    if (hi > 1) grid.sync();
    lo = 1;
  }
  for (int ph = lo; ph < hi; ++ph) {
    PP p = (PP)__builtin_amdgcn_kernarg_segment_ptr();
    asm volatile("" : "+s"(p));
    unsigned char* AR = p->ws + OFF_AR;
    const float* MOD = (const float*)(p->ws + OFF_MOD);
    int layer, op; decode_phase(ph, layer, op);
#ifdef DUP_OP
    for (int rep = 0; rep < ((op == DUP_OP) ? 2 : 1); ++rep) {
#else
    {
#endif
    const int kind = layer % 3, slot = layer / 3;
    const bool want_ctx = layer < 3;
    if (op == OP_ROWA) {
      if (layer == 0) convert_layer_weights(p, layer, smem, get_bid(), get_gdim(), get_gdim() == 256 ? 2 : 7);
      if (layer == 0) rowpass(p, -1, layer, 0, (u16*)(AR + AR_H), 1024, false);
      else rowpass(p, (layer - 1) * 2 + 1, layer, 0, (u16*)(AR + AR_H), kind == 2 ? 2048 : 1024, false, false, 8, (const float*)(AR + AR_PART_MLP2), (layer - 1) * 2, MOD + (size_t)((layer - 1) * 9 + 8) * 6144 + 5 * 1024);
    }
    else if (op == OP_ROWE) {
      if (layer == 3) rowpass(p, layer * 2, layer, 3, (u16*)(AR + AR_H), 1024, false, true);
      else rowpass(p, layer * 2, layer, 3, (u16*)(AR + AR_H), 1024, false, false, 4, (const float*)(AR + AR_PART_WO), layer == 0 ? -1 : (layer - 1) * 2 + 1, MOD + (size_t)(layer * 9 + 8) * 6144 + 2 * 1024, layer == 0);
    }
    else if (op == OP_FINAL) rowpass(p, 7, 0, 0, nullptr, 0, true);
    else if (op == OP_XX) xx_pass(p);
    else if (op == OP_QKPREP) qk_prep(p, slot);
    else if (op == OP_ATTN) {
#ifndef NO_ATTN
      gqa_attention(p, smem, want_ctx, slot);
#endif
    }
    else if (op == OP_NA) {
#ifndef NO_NA
      na_attention(p, smem, want_ctx);
#endif
    }
    else if (op == OP_OUTPREP) rwkv_outprep(p, slot);
    else if (op == OP_RW1) {
      EpiRw1 E{(u16*)(AR + AR_R), (u16*)(AR + AR_L1)};
#ifndef NO_RW1
      run_gemm(smem, (const u16*)(AR + AR_H), (const u16*)(p->ws + OFF_WB + WB_MIX), M, 3584, 2048, E);
#endif
    }
    else if (op == OP_QKV || op == OP_MLP1 || op == OP_SCAN) {
      int ng = 1;
      const u16 *A0, *B0, *A1 = nullptr, *B1 = nullptr; u16 *O0, *O1 = nullptr; int M0, N0, K0, L0, M1 = 0, N1 = 0, K1 = 0, L1_ = 0, act = 0, ld0 = 0;
      if (op == OP_MLP1) { A0 = (const u16*)(AR + AR_H); B0 = (const u16*)(p->ws + OFF_WB + WB_W1T); O0 = (u16*)(AR + AR_HID); M0 = M; N0 = 4096; K0 = 1024; L0 = 4096; act = 1; }
      else if (op == OP_SCAN) { A0 = (const u16*)(AR + AR_L1) + 128; B0 = (const u16*)(p->ws + OFF_WB + WB_RW_BG) + 128; O0 = (u16*)(AR + AR_G); M0 = M; N0 = 1024; K0 = 256; L0 = 1024; ld0 = 384; }
      else if (kind == 0) { A0 = (const u16*)(AR + AR_H); B0 = (const u16*)(p->ws + OFF_WB + WB_MIX); O0 = (u16*)(AR + AR_QKV); M0 = M; N0 = 1536; K0 = 1024; L0 = 1536; }
      else { A0 = (const u16*)(AR + AR_H); B0 = (const u16*)(p->ws + OFF_WB + WB_MIX); O0 = (u16*)(AR + AR_NA_QK); M0 = M; N0 = 2048; K0 = 1024; L0 = 2048;
             ng = 2; A1 = (const u16*)(p->ws + OFF_WB + WB_MIX) + (size_t)2048 * 1024; B1 = (const u16*)(AR + AR_H); O1 = (u16*)(AR + AR_NA_VT); M1 = 1024; N1 = M; K1 = 1024; L1_ = M; }
      for (int g = 0; g < ng; ++g) {
        EpiStore E{g ? O1 : O0, g ? L1_ : L0, act};
#ifndef NO_GS
        run_gemm(smem, g ? A1 : A0, g ? B1 : B0, g ? M1 : M0, g ? N1 : N0, g ? K1 : K0, E, (op == OP_MLP1 && layer == 3) ? 1 : 0, g ? 0 : ld0, (g && get_gdim() == 256) ? 128 : 0);
#endif
      }
#ifndef NO_SCAN
#ifdef SCAN_V1
      if (op == OP_SCAN) rwkv_scan(p, smem, slot);
#else
      if (op == OP_SCAN) rwkv_scan2(p, smem, slot);
#endif
      if (op == OP_MLP1 && layer < 3 && get_gdim() == 256 && get_bid() >= 128) convert_layer_weights(p, layer + 1, smem, get_bid() - 128, 128, 6);
      if (op == OP_QKV && layer == 0 && get_gdim() == 256 && get_bid() >= 48) convert_layer_weights(p, 0, smem, get_bid() - 48, 208, 5);
#endif
    }
    else if (op == OP_WO || op == OP_MLP2) {
      const u16 *A, *B; int K; const float* gate;
      if (op == OP_MLP2) { A = (const u16*)(AR + AR_HID); B = (const u16*)(p->ws + OFF_WB + ((layer & 1) ? WB_W2T_B : WB_W2T)); K = 4096; gate = MOD + (size_t)layer * 9 * 6144 + 5 * 1024; }
      else { K = 1024; gate = MOD + (size_t)layer * 9 * 6144 + 2 * 1024;
        if (kind == 0) { A = (const u16*)(AR + AR_ATT_O); B = (const u16*)(p->ws + OFF_WB + WB_ATT_WO); }
        else if (kind == 1) { A = (const u16*)(AR + AR_NA_O); B = (const u16*)(p->ws + OFF_WB + WB_NA_WO); }
        else { A = (const u16*)(AR + AR_YG); B = (const u16*)(p->ws + OFF_WB + WB_RW_WO); } }
      const int pln = (op == OP_MLP2) ? layer * 2 : (layer == 0 ? -1 : (layer - 1) * 2 + 1);
#ifndef NO_GR
      const int nsplit = op == OP_MLP2 ? 8 : 4, Ksub = K / nsplit;
      for (int pass = 0; pass < (layer < 3 ? 2 : 1); ++pass) {
        const int c = get_bid(), unit = c / nsplit, ks = c - unit * nsplit;
        float* part = pass ? (float*)(AR + (op == OP_MLP2 ? AR_PART_MLP2 : AR_PART_WO)) + (size_t)ks * 2048 * 1024 : nullptr;
        EpiResid E{p->out, (float*)(p->ws + OFF_XC), gate, (const float*)(p->ws + OFF_STATS), pln < 0 ? nullptr : p->ln_g + (size_t)pln * 1024, pln < 0 ? nullptr : p->ln_b + (size_t)pln * 1024, part, (op == OP_WO && layer == 0) ? p->x : (const float*)p->out, (op == OP_WO && layer == 0) ? p->ctx : (const float*)(p->ws + OFF_XC)};
        pg8::Gemm g{pass ? A + (size_t)ks * Ksub : A, pass ? B + (size_t)ks * Ksub : B, M, 1024, pass ? Ksub : K, K};
        pg8::StaticOrder S; S.init(M, 1024, get_gdim(), c, 1);
        if (pass) { S.one = unit < 32 ? 1 : 2; S.one_pm = (unit >> 2) * 17 + 16; S.one_pn = unit & 3; }
        pg8::gemm_phase<EpiResid, pg8::StaticOrder, false>((PG8_LAS unsigned char*)smem, g, S, E, nullptr);
        __syncthreads();
      }
#endif
      if (op == OP_MLP2 && layer < 3) convert_layer_weights(p, layer + 1, smem, get_bid(), get_gdim(), get_gdim() == 256 ? 1 : 7);
    }
    }
    if (ph + 1 < hi) xcd_barrier(xbar);
  }
}

extern "C" void kernel_launch(void* const* d_in, const int* in_sizes, int n_in, void* d_out, int out_size, void* d_ws, size_t ws_size, hipStream_t stream) {
  static int grid_blocks = 0;
  if (!grid_blocks) {
    int dev = 0, cus = 0, per_cu = 0;
    hipGetDevice(&dev);
    hipDeviceGetAttribute(&cus, hipDeviceAttributeMultiprocessorCount, dev);
    hipFuncSetAttribute((const void*)mega, hipFuncAttributeMaxDynamicSharedMemorySize, LDS_BYTES);
    hipOccupancyMaxActiveBlocksPerMultiprocessor(&per_cu, (const void*)mega, 512, LDS_BYTES);
    if (per_cu < 1) per_cu = 1;
    grid_blocks = cus * per_cu;
    if (grid_blocks > 256) grid_blocks = 256;
    if (ws_size < 492 * MiB) fprintf(stderr, "kernel_launch: workspace too small: %zu\n", ws_size);
  }
  P p{};
  const float** pf = (const float**)&p;
  for (int i = 0; i < 35; ++i) pf[i] = (const float*)d_in[i];
  p.out = (float*)d_out; p.ws = (unsigned char*)d_ws;
#if FUSED
  hipMemsetAsync((unsigned char*)d_ws + OFF_BARW, 0, XCD_BAR_WORDS * 4, stream);
  int lo = 0, hi = NPHASE;
  void* args[] = {&p, &lo, &hi};
  hipError_t e = hipLaunchCooperativeKernel((const void*)mega, dim3(grid_blocks), dim3(512), args, LDS_BYTES, stream);
  if (e != hipSuccess) fprintf(stderr, "cooperative launch failed: %s (grid %d)\n", hipGetErrorString(e), grid_blocks);
#else
  for (int ph = 0; ph < NPHASE; ++ph) hipLaunchKernelGGL(mega, dim3(grid_blocks), dim3(512), LDS_BYTES, stream, p, ph, ph + 1);
#endif
}
```

```cpp
#include <hip/hip_runtime.h>
#include <hip/hip_cooperative_groups.h>
#include <cstdio>
#include <cstdint>
namespace cg = cooperative_groups;

#ifndef FUSED
#define FUSED 1
#endif

typedef unsigned short u16;
typedef short v8s __attribute__((ext_vector_type(8)));
typedef short v4s __attribute__((ext_vector_type(4)));
typedef float v2f __attribute__((ext_vector_type(2)));
typedef float v4f __attribute__((ext_vector_type(4)));
typedef float v16f __attribute__((ext_vector_type(16)));
typedef unsigned v4u __attribute__((ext_vector_type(4)));
typedef unsigned v2u __attribute__((ext_vector_type(2)));

constexpr int D = 1024, NB = 8, SEQ = 4096, CTXL = 256, TB = SEQ + CTXL, M = NB * TB;
constexpr float ALPHA = 1.6817928305074292f;
constexpr float LN_EPS = 1e-6f;
constexpr float LOG2E = 1.4426950408889634f;
constexpr size_t MiB = (size_t)1 << 20;
constexpr int LDS_BYTES = 131072 + 1024;
constexpr int NPHASE = 34;

constexpr size_t OFF_WB = 0;
constexpr size_t OFF_XC = 42 * MiB;
constexpr size_t OFF_MOD = 50 * MiB;
constexpr size_t OFF_TAB = 51 * MiB;
constexpr size_t OFF_ONES = 51 * MiB + 64 * 1024;
constexpr size_t OFF_BON = 52 * MiB;
constexpr size_t OFF_STATS = 56 * MiB + 512 * 1024;
constexpr size_t OFF_BARW = 57 * MiB;
constexpr size_t OFF_AR = 58 * MiB;
constexpr size_t WB_W1T = 0, WB_W2T = 8 * MiB, WB_MIX = 16 * MiB, WB_W2T_B = 34 * MiB;
constexpr size_t WB_ATT_WO = 19 * MiB, WB_NA_WO = 22 * MiB, WB_RW_WO = 30 * MiB, WB_RW_BG = 32 * MiB, WB_RW_W2T = 32 * MiB + 768 * 1024, WB_RW_A2T = 33 * MiB;
constexpr size_t AR_H = 0;
constexpr size_t AR_QKV = 68 * MiB, AR_ATT_O = 170 * MiB;
constexpr size_t AR_NA_QK = 68 * MiB, AR_NA_VT = 204 * MiB, AR_NA_O = 272 * MiB;
constexpr size_t AR_PART_WO = 68 * MiB, AR_PART_MLP2 = 340 * MiB;
constexpr size_t AR_HID = 68 * MiB;
constexpr size_t AR_Y0 = 0, AR_Y1 = 68 * MiB, AR_R = 136 * MiB, AR_K = 204 * MiB, AR_V = 272 * MiB, AR_L1 = 340 * MiB, AR_G = 366 * MiB, AR_YG = 136 * MiB;

struct P {
  const float *x, *c, *ctx, *c_ctx, *mod_w, *mod_b, *ln_g, *ln_b, *mlp_w1, *mlp_w2;
  const float *att_wqkv, *att_wo, *att_qn, *att_kn, *na_wqkv, *na_wo, *na_rpb;
  const float *rw_mu, *rw_wr, *rw_wk, *rw_wv, *rw_wo, *rw_w0, *rw_w1, *rw_w2, *rw_a0, *rw_a1, *rw_a2, *rw_g1, *rw_g2, *rw_kk, *rw_ka, *rw_rk, *rw_lng, *rw_lnb;
  float* out; unsigned char* ws;
};

typedef const __attribute__((address_space(4))) P* PP;
__device__ __forceinline__ int get_tid() { int t = threadIdx.x; asm volatile("" : "+v"(t)); return t; }
__device__ __forceinline__ int get_bid() { int t = blockIdx.x; asm volatile("" : "+s"(t)); return t; }
__device__ __forceinline__ int get_gdim() { int t = gridDim.x; asm volatile("" : "+s"(t)); return t; }
__device__ __forceinline__ unsigned cvtpk(float lo, float hi) { unsigned r; asm volatile("v_cvt_pk_bf16_f32 %0, %1, %2" : "=v"(r) : "v"(lo), "v"(hi)); return r; }
__device__ __forceinline__ float bf2f(u16 v) { return __uint_as_float((unsigned)v << 16); }
__device__ __forceinline__ float bflo(unsigned w) { return __uint_as_float(w << 16); }
__device__ __forceinline__ float bfhi(unsigned w) { return __uint_as_float(w & 0xffff0000u); }
template <int CTRL> __device__ __forceinline__ float dppf(float v) { return __int_as_float(__builtin_amdgcn_update_dpp(0, __float_as_int(v), CTRL, 0xF, 0xF, true)); }
__device__ __forceinline__ float row_sum16(float v) { v += dppf<0xB1>(v); v += dppf<0x4E>(v); v += dppf<0x141>(v); v += dppf<0x140>(v); return v; }
__device__ __forceinline__ float wave_sum(float v) {
  v = row_sum16(v);
  const float a = __int_as_float(__builtin_amdgcn_readlane(__float_as_int(v), 0)), b = __int_as_float(__builtin_amdgcn_readlane(__float_as_int(v), 16));
  const float c = __int_as_float(__builtin_amdgcn_readlane(__float_as_int(v), 32)), d = __int_as_float(__builtin_amdgcn_readlane(__float_as_int(v), 48));
  return (a + b) + (c + d);
}
__device__ __forceinline__ float* xrow(PP p, int row) {
  const int b = row / TB, t = row - b * TB;
  return t < SEQ ? p->out + (size_t)(b * SEQ + t) * D : (float*)(p->ws + OFF_XC) + (size_t)(b * CTXL + t - SEQ) * D;
}
__device__ __forceinline__ int modidx(int row) { const int b = row / TB, t = row - b * TB; return t < SEQ ? b : 8; }
__device__ __forceinline__ int crow(int r, int hi) { return (r & 3) + 8 * (r >> 2) + 4 * hi; }

namespace pg8 {
#define PG8_LAS __attribute__((address_space(3)))
typedef unsigned short bf16_t;
typedef short bf16x8 __attribute__((ext_vector_type(8)));
typedef float f32x4 __attribute__((ext_vector_type(4)));
typedef unsigned u32x4 __attribute__((ext_vector_type(4)));
constexpr int BM = 256, BK = 64, HALF = 128, HTB = HALF * BK * 2  , STAGE_BYTES = 8 * HTB, NXCD = 8, WGM = 8;

__host__ __device__ __forceinline__ int lds_byte(int r, int c) { const int st = (r >> 4) * 2 + (c >> 5), rr = r & 15, cc = c & 31, ob = rr * 64 + cc * 2; return st * 1024 + (ob ^ (((ob >> 9) & 1) << 5)); }
__host__ __device__ __forceinline__ void stage_rc(int b, int& R, int& C) { const int st = b / 1024, sb = b % 1024, swz = sb ^ (((sb >> 9) & 1) << 5); R = (st >> 1) * 16 + swz / 64; C = (st & 1) * 32 + (swz % 64) / 2; }
__host__ __device__ __forceinline__ int perm32(int rho) { const int n = rho >> 4, i = rho & 15; return 8 * (i >> 2) + 4 * n + (i & 3); }

struct Unit { int pm, pn; };
struct Gemm { const bf16_t* A; const bf16_t* Bt; int M, N, K, ld; };

struct StaticOrder {
    int nM, nN, nwg, G, c, skip, one, one_pm, one_pn;
    __host__ __device__ void init(int M, int N, int G_, int c_, int skip_ = 0) { nM = M / BM; if (skip_) nM = nM / 17 * 16; nN = N / BM; nwg = nM * nN; G = G_; c = c_; skip = skip_; one = 0; one_pm = 0; one_pn = 0; }
    __host__ __device__ bool next(int i, Unit& u) const {
        if (one) { if (one == 1 && i == 0) { u.pm = one_pm; u.pn = one_pn; return true; } return false; }
        const long L = (long)i * G + c; if (L >= nwg) return false;
        int wgid = (int)L; { const int q = nwg / NXCD, r = nwg % NXCD, xcd = wgid % NXCD, off = wgid / NXCD; wgid = (xcd < r ? xcd * (q + 1) : r * (q + 1) + (xcd - r) * q) + off; }
        const int nig = WGM * nN, gid = wgid / nig, fm = gid * WGM, gsz = (nM - fm) < WGM ? (nM - fm) : WGM;
        u.pm = fm + ((wgid % nig) % gsz); u.pn = (wgid % nig) / gsz; if (skip) u.pm += u.pm >> 4; return true;
    }
    __device__ __forceinline__ void a_ready(const Unit&) const {}
    __device__ __forceinline__ void done(const Unit&) const {}
};
__device__ __forceinline__ unsigned cvt_pk_bf16(float lo, float hi) { unsigned r; asm volatile("v_cvt_pk_bf16_f32 %0, %1, %2" : "=v"(r) : "v"(lo), "v"(hi)); return r; }
typedef float f32x2 __attribute__((ext_vector_type(2)));
template <class Epi, class Sched, bool STAMP = false>
__device__ __forceinline__ void gemm_phase(PG8_LAS unsigned char* lds, const Gemm g, const Sched& S, const Epi& E, unsigned long long* stamps) {
    const int tid = get_tid(), wid = __builtin_amdgcn_readfirstlane(tid >> 6), lane = tid & 63, wr = wid >> 2, wc = wid & 3, fr = lane & 15, fq = lane >> 4;
    const int K = g.K, nt = K / BK;
    int ts_lo = 0, ts_hi = 0, nts = 0; const unsigned long long rt_entry = STAMP ? (unsigned long long)wall_clock64() : 0ull;
#define PG8_STAMP() do { if (STAMP && wid == 0 && nts < 64) { const unsigned long long _c = (unsigned long long)clock64(); \
        ts_lo = (lane == nts) ? (int)(unsigned)_c : ts_lo; ts_hi = (lane == nts) ? (int)(unsigned)(_c >> 32) : ts_hi; ++nts; } } while (0)
    PG8_STAMP();
    unsigned voffA[2], voffB[2];
#pragma unroll
    for (int i = 0; i < 2; ++i) { int R, C; stage_rc(tid * 16 + i * 8192, R, C); const int Rb = Epi::PERM ? ((R & ~31) + perm32(R & 31)) : R;
        voffA[i] = (unsigned)(R * g.ld + C) * 2u; voffB[i] = (unsigned)(Rb * g.ld + C) * 2u; }
    const size_t kstep = (size_t)(BK * 2);
    const size_t hstep = (size_t)HALF * g.ld * 2;
    const size_t tstep = 2 * hstep;
    const unsigned ldsw = (unsigned)wid * 1024u;
    const int aoff = lds_byte(wr * 64 + fr, fq * 8), boff = lds_byte(wc * 32 + fr, fq * 8);
#define PG8_SA(b, h) (((b) * 2 + (h)) * HTB)
#define PG8_SB(b, h) ((4 + (b) * 2 + (h)) * HTB)
#define PG8_STAGE(bufoff, gbase, voff) do { _Pragma("unroll") for (int _i = 0; _i < 2; ++_i) \
        __builtin_amdgcn_global_load_lds((const unsigned*)((const char*)(gbase) + (voff)[_i]), (PG8_LAS unsigned*)(lds + (bufoff) + ldsw + _i * 8192), 16, 0, 0); } while (0)
#define PG8_LDA(dst, b, h) do { _Pragma("unroll") for (int m = 0; m < 4; ++m) _Pragma("unroll") for (int k = 0; k < 2; ++k) dst[m][k] = *(const PG8_LAS bf16x8*)(lds + PG8_SA(b, h) + aoff + m * 2048 + k * 1024); } while (0)
#define PG8_LDB(dst, b, h) do { _Pragma("unroll") for (int n = 0; n < 2; ++n) _Pragma("unroll") for (int k = 0; k < 2; ++k) dst[n][k] = *(const PG8_LAS bf16x8*)(lds + PG8_SB(b, h) + boff + n * 2048 + k * 1024); } while (0)
#define PG8_MMA(ai, bj, At, Bt) do { __builtin_amdgcn_s_setprio(1); _Pragma("unroll") for (int m = 0; m < 4; ++m) _Pragma("unroll") for (int n = 0; n < 2; ++n) _Pragma("unroll") for (int k = 0; k < 2; ++k) \
        acc[ai][bj][m][n] = __builtin_amdgcn_mfma_f32_16x16x32_bf16(Bt[n][k], At[m][k], acc[ai][bj][m][n], 0, 0, 0); __builtin_amdgcn_s_setprio(0); } while (0)
#define PG8_WAIT_V(n) asm volatile("s_waitcnt vmcnt(" #n ")" ::: "memory")
#define PG8_WAIT_L(n) asm volatile("s_waitcnt lgkmcnt(" #n ")" ::: "memory")
#define PG8_BAR __builtin_amdgcn_s_barrier()
#define PG8_SCHED __builtin_amdgcn_sched_barrier(0)
    Unit cur, nxt; int ui = 0;
    if (!S.next(0, cur)) return;
    f32x4 acc[2][2][4][2];
#pragma unroll
    for (int a = 0; a < 2; ++a)
#pragma unroll
        for (int b = 0; b < 2; ++b)
#pragma unroll
            for (int m = 0; m < 4; ++m)
#pragma unroll
                for (int n = 0; n < 2; ++n) acc[a][b][m][n] = (f32x4){0.f, 0.f, 0.f, 0.f};
    bf16x8 At[4][2], B0[2][2], B1[2][2];
    const char* cA = (const char*)g.A + (size_t)cur.pm * tstep; const char* cB = (const char*)g.Bt + (size_t)cur.pn * tstep;
    S.a_ready(cur);
    PG8_STAGE(PG8_SB(0, 0), cB, voffB); PG8_STAGE(PG8_SA(0, 0), cA, voffA); PG8_STAGE(PG8_SB(0, 1), cB + hstep, voffB); PG8_STAGE(PG8_SA(0, 1), cA + hstep, voffA);
    if (wr == 1) PG8_BAR;
    PG8_WAIT_V(4); PG8_BAR;
    PG8_STAGE(PG8_SB(1, 0), cB + kstep, voffB); PG8_STAGE(PG8_SA(1, 0), cA + kstep, voffA); PG8_STAGE(PG8_SB(1, 1), cB + hstep + kstep, voffB);
    PG8_WAIT_V(6); PG8_BAR;
    PG8_STAMP();
    for (;;) {
        const bool has_next = S.next(ui + 1, nxt);
        const char* nA = has_next ? (const char*)g.A + (size_t)nxt.pm * tstep : cA; const char* nB = has_next ? (const char*)g.Bt + (size_t)nxt.pn * tstep : cB;
        for (int t = 0; t < nt; t += 2) {
            const bool last = (t == nt - 2);
            const char* a1 = cA + (size_t)(t + 1) * kstep;
            const char* a2 = last ? nA : cA + (size_t)(t + 2) * kstep; const char* b2 = last ? nB : cB + (size_t)(t + 2) * kstep;
            const char* a3 = a2 + kstep; const char* b3 = b2 + kstep;
            if (last && has_next) S.a_ready(nxt);
            PG8_LDB(B0, 0, 0); PG8_SCHED; PG8_LDA(At, 0, 0); PG8_STAGE(PG8_SA(1, 1), a1 + hstep, voffA);
            PG8_WAIT_L(8); PG8_BAR; PG8_WAIT_L(0); PG8_MMA(0, 0, At, B0); PG8_BAR; PG8_SCHED;
            PG8_LDB(B1, 0, 1); PG8_STAGE(PG8_SB(0, 0), b2, voffB);
            PG8_BAR; PG8_WAIT_L(0); PG8_MMA(0, 1, At, B1); PG8_BAR;
            PG8_LDA(At, 0, 1); PG8_STAGE(PG8_SA(0, 0), a2, voffA);
            PG8_BAR; PG8_WAIT_L(0); PG8_MMA(1, 0, At, B0); PG8_BAR; PG8_SCHED;
            PG8_STAGE(PG8_SB(0, 1), b2 + hstep, voffB);
            PG8_WAIT_V(6); PG8_BAR; PG8_MMA(1, 1, At, B1); PG8_BAR;
            PG8_LDB(B0, 1, 0); PG8_SCHED; PG8_LDA(At, 1, 0); PG8_STAGE(PG8_SA(0, 1), a2 + hstep, voffA);
            PG8_WAIT_L(8); PG8_BAR; PG8_WAIT_L(0); PG8_MMA(0, 0, At, B0); PG8_BAR; PG8_SCHED;
            PG8_LDB(B1, 1, 1); PG8_STAGE(PG8_SB(1, 0), b3, voffB);
            PG8_BAR; PG8_WAIT_L(0); PG8_MMA(0, 1, At, B1); PG8_BAR;
            PG8_LDA(At, 1, 1); PG8_STAGE(PG8_SA(1, 0), a3, voffA);
            PG8_BAR; PG8_WAIT_L(0); PG8_MMA(1, 0, At, B0); PG8_BAR; PG8_SCHED;
            PG8_STAGE(PG8_SB(1, 1), b3 + hstep, voffB);
            PG8_WAIT_V(6); PG8_BAR; PG8_MMA(1, 1, At, B1); PG8_BAR;
        }
        PG8_STAMP();
        if constexpr (!Epi::AFTER_DRAIN) { E(acc, cur, wr, wc, fr, fq); S.done(cur); }
        PG8_STAMP();
        if (!has_next) break;
#pragma unroll
        for (int a = 0; a < 2; ++a)
#pragma unroll
            for (int b = 0; b < 2; ++b)
#pragma unroll
                for (int m = 0; m < 4; ++m)
#pragma unroll
                    for (int n = 0; n < 2; ++n) acc[a][b][m][n] = (f32x4){0.f, 0.f, 0.f, 0.f};
        cur = nxt; cA = nA; cB = nB; ++ui;
    }
    PG8_WAIT_V(0);
    if (wr == 0) PG8_BAR;
    PG8_BAR;
    if constexpr (Epi::AFTER_DRAIN) { E.fused(acc, cur, wr, wc, fr, fq, lds, wid, lane); S.done(cur); }
    PG8_STAMP();
    if (STAMP && wid == 0) { stamps[lane] = lane < nts ? (((unsigned long long)(unsigned)ts_hi << 32) | (unsigned)ts_lo) : 0ull;
        if (lane == 62) stamps[62] = rt_entry; if (lane == 63) stamps[63] = (unsigned long long)wall_clock64(); }
#undef PG8_STAMP
#undef PG8_SA
#undef PG8_SB
#undef PG8_STAGE
#undef PG8_LDA
#undef PG8_LDB
#undef PG8_MMA
#undef PG8_WAIT_V
#undef PG8_WAIT_L
#undef PG8_BAR
#undef PG8_SCHED
}
}

struct EpiStore {
  static constexpr bool PERM = true, AFTER_DRAIN = false;
  u16* O; int ldc; int act;
  __device__ __forceinline__ void operator()(const pg8::f32x4 (&acc)[2][2][4][2], const pg8::Unit& u, int wr, int wc, int fr, int fq) const {
    const int row0 = u.pm * 256 + wr * 64 + fr, col0 = u.pn * 256 + wc * 32 + 8 * fq;
#pragma unroll
    for (int ai = 0; ai < 2; ++ai)
#pragma unroll
      for (int m = 0; m < 4; ++m) {
        u16* rowp = O + (size_t)(row0 + ai * 128 + m * 16) * ldc + col0;
#pragma unroll
        for (int bj = 0; bj < 2; ++bj) {
          pg8::f32x4 v0 = acc[ai][bj][m][0], v1 = acc[ai][bj][m][1];
          if (act == 1) {
#pragma unroll
            for (int j = 0; j < 4; ++j) { float a = fmaxf(v0[j], 0.f), b = fmaxf(v1[j], 0.f); v0[j] = a * a; v1[j] = b * b; }
          }
          v4u w; w.x = cvtpk(v0[0], v0[1]); w.y = cvtpk(v0[2], v0[3]); w.z = cvtpk(v1[0], v1[1]); w.w = cvtpk(v1[2], v1[3]);
          *(v4u*)(rowp + bj * 128) = w;
        }
      }
  }
};
struct EpiResid {
  static constexpr bool PERM = false, AFTER_DRAIN = false;
  float* out; float* xc; const float* gate;
  const float* stats; const float* lng; const float* lnb;
  float* part;
  const float* xin_lat; const float* xin_ctx;
  __device__ __forceinline__ void operator()(const pg8::f32x4 (&acc)[2][2][4][2], const pg8::Unit& u, int wr, int wc, int fr, int fq) const {
    const int row0 = u.pm * 256 + wr * 64 + fr, col0 = u.pn * 256 + wc * 32 + 4 * fq;
    if (part) {
      const int ct = u.pm / 17;
#pragma unroll
      for (int ai = 0; ai < 2; ++ai)
#pragma unroll
        for (int m = 0; m < 4; ++m) {
          float* rowp = part + (size_t)(ct * 256 + wr * 64 + fr + ai * 128 + m * 16) * 1024 + col0;
#pragma unroll
          for (int bj = 0; bj < 2; ++bj)
#pragma unroll
            for (int n = 0; n < 2; ++n) *(pg8::f32x4*)(rowp + bj * 128 + n * 16) = acc[ai][bj][m][n];
        }
      return;
    }
#pragma unroll
    for (int ai = 0; ai < 2; ++ai)
#pragma unroll
      for (int m = 0; m < 4; ++m) {
        const int row = row0 + ai * 128 + m * 16; const int b = row / TB, t = row - b * TB;
        const size_t roff = t < SEQ ? (size_t)(b * SEQ + t) * D : (size_t)(b * CTXL + t - SEQ) * D;
        float* xr = (t < SEQ ? out : xc) + roff;
        const float* xi = (t < SEQ ? xin_lat : xin_ctx) + roff;
        const float* g = gate + (t < SEQ ? b : 8) * 6144;
        v2f st_ = {0.f, 1.f}; if (lng) st_ = *(const v2f*)(stats + (size_t)row * 2);
#pragma unroll
        for (int bj = 0; bj < 2; ++bj)
#pragma unroll
          for (int n = 0; n < 2; ++n) {
            const int c = col0 + bj * 128 + n * 16;
            pg8::f32x4 x = *(const pg8::f32x4*)(xi + c); const pg8::f32x4 gg = *(const pg8::f32x4*)(g + c);
            if (lng) x = (x - st_.x) * st_.y * *(const pg8::f32x4*)(lng + c) + *(const pg8::f32x4*)(lnb + c);
            *(pg8::f32x4*)(xr + c) = x * ALPHA + gg * acc[ai][bj][m][n];
          }
      }
  }
};
struct EpiRw1 {
  static constexpr bool PERM = true, AFTER_DRAIN = false;
  u16* RKV; u16* L1;
  __device__ __forceinline__ void operator()(const pg8::f32x4 (&acc)[2][2][4][2], const pg8::Unit& u, int wr, int wc, int fr, int fq) const {
    const int row0 = u.pm * 256 + wr * 64 + fr, lc0 = wc * 32 + 8 * fq;
    if (u.pn < 12) {
      u16* base = RKV + (size_t)(u.pn >> 2) * ((size_t)M * 1024) + (u.pn & 3) * 256 + lc0;
#pragma unroll
      for (int ai = 0; ai < 2; ++ai)
#pragma unroll
        for (int m = 0; m < 4; ++m) {
          u16* rowp = base + (size_t)(row0 + ai * 128 + m * 16) * 1024;
#pragma unroll
          for (int bj = 0; bj < 2; ++bj) {
            const pg8::f32x4 v0 = acc[ai][bj][m][0], v1 = acc[ai][bj][m][1];
            v4u w; w.x = cvtpk(v0[0], v0[1]); w.y = cvtpk(v0[2], v0[3]); w.z = cvtpk(v1[0], v1[1]); w.w = cvtpk(v1[2], v1[3]);
            *(v4u*)(rowp + bj * 128) = w;
          }
        }
    } else {
#pragma unroll
      for (int ai = 0; ai < 2; ++ai)
#pragma unroll
        for (int m = 0; m < 4; ++m) {
          u16* rowp = L1 + (size_t)(row0 + ai * 128 + m * 16) * 384 + (u.pn - 12) * 256 + lc0;
#pragma unroll
          for (int bj = 0; bj < 2; ++bj) {
            if (u.pn == 13 && bj == 1) continue;
            const int mode = (u.pn == 12) ? (bj == 0 ? 1 : 0) : 2;
            float v[8];
#pragma unroll
            for (int j = 0; j < 4; ++j) { v[j] = acc[ai][bj][m][0][j]; v[4 + j] = acc[ai][bj][m][1][j]; }
#pragma unroll
            for (int j = 0; j < 8; ++j) {
              if (mode == 1) v[j] = 1.f - 2.f / (1.f + __expf(2.f * v[j]));
              else if (mode == 2) v[j] = 1.f / (1.f + __expf(-v[j]));
            }
            v4u w; w.x = cvtpk(v[0], v[1]); w.y = cvtpk(v[2], v[3]); w.z = cvtpk(v[4], v[5]); w.w = cvtpk(v[6], v[7]);
            *(v4u*)(rowp + bj * 128) = w;
          }
        }
    }
  }
};

template <class Epi>
__device__ __forceinline__ void run_gemm(unsigned char* smem, const u16* A, const u16* Bt, int Mr, int N, int K, const Epi& E, int skip = 0, int ld = 0, int crot = 0) {
  pg8::Gemm g{A, Bt, Mr, N, K, ld ? ld : K}; pg8::StaticOrder S; S.init(Mr, N, get_gdim(), (get_bid() + crot) & (get_gdim() - 1), skip);
  pg8::gemm_phase<Epi, pg8::StaticOrder, false>((PG8_LAS unsigned char*)smem, g, S, E, nullptr);
  __syncthreads();
}

__device__ __forceinline__ void my_sincos(double x, float& s, float& c) {
  const double kd = rint(x * 0.6366197723675814);
  const int k = (int)kd;
  double r = fma(-kd, 1.5707963267948966, x); r = fma(-kd, 6.123233995736766e-17, r);
  const double r2 = r * r;
  const double sp = r * (1.0 + r2 * (-1.0 / 6.0 + r2 * (1.0 / 120.0 + r2 * (-1.0 / 5040.0 + r2 * (1.0 / 362880.0 + r2 * (-1.0 / 39916800.0 + r2 * (1.0 / 6227020800.0)))))));
  const double cp = 1.0 + r2 * (-0.5 + r2 * (1.0 / 24.0 + r2 * (-1.0 / 720.0 + r2 * (1.0 / 40320.0 + r2 * (-1.0 / 3628800.0 + r2 * (1.0 / 479001600.0 + r2 * (-1.0 / 87178291200.0)))))));
  const int q = k & 3;
  const double ss = (q == 0) ? sp : (q == 1) ? cp : (q == 2) ? -sp : -cp;
  const double cc = (q == 0) ? cp : (q == 1) ? -sp : (q == 2) ? -cp : sp;
  s = (float)ss; c = (float)cc;
}

__device__ void phase_mod(PP p, unsigned char* smem) {
  float* sc = (float*)smem; float* red = sc + 9 * 1024;
  const int tid = get_tid();
  for (int e = tid; e < 9 * 1024; e += 512) { const int j = e >> 10, k = e & 1023; const float v = j < 8 ? p->c[j * 1024 + k] : p->c_ctx[k]; sc[e] = v / (1.f + __expf(-v)); }
  __syncthreads();
  float* MOD = (float*)(p->ws + OFF_MOD);
  for (int item = get_bid(); item < 4 * 48; item += get_gdim()) {
    const int l = item / 48, cb = item % 48, c4 = (tid & 31) * 4, kq = tid >> 5;
    const float* w = p->mod_w + (size_t)l * 1024 * 6144 + cb * 128 + c4;
    v4f acc[9];
#pragma unroll
    for (int j = 0; j < 9; ++j) acc[j] = (v4f){0.f, 0.f, 0.f, 0.f};
#pragma unroll 8
    for (int k = kq * 64; k < kq * 64 + 64; ++k) {
      const v4f wv = *(const v4f*)(w + (size_t)k * 6144);
#pragma unroll
      for (int j = 0; j < 9; ++j) acc[j] += wv * sc[j * 1024 + k];
    }
#pragma unroll
    for (int j = 0; j < 9; ++j) *(v4f*)(red + ((kq * 9 + j) * 128 + c4)) = acc[j];
    __syncthreads();
    for (int o = tid; o < 9 * 128; o += 512) {
      const int j = o >> 7, cl = o & 127;
      float s = p->mod_b[l * 6144 + cb * 128 + cl];
#pragma unroll
      for (int q = 0; q < 16; ++q) s += red[(q * 9 + j) * 128 + cl];
      MOD[(size_t)(l * 9 + j) * 6144 + cb * 128 + cl] = s;
    }
    __syncthreads();
  }
  if (get_bid() == get_gdim() - 1) {
    float* ONES = (float*)(p->ws + OFF_ONES);
    for (int e = tid; e < 2048; e += 512) ONES[e] = e < 1024 ? 1.f : 0.f;
    v2f* TAB = (v2f*)(p->ws + OFF_TAB);
    for (int e = tid; e < 2048; e += 512) {
      const int pos = e >> 5, i = e & 31;
      double f = 1.0; for (int q = 0; q < i; ++q) f *= 0.7498942093324559;
      float s, c; my_sincos((double)pos * f, s, c);
      TAB[e] = (v2f){c, s};
    }
  }
}

__device__ void cvt_T(const float* src, int ldsrc, u16* dst, int ldd, int K, int N, const float* scale, float* tile, int& rot, int bid, int G) {
  const int tid = get_tid();
  const int ntn = N / 64, nt = (K / 64) * ntn;
  const int first = ((bid - rot) % G + G) % G;
  for (int t = first; t < nt; t += G) {
    const int tk = t / ntn, tn = t - tk * ntn;
#pragma unroll
    for (int i = 0; i < 8; ++i) {
      const int e = tid + 512 * i, k = e >> 6, n = e & 63;
      float v = src[(size_t)(tk * 64 + k) * ldsrc + tn * 64 + n];
      if (scale) v *= scale[tk * 64 + k];
      tile[k * 65 + n] = v;
    }
    __syncthreads();
    {
      const int n = tid >> 3, kc = (tid & 7) * 8;
      float v[8];
#pragma unroll
      for (int i = 0; i < 8; ++i) v[i] = tile[(kc + i) * 65 + n];
      v4u w; w.x = cvtpk(v[0], v[1]); w.y = cvtpk(v[2], v[3]); w.z = cvtpk(v[4], v[5]); w.w = cvtpk(v[6], v[7]);
      *(v4u*)(dst + (size_t)(tn * 64 + n) * ldd + tk * 64 + kc) = w;
    }
    __syncthreads();
  }
  rot = (rot + nt) % G;
}
__device__ void zero_bf16(u16* dst, int ldd, int nrows, int c0, int ncols, int bid, int G) {
  const int per = ncols / 8; const long total = (long)nrows * per;
  for (long i = (long)bid * 512 + get_tid(); i < total; i += (long)G * 512) {
    const long r = i / per; const int cc = (int)(i - r * per);
    *(v4u*)(dst + (size_t)r * ldd + c0 + cc * 8) = (v4u){0u, 0u, 0u, 0u};
  }
}

__device__ void convert_layer_weights(PP p, int layer, unsigned char* smem, int bid, int G, int parts = 7) {
  float* tile = (float*)smem; int rot = 0;
  const int kind = layer % 3, slot = layer / 3;
  u16* WB = (u16*)(p->ws + OFF_WB);
  if (parts & 1) cvt_T(p->mlp_w1 + (size_t)layer * 1024 * 4096, 4096, (u16*)(p->ws + OFF_WB + WB_W1T), 1024, 1024, 4096, nullptr, tile, rot, bid, G);
  if (parts & 4) cvt_T(p->mlp_w2 + (size_t)layer * 4096 * 1024, 1024, (u16*)(p->ws + OFF_WB + ((layer & 1) ? WB_W2T_B : WB_W2T)), 4096, 4096, 1024, nullptr, tile, rot, bid, G);
  if (!(parts & 2)) return;
  u16* MIX = (u16*)(p->ws + OFF_WB + WB_MIX);
  if (kind == 0) {
    cvt_T(p->att_wqkv + (size_t)slot * 1024 * 1536, 1536, MIX, 1024, 1024, 1536, nullptr, tile, rot, bid, G);
    cvt_T(p->att_wo + (size_t)slot * 1024 * 1024, 1024, (u16*)(p->ws + OFF_WB + WB_ATT_WO), 1024, 1024, 1024, nullptr, tile, rot, bid, G);
  } else if (kind == 1) {
    cvt_T(p->na_wqkv + (size_t)slot * 1024 * 3072, 3072, MIX, 1024, 1024, 3072, nullptr, tile, rot, bid, G);
    cvt_T(p->na_wo + (size_t)slot * 1024 * 1024, 1024, (u16*)(p->ws + OFF_WB + WB_NA_WO), 1024, 1024, 1024, nullptr, tile, rot, bid, G);
  } else {
    const float* mu = p->rw_mu + (size_t)slot * 6 * 1024;
    {
      const float* s0 = p->rw_wr + (size_t)slot * 1024 * 1024; const float* s1 = p->rw_wk + (size_t)slot * 1024 * 1024; const float* s2 = p->rw_wv + (size_t)slot * 1024 * 1024;
      cvt_T(s0, 1024, MIX, 2048, 1024, 1024, nullptr, tile, rot, bid, G);
      cvt_T(s0, 1024, MIX + 1024, 2048, 1024, 1024, mu + 0 * 1024, tile, rot, bid, G);
      cvt_T(s1, 1024, MIX + (size_t)1024 * 2048, 2048, 1024, 1024, nullptr, tile, rot, bid, G);
      cvt_T(s1, 1024, MIX + (size_t)1024 * 2048 + 1024, 2048, 1024, 1024, mu + 2 * 1024, tile, rot, bid, G);
      cvt_T(s2, 1024, MIX + (size_t)2048 * 2048, 2048, 1024, 1024, nullptr, tile, rot, bid, G);
      cvt_T(s2, 1024, MIX + (size_t)2048 * 2048 + 1024, 2048, 1024, 1024, mu + 3 * 1024, tile, rot, bid, G);
    }
    for (int d = 0; d < 2; ++d) {
      const float* w1 = p->rw_w1 + (size_t)(slot * 2 + d) * 1024 * 64;
      cvt_T(w1, 64, MIX + (size_t)(3072 + 64 * d) * 2048, 2048, 1024, 64, nullptr, tile, rot, bid, G);
      cvt_T(w1, 64, MIX + (size_t)(3072 + 64 * d) * 2048 + 1024, 2048, 1024, 64, mu + 1 * 1024, tile, rot, bid, G);
      const float* a1 = p->rw_a1 + (size_t)(slot * 2 + d) * 1024 * 64;
      cvt_T(a1, 64, MIX + (size_t)(3200 + 64 * d) * 2048, 2048, 1024, 64, nullptr, tile, rot, bid, G);
      cvt_T(a1, 64, MIX + (size_t)(3200 + 64 * d) * 2048 + 1024, 2048, 1024, 64, mu + 4 * 1024, tile, rot, bid, G);
      cvt_T(p->rw_w2 + (size_t)(slot * 2 + d) * 64 * 1024, 1024, (u16*)(p->ws + OFF_WB + WB_RW_W2T) + (size_t)d * 1024 * 64, 64, 64, 1024, nullptr, tile, rot, bid, G);
      cvt_T(p->rw_a2 + (size_t)(slot * 2 + d) * 64 * 1024, 1024, (u16*)(p->ws + OFF_WB + WB_RW_A2T) + (size_t)d * 1024 * 64, 64, 64, 1024, nullptr, tile, rot, bid, G);
    }
    const float* g1 = p->rw_g1 + (size_t)slot * 1024 * 128;
    cvt_T(g1, 128, MIX + (size_t)3328 * 2048, 2048, 1024, 128, nullptr, tile, rot, bid, G);
    cvt_T(g1, 128, MIX + (size_t)3328 * 2048 + 1024, 2048, 1024, 128, mu + 5 * 1024, tile, rot, bid, G);
    zero_bf16(MIX + (size_t)3456 * 2048, 2048, 128, 0, 2048, bid, G);
    cvt_T(p->rw_wo + (size_t)slot * 1024 * 1024, 1024, (u16*)(p->ws + OFF_WB + WB_RW_WO), 1024, 1024, 1024, nullptr, tile, rot, bid, G);
    u16* BG = (u16*)(p->ws + OFF_WB + WB_RW_BG);
    zero_bf16(BG, 384, 1024, 0, 256, bid, G);
    cvt_T(p->rw_g2 + (size_t)slot * 128 * 1024, 1024, BG + 256, 384, 128, 1024, nullptr, tile, rot, bid, G);
  }
  (void)WB;
}

__device__ void rowpass(PP p, int src_ln, int mod_layer, int mod_off, u16* H, int ldh, bool final, bool skipctx = false, int nparts = 0, const float* part = nullptr, int pend_ln = -1, const float* gatec = nullptr, bool ctx_from_input = false) {
  const int wid = get_tid() >> 6, lane = get_tid() & 63;
  const float* MOD = (const float*)(p->ws + OFF_MOD);
  v4f lg_[4], lb_[4];
#pragma unroll
  for (int q = 0; q < 4; ++q) {
    lg_[q] = src_ln >= 0 ? *(const v4f*)(p->ln_g + (size_t)src_ln * 1024 + q * 256 + lane * 4) : (v4f){1.f, 1.f, 1.f, 1.f};
    lb_[q] = src_ln >= 0 ? *(const v4f*)(p->ln_b + (size_t)src_ln * 1024 + q * 256 + lane * 4) : (v4f){0.f, 0.f, 0.f, 0.f};
  }
  for (int row = get_bid() * 8 + wid; row < M; row += get_gdim() * 8) {
    const int b = row / TB, t = row - b * TB;
    if ((final || skipctx) && t >= SEQ) continue;
    float* xr = xrow(p, row);
    const float* src = src_ln < 0 ? (t < SEQ ? p->x + (size_t)(b * SEQ + t) * D : p->ctx + (size_t)(b * CTXL + t - SEQ) * D) : ((ctx_from_input && t >= SEQ) ? p->ctx + (size_t)(b * CTXL + t - SEQ) * D : xr);
    v4f v[4];
#pragma unroll
    for (int q = 0; q < 4; ++q) v[q] = *(const v4f*)(src + q * 256 + lane * 4);
    if (nparts > 0 && t >= SEQ) {
      const v2f ps = *(const v2f*)((const float*)(p->ws + OFF_STATS) + (size_t)row * 2);
      const float* pg_ = pend_ln < 0 ? (const float*)(p->ws + OFF_ONES) : p->ln_g + (size_t)pend_ln * 1024;
      const float* pb_ = pend_ln < 0 ? (const float*)(p->ws + OFF_ONES) + 1024 : p->ln_b + (size_t)pend_ln * 1024;
      const int crow = b * CTXL + t - SEQ;
#pragma unroll
      for (int q = 0; q < 4; ++q) {
        const int c = q * 256 + lane * 4;
        v4f acc = *(const v4f*)(part + (size_t)crow * 1024 + c);
        for (int ks = 1; ks < nparts; ++ks) acc += *(const v4f*)(part + ((size_t)ks * 2048 + crow) * 1024 + c);
        v[q] = ((v[q] - ps.x) * ps.y * *(const v4f*)(pg_ + c) + *(const v4f*)(pb_ + c)) * ALPHA + *(const v4f*)(gatec + c) * acc;
        *(v4f*)(xr + c) = v[q];
      }
    }
    if (src_ln >= 0) {
      float s = 0.f;
#pragma unroll
      for (int q = 0; q < 4; ++q) s += (v[q][0] + v[q][1]) + (v[q][2] + v[q][3]);
      const float mean = wave_sum(s) * (1.f / 1024.f);
      float sq = 0.f;
#pragma unroll
      for (int q = 0; q < 4; ++q) { v[q] = v[q] - mean; sq += (v[q][0] * v[q][0] + v[q][1] * v[q][1]) + (v[q][2] * v[q][2] + v[q][3] * v[q][3]); }
      const float rstd = 1.0f / sqrtf(wave_sum(sq) * (1.f / 1024.f) + LN_EPS);
      if (lane == 0 && !final) *(v2f*)((float*)(p->ws + OFF_STATS) + (size_t)row * 2) = (v2f){mean, rstd};
#pragma unroll
      for (int q = 0; q < 4; ++q) v[q] = v[q] * rstd * lg_[q] + lb_[q];
    }
    if (final) {
#pragma unroll
      for (int q = 0; q < 4; ++q) *(v4f*)(xr + q * 256 + lane * 4) = v[q];
    }
    if (src_ln < 0 && lane == 0) *(v2f*)((float*)(p->ws + OFF_STATS) + (size_t)row * 2) = (v2f){0.f, 1.f};
    if (final) continue;
    const float* md = MOD + (size_t)(mod_layer * 9 + (t < SEQ ? b : 8)) * 6144 + mod_off * 1024;
#pragma unroll
    for (int q = 0; q < 4; ++q) {
      const v4f sh = *(const v4f*)(md + q * 256 + lane * 4), scl = *(const v4f*)(md + 1024 + q * 256 + lane * 4);
      const v4f h = v[q] * (scl + 1.f) + sh;
      v2u w; w.x = cvtpk(h[0], h[1]); w.y = cvtpk(h[2], h[3]);
      *(v2u*)(H + (size_t)row * ldh + q * 256 + lane * 4) = w;
    }
  }
}

__device__ void xx_pass(PP p) {
  u16* HX = (u16*)(p->ws + OFF_AR + AR_H);
  for (long idx = (long)get_bid() * 512 + get_tid(); idx < (long)M * 128; idx += (long)get_gdim() * 512) {
    const int row = (int)(idx >> 7), c8 = (int)(idx & 127) * 8;
    const int t = row % TB;
    const bool first = (t == 0) || (t == SEQ), last = (t == SEQ - 1) || (t == TB - 1);
    const v4u z = {0u, 0u, 0u, 0u};
    const v4u h = *(const v4u*)(HX + (size_t)row * 2048 + c8);
    const v4u hp = first ? z : *(const v4u*)(HX + (size_t)(row - 1) * 2048 + c8);
    const v4u hn = last ? z : *(const v4u*)(HX + (size_t)(row + 1) * 2048 + c8);
    v4u o;
#pragma unroll
    for (int j = 0; j < 4; ++j) {
      const float lo = 0.5f * (bflo(hp[j]) + bflo(hn[j])) - bflo(h[j]);
      const float hi = 0.5f * (bfhi(hp[j]) + bfhi(hn[j])) - bfhi(h[j]);
      o[j] = cvtpk(lo, hi);
    }
    *(v4u*)(HX + (size_t)row * 2048 + 1024 + c8) = o;
  }
}

__device__ void qk_prep(PP p, int slot) {
  u16* QKV = (u16*)(p->ws + OFF_AR + AR_QKV);
  const v2f* TAB = (const v2f*)(p->ws + OFF_TAB);
  const int tid = get_tid(), q = tid & 15, d0 = q * 8;
  const float* qn = p->att_qn + slot * 128; const float* kn = p->att_kn + slot * 128;
  const int pq = q ^ 4, pd0 = pq * 8;
  const bool up = (q & 4) != 0;
  const int i0 = d0 & 31;
  const bool colang = q >= 8;
  float gq_[8], gk_[8], pgq_[8], pgk_[8];
#pragma unroll
  for (int j = 0; j < 8; ++j) { gq_[j] = qn[d0 + j]; gk_[j] = kn[d0 + j]; pgq_[j] = qn[pd0 + j]; pgk_[j] = kn[pd0 + j]; }
  const int total = M * 2, stride = get_gdim() * 32;
  for (int it0 = get_bid() * 32 + (tid >> 4); it0 < total; it0 += stride * 4) {
    v4u raws[4];
#pragma unroll
    for (int uu = 0; uu < 4; ++uu) {
      const int it = it0 + uu * stride;
      if (it < total) { const int row = it >> 1, hs = 8 + (it & 1); raws[uu] = *(const v4u*)(QKV + (size_t)row * 1536 + hs * 128 + d0); }
    }
#pragma unroll
    for (int uu = 0; uu < 4; ++uu) {
      const int it = it0 + uu * stride;
      if (it < total) {
        const int row = it >> 1, hs = 8 + (it & 1);
        u16* base = QKV + (size_t)row * 1536 + hs * 128 + d0;
        const v4u raw = raws[uu];
        v4u praw;
#pragma unroll
        for (int j = 0; j < 4; ++j) praw[j] = (unsigned)__shfl_xor((int)raw[j], 4);
        float e[8], pe[8];
#pragma unroll
        for (int j = 0; j < 4; ++j) { e[2 * j] = bflo(raw[j]); e[2 * j + 1] = bfhi(raw[j]); pe[2 * j] = bflo(praw[j]); pe[2 * j + 1] = bfhi(praw[j]); }
        float ss = 0.f;
#pragma unroll
        for (int j = 0; j < 8; ++j) ss += e[j] * e[j];
        ss = row_sum16(ss);
        const float rn = 1.0f / sqrtf(ss * (1.f / 128.f) + LN_EPS);
        const bool isq = hs < 8;
        const int t = row % TB;
        const bool rope = t < SEQ;
        const int pos = colang ? (t & 63) : (t >> 6);
        float o[8];
        if (rope) {
          const v4f* tp = (const v4f*)(TAB + (pos & 63) * 32 + i0);
          const v4f c01 = tp[0], c23 = tp[1], c45 = tp[2], c67 = tp[3];
          const float cs_[8] = {c01[0], c01[2], c23[0], c23[2], c45[0], c45[2], c67[0], c67[2]};
          const float sn_[8] = {c01[1], c01[3], c23[1], c23[3], c45[1], c45[3], c67[1], c67[3]};
#pragma unroll
          for (int j = 0; j < 8; ++j) {
            const float x = e[j] * rn * (isq ? gq_[j] : gk_[j]);
            const float px = pe[j] * rn * (isq ? pgq_[j] : pgk_[j]);
            o[j] = x * cs_[j] + (up ? px : -px) * sn_[j];
          }
        } else {
#pragma unroll
          for (int j = 0; j < 8; ++j) o[j] = e[j] * rn * (isq ? gq_[j] : gk_[j]);
        }
        v4u w; w.x = cvtpk(o[0], o[1]); w.y = cvtpk(o[2], o[3]); w.z = cvtpk(o[4], o[5]); w.w = cvtpk(o[6], o[7]);
        *(v4u*)base = w;
      }
    }
  }
}

namespace att {
constexpr int DH = 128, NW = 8, QBLK = 32, KVBLK = 64;
constexpr float SCALE = 0.088388347648318440f;
constexpr float THR = 8.f;
constexpr int LDQ = 1536, LDK = 1536, LDO = 1024;
constexpr size_t SHM_V = KVBLK * DH * 2, SHM_K = KVBLK * DH * 2;
#define KSWZ(row, colB) ((row) * 256 + ((colB) ^ (((row) & 7) << 4)))
#define SBAR() __builtin_amdgcn_sched_barrier(0)
__device__ __forceinline__ void partialSM(v16f& p0, v16f& p1, float& m_reg, float& mn, float& alpha) {
  constexpr float C = SCALE * 1.4426950408889634f;
  float pmax = p0[0];
#pragma unroll
  for (int r = 1; r < 16; ++r) pmax = fmaxf(pmax, p0[r]);
#pragma unroll
  for (int r = 0; r < 16; ++r) pmax = fmaxf(pmax, p1[r]);
  { auto rr = __builtin_amdgcn_permlane32_swap(__float_as_uint(pmax), __float_as_uint(pmax), false, false);
    pmax = fmaxf(__uint_as_float(rr[0]), __uint_as_float(rr[1])); }
  if (__builtin_expect(__all(pmax - m_reg <= THR / SCALE), 1)) { mn = m_reg; alpha = 1.f; }
  else { mn = fmaxf(m_reg, pmax); alpha = __builtin_amdgcn_exp2f((m_reg - mn) * C); m_reg = mn; }
  float mnC = -mn * C;
#pragma unroll
  for (int r = 0; r < 16; ++r) p0[r] = fmaf(p0[r], C, mnC);
#pragma unroll
  for (int r = 0; r < 16; ++r) p1[r] = fmaf(p1[r], C, mnC);
#pragma unroll
  for (int r = 0; r < 16; ++r) p0[r] = __builtin_amdgcn_exp2f(p0[r]);
}
__device__ __forceinline__ void finishSM(v16f& p0, v16f& p1, float alpha, float& l_reg, v8s& pa0, v8s& pa1, v8s& pa2, v8s& pa3) {
#pragma unroll
  for (int r = 0; r < 16; ++r) p1[r] = __builtin_amdgcn_exp2f(p1[r]);
  float ps = 0;
#pragma unroll
  for (int r = 0; r < 16; ++r) ps += p0[r];
#pragma unroll
  for (int r = 0; r < 16; ++r) ps += p1[r];
  { auto rr = __builtin_amdgcn_permlane32_swap(__float_as_uint(ps), __float_as_uint(ps), false, false);
    ps = __uint_as_float(rr[0]) + __uint_as_float(rr[1]); }
  l_reg = l_reg * alpha + ps;
#define PK4(Pv, BASE, OUT) do { unsigned a0 = cvtpk(Pv[BASE + 0], Pv[BASE + 1]), a1 = cvtpk(Pv[BASE + 2], Pv[BASE + 3]);   \
    unsigned b0 = cvtpk(Pv[BASE + 4], Pv[BASE + 5]), b1 = cvtpk(Pv[BASE + 6], Pv[BASE + 7]);                              \
    auto r0 = __builtin_amdgcn_permlane32_swap(a0, b0, false, false); auto r1 = __builtin_amdgcn_permlane32_swap(a1, b1, false, false); \
    v4u w = {r0[0], r1[0], r0[1], r1[1]}; OUT = *reinterpret_cast<v8s*>(&w); } while (0)
  PK4(p0, 0, pa0); PK4(p0, 8, pa1); PK4(p1, 0, pa2); PK4(p1, 8, pa3);
#undef PK4
}
__device__ __forceinline__ void qkt(v16f& p0, v16f& p1, const u16* Ks, const v8s* qr, int r32, int hi) {
  p0 = v16f{}; p1 = v16f{};
#pragma unroll
  for (int d0 = 0; d0 < 8; ++d0) { int cb = (d0 * 16 + hi * 8) * 2;
    v8s b0 = *reinterpret_cast<const v8s*>((const char*)Ks + KSWZ(r32, cb));
    v8s b1 = *reinterpret_cast<const v8s*>((const char*)Ks + KSWZ(32 + r32, cb));
    p0 = __builtin_amdgcn_mfma_f32_32x32x16_bf16(b0, qr[d0], p0, 0, 0, 0);
    p1 = __builtin_amdgcn_mfma_f32_32x32x16_bf16(b1, qr[d0], p1, 0, 0, 0); }
}
__device__ __forceinline__ int v_st(int k, int c) { const int kk = (k & ~0xC) | ((k & 4) << 1) | ((k & 8) >> 1); return ((kk >> 3) * 4 + (c >> 5)) * 512 + ((kk & 7) * 32 + (c & 31)) * 2; }
__device__ __forceinline__ int v_rd_base(int lane) { return ((lane & 3) << 3) | (((lane >> 2) & 3) << 6) | (((lane >> 4) & 1) << 5) | (((lane >> 5) & 1) << 8); }
constexpr int v_rd_off(int d0, int ks, int half) { return d0 * 512 + ks * 4096 + half * 2048; }
template <int OFF> __device__ __forceinline__ v4s tr_read(int vb) {
  v4s r; asm volatile("ds_read_b64_tr_b16 %0, %1 offset:%2" : "=&v"(r) : "v"(vb), "i"(OFF) : "memory"); return r;
}
template <int D0> __device__ __forceinline__ void pv_one(v16f& od, int vb, v8s pa0, v8s pa1, v8s pa2, v8s pa3) {
  const v4s l0 = tr_read<v_rd_off(D0, 0, 0)>(vb), h0 = tr_read<v_rd_off(D0, 0, 1)>(vb), l1 = tr_read<v_rd_off(D0, 1, 0)>(vb), h1 = tr_read<v_rd_off(D0, 1, 1)>(vb);
  const v4s l2 = tr_read<v_rd_off(D0, 2, 0)>(vb), h2 = tr_read<v_rd_off(D0, 2, 1)>(vb), l3 = tr_read<v_rd_off(D0, 3, 0)>(vb), h3 = tr_read<v_rd_off(D0, 3, 1)>(vb);
  asm volatile("s_waitcnt lgkmcnt(0)" ::: "memory"); SBAR();
#define PKV(L, H) (v8s){L[0], L[1], L[2], L[3], H[0], H[1], H[2], H[3]}
  od = __builtin_amdgcn_mfma_f32_32x32x16_bf16(pa0, PKV(l0, h0), od, 0, 0, 0);
  od = __builtin_amdgcn_mfma_f32_32x32x16_bf16(pa1, PKV(l1, h1), od, 0, 0, 0);
  od = __builtin_amdgcn_mfma_f32_32x32x16_bf16(pa2, PKV(l2, h2), od, 0, 0, 0);
  od = __builtin_amdgcn_mfma_f32_32x32x16_bf16(pa3, PKV(l3, h3), od, 0, 0, 0);
#undef PKV
}
__device__ __forceinline__ void pv_d0(v16f* o, int vb, v8s pa0, v8s pa1, v8s pa2, v8s pa3) {
  pv_one<0>(o[0], vb, pa0, pa1, pa2, pa3); pv_one<1>(o[1], vb, pa0, pa1, pa2, pa3); pv_one<2>(o[2], vb, pa0, pa1, pa2, pa3); pv_one<3>(o[3], vb, pa0, pa1, pa2, pa3);
}
__device__ __forceinline__ void attn_dense_body(const u16* __restrict__ Qb, const u16* __restrict__ Kh, const u16* __restrict__ Vh,
                                                u16* __restrict__ Ob, int seq, char* lds, const float* __restrict__ qn, const v2f* __restrict__ TAB, int t0, bool rope) {
  const int tid = get_tid(), wid = tid >> 6, lane = tid & 63, r32 = lane & 31, hi = lane >> 5;
  u16* V_lds = (u16*)lds; u16* K_lds = (u16*)(lds + 2 * SHM_V);
  float* ws = (float*)(lds + 2 * SHM_V + 2 * SHM_K) + wid * 64; float* li_l = ws; float* al_l = ws + 32;
  float m_reg = -1e30f, l_reg = 0; v16f o[4] = {}; v8s qr[8];
  const u16* Qw = Qb + (long)(wid * QBLK + r32) * LDQ + hi * 8;
#pragma unroll
  for (int d0 = 0; d0 < 8; ++d0) qr[d0] = *reinterpret_cast<const v8s*>(Qw + d0 * 16);
  {
    float xq[8][8]; float ss = 0.f;
#pragma unroll
    for (int d0 = 0; d0 < 8; ++d0) {
      const v4u w = *reinterpret_cast<const v4u*>(&qr[d0]);
#pragma unroll
      for (int j = 0; j < 4; ++j) { xq[d0][2 * j] = bflo(w[j]); xq[d0][2 * j + 1] = bfhi(w[j]); ss += xq[d0][2 * j] * xq[d0][2 * j] + xq[d0][2 * j + 1] * xq[d0][2 * j + 1]; }
    }
    ss += __shfl_xor(ss, 32);
    const float rn = 1.0f / sqrtf(ss * (1.f / 128.f) + LN_EPS);
#pragma unroll
    for (int d0 = 0; d0 < 8; ++d0) {
      const v4f g0 = *(const v4f*)(qn + d0 * 16 + hi * 8), g1 = *(const v4f*)(qn + d0 * 16 + hi * 8 + 4);
#pragma unroll
      for (int e = 0; e < 4; ++e) { xq[d0][e] *= rn * g0[e]; xq[d0][4 + e] *= rn * g1[e]; }
    }
    if (rope) {
      const int t = t0 + wid * QBLK + r32;
#pragma unroll
      for (int m = 0; m < 2; ++m)
#pragma unroll
        for (int ax = 0; ax < 2; ++ax) {
          const int pos = ax ? (t & 63) : (t >> 6);
          const v4f* tp = (const v4f*)(TAB + pos * 32 + 16 * m + 8 * hi);
          const int da = m + 4 * ax, db = da + 2;
#pragma unroll
          for (int e2 = 0; e2 < 4; ++e2) {
            const v4f cs = tp[e2];
#pragma unroll
            for (int k = 0; k < 2; ++k) {
              const float c_ = cs[2 * k], s_ = cs[2 * k + 1];
              const float xa = xq[da][2 * e2 + k], xb = xq[db][2 * e2 + k];
              xq[da][2 * e2 + k] = xa * c_ - xb * s_;
              xq[db][2 * e2 + k] = xb * c_ + xa * s_;
            }
          }
        }
    }
#pragma unroll
    for (int d0 = 0; d0 < 8; ++d0) {
      v4u w; w.x = cvtpk(xq[d0][0], xq[d0][1]); w.y = cvtpk(xq[d0][2], xq[d0][3]); w.z = cvtpk(xq[d0][4], xq[d0][5]); w.w = cvtpk(xq[d0][6], xq[d0][7]);
      qr[d0] = *reinterpret_cast<v8s*>(&w);
    }
  }
  const int sr = tid >> 4, sc = (tid & 15) * 8, vst0 = v_st(sr, sc), vst1 = v_st(32 + sr, sc);
  const int vb0 = (int)(uintptr_t)V_lds + v_rd_base(lane);
  struct { v8s vs0, vs1, ks0, ks1; } sr_[2];
#define SLOAD(i, k0) do { sr_[i].vs0 = *(const v8s*)(&Vh[(long)((k0) + sr) * LDK + sc]); sr_[i].vs1 = *(const v8s*)(&Vh[(long)((k0) + 32 + sr) * LDK + sc]); \
    sr_[i].ks0 = *(const v8s*)(&Kh[(long)((k0) + sr) * LDK + sc]); sr_[i].ks1 = *(const v8s*)(&Kh[(long)((k0) + 32 + sr) * LDK + sc]); } while (0)
#define SWRITE(b, i) do { *(v8s*)((char*)V_lds + (b) * SHM_V + vst0) = sr_[i].vs0;          \
    *(v8s*)((char*)V_lds + (b) * SHM_V + vst1) = sr_[i].vs1; int kc = sc * 2;               \
    *(v8s*)((char*)K_lds + (b) * SHM_K + KSWZ(sr, kc)) = sr_[i].ks0;                       \
    *(v8s*)((char*)K_lds + (b) * SHM_K + KSWZ(32 + sr, kc)) = sr_[i].ks1; } while (0)
#define SWAIT() asm volatile("s_waitcnt vmcnt(4)" ::: "memory")
#define RESC(a) do { if (__any((a) < 1.f)) { if (hi == 0) al_l[r32] = (a); asm volatile("s_waitcnt lgkmcnt(0)" ::: "memory"); \
    for (int d = 0; d < 4; ++d) for (int r = 0; r < 16; ++r) o[d][r] *= al_l[crow(r, hi)]; } } while (0)
  v16f pA0, pA1, pB0, pB1; float mnA, mnB, alA, alB; v8s pa0, pa1, pa2, pa3; const int NT = seq / KVBLK;
  constexpr int SE = 0, SO = 1;
  SLOAD(SE, 0); asm volatile("s_waitcnt vmcnt(0)" ::: "memory"); SWRITE(0, SE); __syncthreads();
  qkt(pA0, pA1, K_lds, qr, r32, hi); partialSM(pA0, pA1, m_reg, mnA, alA);
  SLOAD(SO, KVBLK); if (2 < NT) SLOAD(SE, 2 * KVBLK);
  SWAIT(); SWRITE(1, SO); __syncthreads();
  for (int j = 1; j + 1 < NT; j += 2) {
    SBAR(); qkt(pB0, pB1, (u16*)((char*)K_lds + SHM_K), qr, r32, hi);
    finishSM(pA0, pA1, alA, l_reg, pa0, pa1, pa2, pa3); SBAR();
    SLOAD(SO, (j + 2) * KVBLK); SBAR();
    pv_d0(o, vb0, pa0, pa1, pa2, pa3); partialSM(pB0, pB1, m_reg, mnB, alB);
    __syncthreads(); SWAIT(); SWRITE(0, SE);
    RESC(alB); __syncthreads();
    SBAR(); qkt(pA0, pA1, K_lds, qr, r32, hi);
    finishSM(pB0, pB1, alB, l_reg, pa0, pa1, pa2, pa3); SBAR();
    if (j + 3 < NT) SLOAD(SE, (j + 3) * KVBLK); SBAR();
    pv_d0(o, vb0 + (int)SHM_V, pa0, pa1, pa2, pa3); partialSM(pA0, pA1, m_reg, mnA, alA);
    __syncthreads(); SWAIT(); SWRITE(1, SO);
    RESC(alA); __syncthreads();
  }
  SBAR(); qkt(pB0, pB1, (u16*)((char*)K_lds + SHM_K), qr, r32, hi);
  finishSM(pA0, pA1, alA, l_reg, pa0, pa1, pa2, pa3); SBAR();
  pv_d0(o, vb0, pa0, pa1, pa2, pa3); partialSM(pB0, pB1, m_reg, mnB, alB);
  __syncthreads(); RESC(alB);
  finishSM(pB0, pB1, alB, l_reg, pa0, pa1, pa2, pa3); SBAR();
  pv_d0(o, vb0 + (int)SHM_V, pa0, pa1, pa2, pa3);
  if (hi == 0) li_l[r32] = l_reg; asm volatile("s_waitcnt lgkmcnt(0)" ::: "memory");
  float rli[16];
#pragma unroll
  for (int r = 0; r < 16; ++r) rli[r] = __builtin_amdgcn_rcpf(li_l[crow(r, hi)]);
  u16* Ow = Ob + (long)(wid * QBLK) * LDO;
#pragma unroll
  for (int r = 0; r < 16; ++r) { int orow = crow(r, hi);
#pragma unroll
    for (int d0 = 0; d0 < 4; ++d0) { const float val = o[d0][r] * rli[r]; Ow[(long)orow * LDO + d0 * 32 + r32] = (u16)(cvtpk(val, val) & 0xffffu); } }
#undef SLOAD
#undef SWRITE
#undef SWAIT
#undef RESC
}
}

__device__ void gqa_attention(PP p, unsigned char* smem, bool want_ctx, int slot) {
  const u16* QKV = (const u16*)(p->ws + OFF_AR + AR_QKV);
  u16* O = (u16*)(p->ws + OFF_AR + AR_ATT_O);
  const int nitems = 1024 + (want_ctx ? 64 : 0);
  for (int item = get_bid(); item < nitems; item += get_gdim()) {
    int b, h, qrow, krow, seq;
    if (item < 1024) { b = item >> 7; const int rem = item & 127; h = rem >> 4; qrow = b * TB + (rem & 15) * 256; krow = b * TB; seq = TB; }
    else { const int ci = item - 1024; b = ci >> 3; h = ci & 7; qrow = b * TB + SEQ; krow = b * TB + SEQ; seq = CTXL; }
    const int kvh = h >> 2;
    att::attn_dense_body(QKV + (size_t)qrow * 1536 + h * 128, QKV + (size_t)krow * 1536 + 1024 + kvh * 128, QKV + (size_t)krow * 1536 + 1280 + kvh * 128,
                         O + (size_t)qrow * 1024 + h * 128, seq, (char*)smem, p->att_qn + slot * 128, (const v2f*)(p->ws + OFF_TAB), qrow - b * TB, item < 1024);
    __syncthreads();
  }
}

__device__ void na_attention(PP p, unsigned char* smem, bool want_ctx) {
  const u16* QK = (const u16*)(p->ws + OFF_AR + AR_NA_QK);
  const u16* VT = (const u16*)(p->ws + OFF_AR + AR_NA_VT);
  u16* O = (u16*)(p->ws + OFF_AR + AR_NA_O);
  const int tid = get_tid(), wid = tid >> 6, lane = tid & 63, r32 = lane & 31, hi = lane >> 5;
  float* rpbl = (float*)smem + wid * 640 + 64;
  u16* Kb = (u16*)(smem + 24576) + wid * 4864;
  u16* Vb = Kb + 32 * 72;
  constexpr float C1 = 0.125f * LOG2E;
  const int nrows = 64 + (want_ctx ? 4 : 0);
  for (int item = get_bid(); item < NB * nrows * 2; item += get_gdim()) {
    int hh, rr, b;
    if (item < NB * 64 * 2) { hh = item & 1; rr = (item >> 1) & 63; b = item >> 7; }
    else { const int ci = item - NB * 64 * 2; hh = ci & 1; rr = 64 + ((ci >> 1) & 3); b = ci >> 3; }
    const int h = hh * 8 + wid;
    const bool isctx = rr >= 64;
    const int r = isctx ? 0 : rr;
    for (int e = lane; e < 465; e += 64) rpbl[e] = p->na_rpb[h * 465 + e] * LOG2E;
    const int r0 = min(max(r - 4, 0), 56);
    const size_t qrow0 = (size_t)b * TB + (isctx ? SEQ + (rr - 64) * 64 : r * 64);
    v8s qf[2][4];
#pragma unroll
    for (int qb = 0; qb < 2; ++qb)
#pragma unroll
      for (int ks = 0; ks < 4; ++ks) qf[qb][ks] = *(const v8s*)(QK + (qrow0 + qb * 32 + r32) * 2048 + h * 64 + ks * 16 + hi * 8);
    v16f o[2][2];
#pragma unroll
    for (int a = 0; a < 2; ++a)
#pragma unroll
      for (int c = 0; c < 2; ++c) o[a][c] = v16f{};
    float m_run[2] = {-1e30f, -1e30f}, l_run[2] = {0.f, 0.f};
    v8s kreg[4], vreg[4];
#define NA_KEYROW(tt) ((size_t)b * TB + ((tt) < 16 ? (r0 + ((tt) >> 1)) * 64 + ((tt) & 1) * 32 : SEQ + ((tt) - 16) * 32))
#define NA_GLOAD_K(tt) do { const size_t _kr0 = NA_KEYROW(tt); \
      _Pragma("unroll") for (int i = 0; i < 4; ++i) kreg[i] = *(const v8s*)(QK + (_kr0 + (lane >> 3) + 8 * i) * 2048 + 1024 + h * 64 + (lane & 7) * 8); } while (0)
#define NA_GLOAD_V(tt) do { const size_t _kr0 = NA_KEYROW(tt); \
      _Pragma("unroll") for (int i = 0; i < 4; ++i) vreg[i] = *(const v8s*)(VT + (size_t)(h * 64 + (lane >> 2) + 16 * i) * M + _kr0 + (lane & 3) * 8); } while (0)
    NA_GLOAD_K(isctx ? 16 : 0); NA_GLOAD_V(isctx ? 16 : 0);
    for (int t = isctx ? 16 : 0; t < 24; ++t) {
      const bool local = t < 16; const int j = t >> 1, hf = t & 1;
#pragma unroll
      for (int i = 0; i < 4; ++i) {
        *(v8s*)(Kb + ((lane >> 3) + 8 * i) * 72 + (lane & 7) * 8) = kreg[i];
        *(v8s*)(Vb + ((lane >> 2) + 16 * i) * 40 + (lane & 3) * 8) = vreg[i];
      }
      if (t + 1 < 24) { NA_GLOAD_K(t + 1); NA_GLOAD_V(t + 1); }
      v8s kf[4];
#pragma unroll
      for (int ks = 0; ks < 4; ++ks) kf[ks] = *(const v8s*)(Kb + r32 * 72 + ks * 16 + hi * 8);
      v8s pf[2][2];
      v16f sc2[2];
#pragma unroll
      for (int qb = 0; qb < 2; ++qb) {
        sc2[qb] = v16f{};
#pragma unroll
        for (int ks = 0; ks < 4; ++ks) sc2[qb] = __builtin_amdgcn_mfma_f32_32x32x16_bf16(kf[ks], qf[qb][ks], sc2[qb], 0, 0, 0);
      }
#pragma unroll
      for (int qb = 0; qb < 2; ++qb) {
        v16f scq = sc2[qb];
        const int c = qb * 32 + r32; const int cs = min(max(c - 8, 0), 48);
        float mx = -3e38f;
        if (local) {
          const float* bp = rpbl + (r0 + j - r + 7) * 31 + (hf * 32 + 4 * hi - c + 15);
          const int vlo = hf * 32 + 4 * hi - cs;
#pragma unroll
          for (int hb = 0; hb < 2; ++hb) {
            float bv[8];
#pragma unroll
            for (int i = 0; i < 8; ++i) bv[i] = bp[8 * (2 * hb + (i >> 2)) + (i & 3)];
            asm volatile("" : "+v"(bv[0]), "+v"(bv[1]), "+v"(bv[2]), "+v"(bv[3]), "+v"(bv[4]), "+v"(bv[5]), "+v"(bv[6]), "+v"(bv[7]));
#pragma unroll
            for (int i = 0; i < 8; ++i) {
              const int K_i = 8 * (2 * hb + (i >> 2)) + (i & 3);
              const bool valid = (unsigned)(vlo + K_i) < 16u;
              const float s = valid ? fmaf(scq[8 * hb + i], C1, bv[i]) : -3e38f;
              scq[8 * hb + i] = s; mx = fmaxf(mx, s);
            }
          }
        } else {
#pragma unroll
          for (int i = 0; i < 16; ++i) { const float s = scq[i] * C1; scq[i] = s; mx = fmaxf(mx, s); }
        }
        { auto rr = __builtin_amdgcn_permlane32_swap(__float_as_uint(mx), __float_as_uint(mx), false, false); mx = fmaxf(__uint_as_float(rr[0]), __uint_as_float(rr[1])); }
        const float mnew = fmaxf(m_run[qb], mx);
        const float alpha = __builtin_amdgcn_exp2f(m_run[qb] - mnew);
        m_run[qb] = mnew;
        float ps = 0.f;
#pragma unroll
        for (int i = 0; i < 16; ++i) { const float e = __builtin_amdgcn_exp2f(scq[i] - mnew); scq[i] = e; ps += e; }
        { auto rr = __builtin_amdgcn_permlane32_swap(__float_as_uint(ps), __float_as_uint(ps), false, false); ps = __uint_as_float(rr[0]) + __uint_as_float(rr[1]); }
        l_run[qb] = l_run[qb] * alpha + ps;
#pragma unroll
        for (int db = 0; db < 2; ++db)
#pragma unroll
          for (int i = 0; i < 16; ++i) o[db][qb][i] *= alpha;
#pragma unroll
        for (int s = 0; s < 2; ++s) {
          v4u w; w.x = cvtpk(scq[8 * s + 0], scq[8 * s + 1]); w.y = cvtpk(scq[8 * s + 2], scq[8 * s + 3]);
          w.z = cvtpk(scq[8 * s + 4], scq[8 * s + 5]); w.w = cvtpk(scq[8 * s + 6], scq[8 * s + 7]);
          pf[qb][s] = *reinterpret_cast<v8s*>(&w);
        }
      }
      v8s vf[2][2];
#pragma unroll
      for (int db = 0; db < 2; ++db)
#pragma unroll
        for (int s = 0; s < 2; ++s) {
          const u16* vp = Vb + (db * 32 + r32) * 40 + 16 * s + 4 * hi;
          const v4s lo = *(const v4s*)vp, hi4 = *(const v4s*)(vp + 8);
          vf[db][s] = (v8s){lo[0], lo[1], lo[2], lo[3], hi4[0], hi4[1], hi4[2], hi4[3]};
        }
#pragma unroll
      for (int db = 0; db < 2; ++db)
#pragma unroll
        for (int qb = 0; qb < 2; ++qb)
#pragma unroll
          for (int s = 0; s < 2; ++s) o[db][qb] = __builtin_amdgcn_mfma_f32_32x32x16_bf16(vf[db][s], pf[qb][s], o[db][qb], 0, 0, 0);
    }
#pragma unroll
    for (int qb = 0; qb < 2; ++qb) {
      const float rl = 1.0f / l_run[qb];
      u16* orow = O + (qrow0 + qb * 32 + r32) * 1024 + h * 64;
#pragma unroll
      for (int db = 0; db < 2; ++db)
#pragma unroll
        for (int g4 = 0; g4 < 4; ++g4) {
          v2u w; w.x = cvtpk(o[db][qb][4 * g4 + 0] * rl, o[db][qb][4 * g4 + 1] * rl); w.y = cvtpk(o[db][qb][4 * g4 + 2] * rl, o[db][qb][4 * g4 + 3] * rl);
          *(v2u*)(orow + db * 32 + 8 * g4 + 4 * hi) = w;
        }
    }
  }
}

__device__ __forceinline__ int scan_row(int b, int dir, int s) {
  const int t = s < CTXL ? (dir ? TB - 1 - s : SEQ + s) : (dir ? SEQ - 1 - (s - CTXL) : s - CTXL);
  return b * TB + t;
}
__device__ __forceinline__ float dot4(v4f a, v4f b) { return (a[0] * b[0] + a[1] * b[1]) + (a[2] * b[2] + a[3] * b[3]); }

__device__ void rwkv_scan(PP p, unsigned char* smem, int slot) {
  constexpr int T = 32, NCH = TB / T;
  float* VEC = (float*)smem; float* VV = (float*)(smem + 40960); float* SC = (float*)(smem + 49152); float* YB = (float*)(smem + 49408); float* TMP = (float*)(smem + 57600);
  const int tid = get_tid(), wid = tid >> 6, lane = tid & 63;
  const u16* Rg = (const u16*)(p->ws + OFF_AR + AR_R); const u16* Kg = (const u16*)(p->ws + OFF_AR + AR_K); const u16* Vg = (const u16*)(p->ws + OFF_AR + AR_V);
  const u16* L1 = (const u16*)(p->ws + OFF_AR + AR_L1);
  float* BON = (float*)(p->ws + OFF_BON);
  for (int item = get_bid(); item < 256; item += get_gdim()) {
    const int dir = item >> 7, b = (item >> 4) & 7, h = item & 15;
    u16* Yd = (u16*)(p->ws + OFF_AR + (dir ? AR_Y1 : AR_Y0));
    const int st = tid >> 4, c0 = (tid & 15) * 4, ch = h * 64 + c0;
    const v4f w0 = *(const v4f*)(p->rw_w0 + (size_t)(slot * 2 + dir) * 1024 + ch), a0 = *(const v4f*)(p->rw_a0 + (size_t)(slot * 2 + dir) * 1024 + ch);
    const v4f kkc = *(const v4f*)(p->rw_kk + (size_t)slot * 1024 + ch), kac = *(const v4f*)(p->rw_ka + (size_t)slot * 1024 + ch), rkc = *(const v4f*)(p->rw_rk + (size_t)slot * 1024 + ch);
    const int qn = wid >> 2, rb = (wid >> 1) & 1, cbp = wid & 1, l16 = lane & 15, lq = lane >> 4;
    const u16* WT = (const u16*)(p->ws + OFF_WB + (qn ? WB_RW_A2T : WB_RW_W2T)) + ((size_t)dir * 1024 + h * 64) * 64;
    v8s bfr[2][2];
#pragma unroll
    for (int cb = 0; cb < 2; ++cb)
#pragma unroll
      for (int ks = 0; ks < 2; ++ks) bfr[cb][ks] = *(const v8s*)(WT + (size_t)((cbp * 2 + cb) * 16 + l16) * 64 + ks * 32 + lq * 8);
    v4f S0 = {0.f, 0.f, 0.f, 0.f}, S1 = {0.f, 0.f, 0.f, 0.f};
    const int i0 = 8 * wid + 2 * (lane >> 4);
    v2u pr_r, pr_k, pr_v; v8s pa[2];
#define RW_PREFETCH(cc) do { const int _row = scan_row(b, dir, (cc) * T + st); \
      pr_r = *(const v2u*)(Rg + (size_t)_row * 1024 + ch); pr_k = *(const v2u*)(Kg + (size_t)_row * 1024 + ch); pr_v = *(const v2u*)(Vg + (size_t)_row * 1024 + ch); \
      const int _rowA = scan_row(b, dir, (cc) * T + rb * 16 + l16); \
      pa[0] = *(const v8s*)(L1 + (size_t)_rowA * 384 + qn * 128 + dir * 64 + lq * 8); pa[1] = *(const v8s*)(L1 + (size_t)_rowA * 384 + qn * 128 + dir * 64 + 32 + lq * 8); } while (0)
    RW_PREFETCH(0);
    for (int c = 0; c < NCH; ++c) {
      const int cur_row = scan_row(b, dir, c * T + st);
#pragma unroll
      for (int cb = 0; cb < 2; ++cb) {
        v4f acc = {0.f, 0.f, 0.f, 0.f};
        acc = __builtin_amdgcn_mfma_f32_16x16x32_bf16(pa[0], bfr[cb][0], acc, 0, 0, 0);
        acc = __builtin_amdgcn_mfma_f32_16x16x32_bf16(pa[1], bfr[cb][1], acc, 0, 0, 0);
#pragma unroll
        for (int jj = 0; jj < 4; ++jj) TMP[(qn * T + rb * 16 + lq * 4 + jj) * 64 + (cbp * 2 + cb) * 16 + l16] = acc[jj];
      }
      __syncthreads();
      {
        const v4f wp = *(const v4f*)(TMP + st * 64 + c0) + w0, ap = *(const v4f*)(TMP + (T + st) * 64 + c0) + a0;
        v4f r, k, v, dec, a, kkr;
        r[0] = bflo(pr_r.x); r[1] = bfhi(pr_r.x); r[2] = bflo(pr_r.y); r[3] = bfhi(pr_r.y);
        k[0] = bflo(pr_k.x); k[1] = bfhi(pr_k.x); k[2] = bflo(pr_k.y); k[3] = bfhi(pr_k.y);
        v[0] = bflo(pr_v.x); v[1] = bfhi(pr_v.x); v[2] = bflo(pr_v.y); v[3] = bfhi(pr_v.y);
#pragma unroll
        for (int e = 0; e < 4; ++e) {
          const float z = -wp[e];
          const float sp = z > 20.f ? z : log1pf(__expf(z));
          dec[e] = __expf(-__expf(-sp - 0.5f));
          a[e] = 1.f / (1.f + __expf(-ap[e]));
          kkr[e] = k[e] * kkc[e];
        }
        const float ss = row_sum16(dot4(kkr, kkr));
        const float rn = 1.0f / sqrtf(fmaxf(ss, 1e-12f));
        const v4f kk = kkr * rn;
        const v4f kd = k * ((a - 1.f) * kac + 1.f);
        const v4f bv = kk * a;
        const float br = row_sum16(dot4(bv, r)), kr = row_sum16(dot4(kd, r)), bon = row_sum16(dot4(r * kd, rkc));
        float* vb = VEC + st * 320 + c0;
        *(v4f*)(vb) = -kk; *(v4f*)(vb + 64) = dec * r; *(v4f*)(vb + 128) = dec; *(v4f*)(vb + 192) = bv; *(v4f*)(vb + 256) = kd;
        *(v4f*)(VV + st * 64 + c0) = v;
        if ((tid & 15) == 0) { SC[st * 2] = br; SC[st * 2 + 1] = kr; BON[((size_t)dir * M + cur_row) * 16 + h] = bon; }
      }
      __syncthreads();
      if (c + 1 < NCH) RW_PREFETCH(c + 1);
      for (int s = 0; s < T; ++s) {
        const float* vb = VEC + s * 320 + (lane & 15) * 4;
        const v4f a4 = *(const v4f*)(vb), wr4 = *(const v4f*)(vb + 64), w4 = *(const v4f*)(vb + 128), b4 = *(const v4f*)(vb + 192), k4 = *(const v4f*)(vb + 256);
        const v2f v2 = *(const v2f*)(VV + s * 64 + i0), sc2 = *(const v2f*)(SC + s * 2);
        float p0 = dot4(S0, a4), p1 = dot4(S1, a4), y0 = dot4(S0, wr4), y1 = dot4(S1, wr4);
        p0 = row_sum16(p0); p1 = row_sum16(p1); y0 = row_sum16(y0); y1 = row_sum16(y1);
        y0 += p0 * sc2.x + v2.x * sc2.y; y1 += p1 * sc2.x + v2.y * sc2.y;
        S0 = S0 * w4 + b4 * p0 + k4 * v2.x; S1 = S1 * w4 + b4 * p1 + k4 * v2.y;
        if ((lane & 15) == 0) *(v2f*)(YB + s * 64 + i0) = (v2f){y0, y1};
      }
      __syncthreads();
      {
        const v4f y4 = *(const v4f*)(YB + st * 64 + c0);
        v2u w; w.x = cvtpk(y4[0], y4[1]); w.y = cvtpk(y4[2], y4[3]);
        *(v2u*)(Yd + (size_t)cur_row * 1024 + ch) = w;
      }
    }
#undef RW_PREFETCH
    __syncthreads();
  }
}

#define LBAR() do { asm volatile("s_waitcnt lgkmcnt(0)" ::: "memory"); __builtin_amdgcn_s_barrier(); asm volatile("" ::: "memory"); } while (0)
__device__ void rwkv_scan2(PP p, unsigned char* smem, int slot) {
  constexpr int T = 32, NCH = TB / T;
  float* TMP = (float*)(smem);
  float* LW  = (float*)(smem + 16384);
  float* YB  = (float*)(smem + 24576);
  u16* AT = (u16*)(smem + 32768);
  u16* RT = (u16*)(smem + 32768 + 4608);
  u16* BT = (u16*)(smem + 32768 + 2 * 4608);
  u16* KT = (u16*)(smem + 32768 + 3 * 4608);
  u16* BKT = (u16*)(smem + 51200);
  float* GC = (float*)(smem + 69632);
  unsigned char* UBLK = smem + 107520;
  float* P1 = (float*)(smem + 73728);
  u16* CV = (u16*)(smem + 78848);
  u16* SB = (u16*)(smem + 89088);
  const int x_tid = get_tid();
  const u16* Rg = (const u16*)(p->ws + OFF_AR + AR_R); const u16* Kg = (const u16*)(p->ws + OFF_AR + AR_K); const u16* Vg = (const u16*)(p->ws + OFF_AR + AR_V);
  const u16* L1 = (const u16*)(p->ws + OFF_AR + AR_L1);
  float* BON = (float*)(p->ws + OFF_BON);
  for (int item = get_bid(); item < 256; item += get_gdim()) {
    const int dir = item >> 7, b = (item >> 4) & 7, h = item & 15;
    u16* Yd = (u16*)(p->ws + OFF_AR + (dir ? AR_Y1 : AR_Y0));
#define OPQV(v) ({ int _t = (v); asm volatile("" : "+v"(_t)); _t; })
    const int x_wid = __builtin_amdgcn_readfirstlane(x_tid >> 6);
    int tid = x_tid, wid = x_wid, lane = tid & 63;
    int st = tid >> 4, c0 = (tid & 15) * 4, ch = h * 64 + c0, su = st >> 4, tt = st & 15;
    const v4f w0 = *(const v4f*)(p->rw_w0 + (size_t)(slot * 2 + dir) * 1024 + ch), a0 = *(const v4f*)(p->rw_a0 + (size_t)(slot * 2 + dir) * 1024 + ch);
    const v4f kkc = *(const v4f*)(p->rw_kk + (size_t)slot * 1024 + ch), kac = *(const v4f*)(p->rw_ka + (size_t)slot * 1024 + ch), rkc = *(const v4f*)(p->rw_rk + (size_t)slot * 1024 + ch);
    int qn = wid >> 2, rb_ = (wid >> 1) & 1, cbp = wid & 1, l16 = lane & 15, lq = lane >> 4;
    const u16* WT = (const u16*)(p->ws + OFF_WB + (qn ? WB_RW_A2T : WB_RW_W2T)) + ((size_t)dir * 1024 + h * 64) * 64;
    v8s bfr[2][2];
#pragma unroll
    for (int cb = 0; cb < 2; ++cb)
#pragma unroll
      for (int ks = 0; ks < 2; ++ks) bfr[cb][ks] = *(const v8s*)(WT + (size_t)((cbp * 2 + cb) * 16 + l16) * 64 + ks * 32 + lq * 8);
    v4f S[2]; S[0] = (v4f){0.f, 0.f, 0.f, 0.f}; S[1] = (v4f){0.f, 0.f, 0.f, 0.f};
    for (int e = tid; e < 64 * 72; e += 512) SB[e] = 0;
    for (int e = tid; e < 2 * 64 * 40; e += 512) CV[e] = 0;
    for (int e = tid; e < 2 * 16 * 40; e += 512) { const int uu = e / 640, r = e - uu * 640; ((u16*)(UBLK + uu * 3584 + 1024))[r] = 0; }
    v2u pr_r, pr_k, pr_v; v8s pa[2];
#define RW_PREFETCH(cc) do { const int _row = scan_row(b, dir, (cc) * T + st); \
      pr_r = *(const v2u*)(Rg + (size_t)_row * 1024 + ch); pr_k = *(const v2u*)(Kg + (size_t)_row * 1024 + ch); pr_v = *(const v2u*)(Vg + (size_t)_row * 1024 + ch); \
      const int _rowA = scan_row(b, dir, (cc) * T + rb_ * 16 + l16); \
      pa[0] = *(const v8s*)(L1 + (size_t)_rowA * 384 + qn * 128 + dir * 64 + lq * 8); pa[1] = *(const v8s*)(L1 + (size_t)_rowA * 384 + qn * 128 + dir * 64 + 32 + lq * 8); } while (0)
    RW_PREFETCH(0);
    for (int c = 0; c < NCH; ++c) {
      tid = OPQV(x_tid); lane = tid & 63; st = tid >> 4; c0 = (tid & 15) * 4; ch = h * 64 + c0; su = st >> 4; tt = st & 15; l16 = lane & 15; lq = lane >> 4;
      const int cur_row = scan_row(b, dir, c * T + st);
#pragma unroll
      for (int cb = 0; cb < 2; ++cb) {
        v4f acc = {0.f, 0.f, 0.f, 0.f};
        acc = __builtin_amdgcn_mfma_f32_16x16x32_bf16(pa[0], bfr[cb][0], acc, 0, 0, 0);
        acc = __builtin_amdgcn_mfma_f32_16x16x32_bf16(pa[1], bfr[cb][1], acc, 0, 0, 0);
#pragma unroll
        for (int jj = 0; jj < 4; ++jj) TMP[(qn * T + rb_ * 16 + lq * 4 + jj) * 64 + (cbp * 2 + cb) * 16 + l16] = acc[jj];
      }
      LBAR();
      v4f r, k, v, lwv, a, kkr;
      {
        const v4f wp = *(const v4f*)(TMP + st * 64 + c0) + w0, ap = *(const v4f*)(TMP + (T + st) * 64 + c0) + a0;
        r[0] = bflo(pr_r.x); r[1] = bfhi(pr_r.x); r[2] = bflo(pr_r.y); r[3] = bfhi(pr_r.y);
        k[0] = bflo(pr_k.x); k[1] = bfhi(pr_k.x); k[2] = bflo(pr_k.y); k[3] = bfhi(pr_k.y);
        v[0] = bflo(pr_v.x); v[1] = bfhi(pr_v.x); v[2] = bflo(pr_v.y); v[3] = bfhi(pr_v.y);
#pragma unroll
        for (int e = 0; e < 4; ++e) {
          const float z = -wp[e];
          const float sp = fmaxf(z, 0.f) + __logf(1.f + __expf(-fabsf(z)));
          lwv[e] = -__expf(-sp - 0.5f);
          a[e] = __builtin_amdgcn_rcpf(1.f + __expf(-ap[e]));
          kkr[e] = k[e] * kkc[e];
        }
        *(v4f*)(LW + st * 64 + c0) = lwv;
      }
      if (c + 1 < NCH) RW_PREFETCH(c + 1);
      LBAR();
      {
        const int pu = wid >> 2, pj = wid & 3;
        v4f acc = {0.f, 0.f, 0.f, 0.f};
#pragma unroll
        for (int ks = 0; ks < 4; ++ks) {
          const int s = 4 * ks + lq;
          const float av = (s <= l16) ? 1.f : 0.f;
          const float bv_ = LW[(pu * 16 + s) * 64 + 16 * pj + l16];
          acc = __builtin_amdgcn_mfma_f32_16x16x4f32(av, bv_, acc, 0, 0, 0);
        }
#pragma unroll
        for (int jj = 0; jj < 4; ++jj) TMP[(pu * 16 + 4 * lq + jj) * 64 + 16 * pj + l16] = acc[jj];
      }
      LBAR();
      {
        const float ss = row_sum16(dot4(kkr, kkr));
        const float rn = __builtin_amdgcn_rsqf(fmaxf(ss, 1e-12f));
        const v4f kk = kkr * rn;
        const v4f kd = k * ((a - 1.f) * kac + 1.f);
        const v4f bv = kk * a;
        const float bon = row_sum16(dot4(r * kd, rkc));
        const v4f ci = *(const v4f*)(TMP + st * 64 + c0);
        const v4f ce = ci - lwv;
        v4f eci, ece, eni;
#pragma unroll
        for (int e = 0; e < 4; ++e) { eci[e] = __expf(ci[e]); ece[e] = __expf(ce[e]); eni[e] = __builtin_amdgcn_rcpf(eci[e]); }
        const v4f at = -kk * ece, rt = r * eci, bt = bv * eni, kt = kd * eni;
        const int ro = (su * 16 + tt) * 72 + c0;
        { v2u w; w.x = cvtpk(at[0], at[1]); w.y = cvtpk(at[2], at[3]); *(v2u*)(AT + ro) = w; }
        { v2u w; w.x = cvtpk(rt[0], rt[1]); w.y = cvtpk(rt[2], rt[3]); *(v2u*)(RT + ro) = w; }
        { v2u w; w.x = cvtpk(bt[0], bt[1]); w.y = cvtpk(bt[2], bt[3]); *(v2u*)(BT + ro) = w; }
        { v2u w; w.x = cvtpk(kt[0], kt[1]); w.y = cvtpk(kt[2], kt[3]); *(v2u*)(KT + ro) = w; }
#pragma unroll
        for (int e = 0; e < 4; ++e) {
          u16* bk = BKT + (su * 64 + c0 + e) * 40 + tt;
          bk[0] = (u16)(cvtpk(bt[e], bt[e]) & 0xffffu); bk[16] = (u16)(cvtpk(kt[e], kt[e]) & 0xffffu);
          CV[(su * 64 + c0 + e) * 40 + 16 + tt] = (u16)(cvtpk(v[e], v[e]) & 0xffffu);
        }
        if (tt == 15) *(v4f*)(GC + su * 64 + c0) = eci;
        if ((tid & 15) == 0) BON[((size_t)dir * M + cur_row) * 16 + h] = bon;
      }
      LBAR();
      {
        const int uu = wid >> 2, q = wid & 3;
        const u16* Am = (q & 1) ? KT : BT; const u16* Bm = (q & 2) ? RT : AT;
        v4f acc = {0.f, 0.f, 0.f, 0.f};
#pragma unroll
        for (int ks = 0; ks < 2; ++ks) {
          const v8s A = *(const v8s*)(Am + (uu * 16 + l16) * 72 + ks * 32 + lq * 8);
          const v8s B = *(const v8s*)(Bm + (uu * 16 + l16) * 72 + ks * 32 + lq * 8);
          acc = __builtin_amdgcn_mfma_f32_16x16x32_bf16(A, B, acc, 0, 0, 0);
        }
        float* UBTw = (float*)(UBLK + uu * 3584); u16* UKBw = (u16*)(UBLK + uu * 3584 + 1024); u16* WBKTw = (u16*)(UBLK + uu * 3584 + 2304);
#pragma unroll
        for (int jj = 0; jj < 4; ++jj) {
          const int s = 4 * lq + jj, t = l16;
          if (q == 0) UBTw[t * 16 + (s & 3) * 4 + (s >> 2)] = (s < t) ? acc[jj] : 0.f;
          else if (q == 1) { const float val = (s < t) ? acc[jj] : 0.f; UKBw[t * 40 + 16 + s] = (u16)(cvtpk(val, val) & 0xffffu); }
          else { const float val = (s <= t) ? acc[jj] : 0.f; WBKTw[t * 40 + (q == 3 ? 16 : 0) + s] = (u16)(cvtpk(val, val) & 0xffffu); }
        }
      }
      LBAR();
#pragma unroll
      for (int u = 0; u < 2; ++u) {
        lane = OPQV(x_tid) & 63; l16 = lane & 15; lq = lane >> 4;
        const int rbuf = u, wbuf = u ^ 1;
        float* UBT = (float*)(UBLK + u * 3584); u16* UKB = (u16*)(UBLK + u * 3584 + 1024); u16* WBKT = (u16*)(UBLK + u * 3584 + 2304);
        if (wid < 4) {
          v8s As0 = *(const v8s*)(SB + (rbuf * 64 + 16 * wid + l16) * 72 + lq * 8);
          v8s As1 = *(const v8s*)(SB + (rbuf * 64 + 16 * wid + l16) * 72 + 32 + lq * 8);
          v8s Ba0 = *(const v8s*)(AT + (u * 16 + l16) * 72 + lq * 8);
          v8s Ba1 = *(const v8s*)(AT + (u * 16 + l16) * 72 + 32 + lq * 8);
          v8s A2 = *(const v8s*)(CV + (u * 64 + 16 * wid + l16) * 40 + lq * 8);
          v8s B2 = *(const v8s*)(UKB + l16 * 40 + lq * 8);
          asm volatile("" : "+v"(As0), "+v"(As1), "+v"(Ba0), "+v"(Ba1), "+v"(A2), "+v"(B2));
          v4f accp = {0.f, 0.f, 0.f, 0.f};
          accp = __builtin_amdgcn_mfma_f32_16x16x32_bf16(As0, Ba0, accp, 0, 0, 0);
          accp = __builtin_amdgcn_mfma_f32_16x16x32_bf16(As1, Ba1, accp, 0, 0, 0);
          accp = __builtin_amdgcn_mfma_f32_16x16x32_bf16(A2, B2, accp, 0, 0, 0);
#pragma unroll
          for (int jj = 0; jj < 4; ++jj) P1[(16 * wid + 4 * lq + jj) * 20 + l16] = accp[jj];
        }
        LBAR();
        if (wid < 4) {
          const int gq = lane & 3, irow = 16 * wid + (lane >> 2);
          float p1v[16];
#pragma unroll
          for (int q4 = 0; q4 < 4; ++q4) { const v4f x = *(const v4f*)(P1 + irow * 20 + q4 * 4); p1v[q4 * 4] = x[0]; p1v[q4 * 4 + 1] = x[1]; p1v[q4 * 4 + 2] = x[2]; p1v[q4 * 4 + 3] = x[3]; }
          float cf[16]; float my0 = 0.f, my1 = 0.f, my2 = 0.f, my3 = 0.f;
          cf[0] = p1v[0]; my0 = (gq == 0) ? cf[0] : 0.f;
          v4f ubv[16];
#pragma unroll
          for (int t = 1; t < 16; ++t) ubv[t] = *(const v4f*)(UBT + t * 16 + gq * 4);
#pragma unroll
          for (int t = 1; t < 16; ++t) asm volatile("" : "+v"(ubv[t]));
#pragma unroll
          for (int t = 1; t < 16; ++t) {
            const v4f ub = ubv[t];
            const int kc = (t - 1) >> 2;
            float part = (gq == 0) ? p1v[t] : 0.f;
            if (kc != 0) part += my0 * ub[0];
            if (t > 4 && kc != 1) part += my1 * ub[1];
            if (t > 8 && kc != 2) part += my2 * ub[2];
            if (t > 12 && kc != 3) part += my3 * ub[3];
            part += (kc == 0 ? my0 : kc == 1 ? my1 : kc == 2 ? my2 : my3) * ub[kc];
            part += dppf<0xB1>(part); part += dppf<0x4E>(part);
            cf[t] = part;
            const bool mine = gq == (t & 3);
            if ((t >> 2) == 0) my0 = mine ? part : my0;
            else if ((t >> 2) == 1) my1 = mine ? part : my1;
            else if ((t >> 2) == 2) my2 = mine ? part : my2;
            else my3 = mine ? part : my3;
          }
          if (gq == 0) {
            v4u w0_, w1_;
            w0_.x = cvtpk(cf[0], cf[1]); w0_.y = cvtpk(cf[2], cf[3]); w0_.z = cvtpk(cf[4], cf[5]); w0_.w = cvtpk(cf[6], cf[7]);
            w1_.x = cvtpk(cf[8], cf[9]); w1_.y = cvtpk(cf[10], cf[11]); w1_.z = cvtpk(cf[12], cf[13]); w1_.w = cvtpk(cf[14], cf[15]);
            *(v4u*)(CV + (u * 64 + irow) * 40) = w0_; *(v4u*)(CV + (u * 64 + irow) * 40 + 8) = w1_;
          }
        }
        LBAR();
        {
          const int ib = wid >> 1, jb0 = 2 * (wid & 1);
          v8s Acv = *(const v8s*)(CV + (u * 64 + 16 * ib + l16) * 40 + lq * 8);
          v8s Bk0 = *(const v8s*)(BKT + (u * 64 + 16 * jb0 + l16) * 40 + lq * 8);
          v8s Bk1 = *(const v8s*)(BKT + (u * 64 + 16 * (jb0 + 1) + l16) * 40 + lq * 8);
          float gc0 = GC[u * 64 + 16 * jb0 + l16], gc1 = GC[u * 64 + 16 * (jb0 + 1) + l16];
          if (wid < 4) {
            v8s As0 = *(const v8s*)(SB + (rbuf * 64 + 16 * wid + l16) * 72 + lq * 8);
            v8s As1 = *(const v8s*)(SB + (rbuf * 64 + 16 * wid + l16) * 72 + 32 + lq * 8);
            v8s Br0 = *(const v8s*)(RT + (u * 16 + l16) * 72 + lq * 8);
            v8s Br1 = *(const v8s*)(RT + (u * 16 + l16) * 72 + 32 + lq * 8);
            v8s A2 = *(const v8s*)(CV + (u * 64 + 16 * wid + l16) * 40 + lq * 8);
            v8s B2 = *(const v8s*)(WBKT + l16 * 40 + lq * 8);
            asm volatile("" : "+v"(As0), "+v"(As1), "+v"(Br0), "+v"(Br1), "+v"(A2), "+v"(B2), "+v"(Acv), "+v"(Bk0), "+v"(Bk1), "+v"(gc0), "+v"(gc1));
            v4f acc = {0.f, 0.f, 0.f, 0.f};
            acc = __builtin_amdgcn_mfma_f32_16x16x32_bf16(As0, Br0, acc, 0, 0, 0);
            acc = __builtin_amdgcn_mfma_f32_16x16x32_bf16(As1, Br1, acc, 0, 0, 0);
            acc = __builtin_amdgcn_mfma_f32_16x16x32_bf16(A2, B2, acc, 0, 0, 0);
#pragma unroll
            for (int jj = 0; jj < 4; ++jj) YB[(u * 16 + l16) * 64 + 16 * wid + 4 * lq + jj] = acc[jj];
          } else {
            asm volatile("" : "+v"(Acv), "+v"(Bk0), "+v"(Bk1), "+v"(gc0), "+v"(gc1));
          }
          S[0] = __builtin_amdgcn_mfma_f32_16x16x32_bf16(Acv, Bk0, S[0], 0, 0, 0);
          S[1] = __builtin_amdgcn_mfma_f32_16x16x32_bf16(Acv, Bk1, S[1], 0, 0, 0);
          S[0] = S[0] * gc0; S[1] = S[1] * gc1;
#pragma unroll
          for (int bb = 0; bb < 2; ++bb)
#pragma unroll
            for (int jj = 0; jj < 4; ++jj) SB[(wbuf * 64 + 16 * ib + 4 * lq + jj) * 72 + 16 * (jb0 + bb) + l16] = (u16)(cvtpk(S[bb][jj], S[bb][jj]) & 0xffffu);
        }
        LBAR();
      }
      {
        const v4f y4 = *(const v4f*)(YB + st * 64 + c0);
        v2u w; w.x = cvtpk(y4[0], y4[1]); w.y = cvtpk(y4[2], y4[3]);
        *(v2u*)(Yd + (size_t)cur_row * 1024 + ch) = w;
      }
    }
#undef RW_PREFETCH
    __syncthreads();
  }
}

__device__ __forceinline__ float row_sum8(float v) { v += dppf<0xB1>(v); v += dppf<0x4E>(v); v += dppf<0x141>(v); return v; }
__device__ void rwkv_outprep(PP p, int slot) {
  const u16* Y0 = (const u16*)(p->ws + OFF_AR + AR_Y0); const u16* Y1 = (const u16*)(p->ws + OFF_AR + AR_Y1);
  const u16* Vg = (const u16*)(p->ws + OFF_AR + AR_V); const u16* Gg = (const u16*)(p->ws + OFF_AR + AR_G);
  u16* YG = (u16*)(p->ws + OFF_AR + AR_YG);
  const float* BON = (const float*)(p->ws + OFF_BON);
  for (int idx = get_bid() * 512 + get_tid(); idx < M * 128; idx += get_gdim() * 512) {
    const int row = idx >> 7, c0 = (idx & 127) * 8, h = c0 >> 6;
    const size_t off = (size_t)row * 1024 + c0;
    const v4u a = *(const v4u*)(Y0 + off), bq = *(const v4u*)(Y1 + off), vv = *(const v4u*)(Vg + off), gg = *(const v4u*)(Gg + off);
    float y[8];
#pragma unroll
    for (int j = 0; j < 4; ++j) { y[2 * j] = bflo(a[j]) + bflo(bq[j]); y[2 * j + 1] = bfhi(a[j]) + bfhi(bq[j]); }
    float s = 0.f;
#pragma unroll
    for (int j = 0; j < 8; ++j) s += y[j];
    const float mean = row_sum8(s) * (1.f / 64.f);
    float sq = 0.f;
#pragma unroll
    for (int j = 0; j < 8; ++j) { y[j] -= mean; sq += y[j] * y[j]; }
    const float rstd = 1.0f / sqrtf(row_sum8(sq) * (1.f / 64.f) + 64e-5f);
    const float bon = BON[(size_t)row * 16 + h] + BON[((size_t)M + row) * 16 + h];
    const v4f lg0 = *(const v4f*)(p->rw_lng + (size_t)slot * 1024 + c0), lg1 = *(const v4f*)(p->rw_lng + (size_t)slot * 1024 + c0 + 4);
    const v4f lb0 = *(const v4f*)(p->rw_lnb + (size_t)slot * 1024 + c0), lb1 = *(const v4f*)(p->rw_lnb + (size_t)slot * 1024 + c0 + 4);
    float o[8];
#pragma unroll
    for (int j = 0; j < 8; ++j) {
      const float lg = j < 4 ? lg0[j & 3] : lg1[j & 3], lb = j < 4 ? lb0[j & 3] : lb1[j & 3];
      const float v = (j & 1) ? bfhi(vv[j >> 1]) : bflo(vv[j >> 1]);
      const float g = (j & 1) ? bfhi(gg[j >> 1]) : bflo(gg[j >> 1]);
      o[j] = (y[j] * rstd * lg + lb + v * bon) * g;
    }
    v4u w; w.x = cvtpk(o[0], o[1]); w.y = cvtpk(o[2], o[3]); w.z = cvtpk(o[4], o[5]); w.w = cvtpk(o[6], o[7]);
    *(v4u*)(YG + off) = w;
  }
}

#define XB_TMO      128
#define XB_XCNT(j)  (256  + 64 * (j))
#define XB_XSUB(j)  (1280 + 64 * (j))
#define XB_XGEN(j)  (2304 + 64 * (j))
#define XB_TOP      3328
#define XB_TOPGEN   3392
#define XCD_BAR_WORDS 3456
#define XB_SPIN_CAP (1u << 23)
#ifndef LAS
#define LAS __attribute__((address_space(3)))
#endif

__device__ __forceinline__ unsigned xb_ld(unsigned* p)              { return __hip_atomic_load(p, __ATOMIC_RELAXED, __HIP_MEMORY_SCOPE_AGENT); }
__device__ __forceinline__ unsigned xb_add(unsigned* p, unsigned v) { return __hip_atomic_fetch_add(p, v, __ATOMIC_RELAXED, __HIP_MEMORY_SCOPE_AGENT); }
__device__ __forceinline__ unsigned xb_xcc_id() { return (unsigned)__builtin_amdgcn_s_getreg((3 << 11) | 20) & 0xFu; }
#define XB_SPIN(cond, bar) do { unsigned _sp = 0; while (cond) { __builtin_amdgcn_s_sleep(1); \
    if ((++_sp & 255u) == 0u) { if (xb_ld(&(bar)[XB_TMO])) break; if (_sp > XB_SPIN_CAP) { atomicAdd(&(bar)[XB_TMO], 1u); break; } } } } while (0)

struct XcdBarrier {
    unsigned* bar; unsigned x;
    volatile LAS unsigned* st;
};

__device__ __forceinline__ XcdBarrier xcd_barrier_post(unsigned* bar, volatile LAS unsigned* st) {
    XcdBarrier b; b.bar = bar; b.x = xb_xcc_id(); b.st = st;
    if (get_tid() == 0) (void)xb_add(&bar[XB_XCNT(b.x)], 1u);
    return b;
}
__device__ __forceinline__ void xcd_barrier_complete(unsigned* bar, unsigned x, unsigned& nloc, unsigned& nx) {
    const unsigned G = gridDim.x * gridDim.y * gridDim.z;
    unsigned sum, cnt, mine, sp = 0u;
    for (;;) {
        sum = 0u; cnt = 0u; mine = 0u;
#pragma unroll
        for (unsigned j = 0; j < 16; ++j) { const unsigned c = xb_ld(&bar[XB_XCNT(j)]); sum += c; cnt += (c > 0u) ? 1u : 0u; mine = (j == x) ? c : mine; }
        if (sum == G) break;
        __builtin_amdgcn_s_sleep(1);
        if ((++sp & 255u) == 0u) { if (xb_ld(&bar[XB_TMO])) break; if (sp > XB_SPIN_CAP) { atomicAdd(&bar[XB_TMO], 1u); break; } }
    }
    nloc = mine > 0u ? mine : 1u; nx = cnt > 0u ? cnt : 1u;
}

__device__ __forceinline__ void xcd_barrier(const XcdBarrier& b) {
    asm volatile("s_waitcnt vmcnt(0)" ::: "memory");
    __syncthreads();
    if (get_tid() == 0) {
        unsigned* bar = b.bar;
        __builtin_amdgcn_s_waitcnt(0);
        unsigned nloc = b.st[0], nx = b.st[1];
        if (nloc == 0u) { xcd_barrier_complete(bar, b.x, nloc, nx); b.st[0] = nloc; b.st[1] = nx; }
        const unsigned old = xb_add(&bar[XB_XSUB(b.x)], 1u);
        const unsigned gen = old / nloc;
        if (old + 1u == (gen + 1u) * nloc) {
            __builtin_amdgcn_fence(__ATOMIC_RELEASE, "agent");
            asm volatile("s_waitcnt vmcnt(0)" ::: "memory");
            const unsigned og = xb_add(&bar[XB_TOP], 1u);
            const unsigned tg = og / nx;
            if (og + 1u == (tg + 1u) * nx) xb_add(&bar[XB_TOPGEN], 1u);
            else XB_SPIN(xb_ld(&bar[XB_TOPGEN]) == tg, bar);
            __builtin_amdgcn_fence(__ATOMIC_ACQUIRE, "agent");
            xb_add(&bar[XB_XGEN(b.x)], 1u);
            asm volatile("s_waitcnt vmcnt(0)" ::: "memory");
        } else {
            XB_SPIN(xb_ld(&bar[XB_XGEN(b.x)]) == gen, bar);
            __builtin_amdgcn_fence(__ATOMIC_ACQUIRE, "agent");
            asm volatile("s_waitcnt vmcnt(0)" ::: "memory");
        }
    }
    __syncthreads();
}


enum { OP_MOD = 0, OP_ROWA, OP_XX, OP_QKV, OP_QKPREP, OP_ATTN, OP_NA, OP_RW1, OP_SCAN, OP_OUTPREP, OP_WO, OP_ROWE, OP_MLP1, OP_MLP2, OP_FINAL };
__device__ __forceinline__ void decode_phase(int ph, int& layer, int& op) {
  if (ph == 0) { layer = 0; op = OP_MOD; return; }
  if (ph >= 33) { layer = 3; op = OP_FINAL; return; }
  int s;
  if (ph < 9) { layer = 0; s = ph - 1; } else if (ph < 16) { layer = 1; s = ph - 9; } else if (ph < 25) { layer = 2; s = ph - 16; } else { layer = 3; s = ph - 25; }
  const int kind = layer % 3;
  if (kind == 0) { op = s == 0 ? OP_ROWA : s == 1 ? OP_QKV : s == 2 ? OP_QKPREP : s == 3 ? OP_ATTN : s == 4 ? OP_WO : s == 5 ? OP_ROWE : s == 6 ? OP_MLP1 : OP_MLP2; }
  else if (kind == 1) op = s == 0 ? OP_ROWA : s == 1 ? OP_QKV : s == 2 ? OP_NA : s == 3 ? OP_WO : s == 4 ? OP_ROWE : s == 5 ? OP_MLP1 : OP_MLP2;
  else op = s == 0 ? OP_ROWA : s == 1 ? OP_XX : s == 2 ? OP_RW1 : s == 3 ? OP_SCAN : s == 4 ? OP_OUTPREP : s == 5 ? OP_WO : s == 6 ? OP_ROWE : s == 7 ? OP_MLP1 : OP_MLP2;
}

__global__ void __launch_bounds__(512, 2) mega(P p_, int lo, int hi) {
  extern __shared__ __attribute__((aligned(16))) unsigned char smem[];
  cg::grid_group grid = cg::this_grid();
  volatile LAS unsigned* xst = (volatile LAS unsigned*)(smem + 131072 + 16);
  if (get_tid() == 0) { xst[0] = 0u; xst[1] = 0u; }
  __syncthreads();
  XcdBarrier xbar; xbar.bar = nullptr; xbar.x = 0; xbar.st = xst;
  if (hi - lo > 1) { PP pb = (PP)__builtin_amdgcn_kernarg_segment_ptr(); xbar = xcd_barrier_post((unsigned*)(pb->ws + OFF_BARW), xst); }
  if (lo == 0) {
    PP p0 = (PP)__builtin_amdgcn_kernarg_segment_ptr();
    asm volatile("" : "+s"(p0));
    phase_mod(p0, smem);
    if (hi > 1) grid.sync();
    lo = 1;
  }
  for (int ph = lo; ph < hi; ++ph) {
    PP p = (PP)__builtin_amdgcn_kernarg_segment_ptr();
    asm volatile("" : "+s"(p));
    unsigned char* AR = p->ws + OFF_AR;
    const float* MOD = (const float*)(p->ws + OFF_MOD);
    int layer, op; decode_phase(ph, layer, op);
#ifdef DUP_OP
    for (int rep = 0; rep < ((op == DUP_OP) ? 2 : 1); ++rep) {
#else
    {
#endif
    const int kind = layer % 3, slot = layer / 3;
    const bool want_ctx = layer < 3;
    if (op == OP_ROWA) {
      if (layer == 0) convert_layer_weights(p, layer, smem, get_bid(), get_gdim(), get_gdim() == 256 ? 2 : 7);
      if (layer == 0) rowpass(p, -1, layer, 0, (u16*)(AR + AR_H), 1024, false);
      else rowpass(p, (layer - 1) * 2 + 1, layer, 0, (u16*)(AR + AR_H), kind == 2 ? 2048 : 1024, false, false, 8, (const float*)(AR + AR_PART_MLP2), (layer - 1) * 2, MOD + (size_t)((layer - 1) * 9 + 8) * 6144 + 5 * 1024);
    }
    else if (op == OP_ROWE) {
      if (layer == 3) rowpass(p, layer * 2, layer, 3, (u16*)(AR + AR_H), 1024, false, true);
      else rowpass(p, layer * 2, layer, 3, (u16*)(AR + AR_H), 1024, false, false, 4, (const float*)(AR + AR_PART_WO), layer == 0 ? -1 : (layer - 1) * 2 + 1, MOD + (size_t)(layer * 9 + 8) * 6144 + 2 * 1024, layer == 0);
    }
    else if (op == OP_FINAL) rowpass(p, 7, 0, 0, nullptr, 0, true);
    else if (op == OP_XX) xx_pass(p);
    else if (op == OP_QKPREP) qk_prep(p, slot);
    else if (op == OP_ATTN) {
#ifndef NO_ATTN
      gqa_attention(p, smem, want_ctx, slot);
#endif
    }
    else if (op == OP_NA) {
#ifndef NO_NA
      na_attention(p, smem, want_ctx);
#endif
    }
    else if (op == OP_OUTPREP) rwkv_outprep(p, slot);
    else if (op == OP_RW1) {
      EpiRw1 E{(u16*)(AR + AR_R), (u16*)(AR + AR_L1)};
#ifndef NO_RW1
      run_gemm(smem, (const u16*)(AR + AR_H), (const u16*)(p->ws + OFF_WB + WB_MIX), M, 3584, 2048, E);
#endif
    }
    else if (op == OP_QKV || op == OP_MLP1 || op == OP_SCAN) {
      int ng = 1;
      const u16 *A0, *B0, *A1 = nullptr, *B1 = nullptr; u16 *O0, *O1 = nullptr; int M0, N0, K0, L0, M1 = 0, N1 = 0, K1 = 0, L1_ = 0, act = 0, ld0 = 0;
      if (op == OP_MLP1) { A0 = (const u16*)(AR + AR_H); B0 = (const u16*)(p->ws + OFF_WB + WB_W1T); O0 = (u16*)(AR + AR_HID); M0 = M; N0 = 4096; K0 = 1024; L0 = 4096; act = 1; }
      else if (op == OP_SCAN) { A0 = (const u16*)(AR + AR_L1) + 256; B0 = (const u16*)(p->ws + OFF_WB + WB_RW_BG) + 256; O0 = (u16*)(AR + AR_G); M0 = M; N0 = 1024; K0 = 128; L0 = 1024; ld0 = 384; }
      else if (kind == 0) { A0 = (const u16*)(AR + AR_H); B0 = (const u16*)(p->ws + OFF_WB + WB_MIX); O0 = (u16*)(AR + AR_QKV); M0 = M; N0 = 1536; K0 = 1024; L0 = 1536; }
      else { A0 = (const u16*)(AR + AR_H); B0 = (const u16*)(p->ws + OFF_WB + WB_MIX); O0 = (u16*)(AR + AR_NA_QK); M0 = M; N0 = 2048; K0 = 1024; L0 = 2048;
             ng = 2; A1 = (const u16*)(p->ws + OFF_WB + WB_MIX) + (size_t)2048 * 1024; B1 = (const u16*)(AR + AR_H); O1 = (u16*)(AR + AR_NA_VT); M1 = 1024; N1 = M; K1 = 1024; L1_ = M; }
      for (int g = 0; g < ng; ++g) {
        EpiStore E{g ? O1 : O0, g ? L1_ : L0, act};
#ifndef NO_GS
        run_gemm(smem, g ? A1 : A0, g ? B1 : B0, g ? M1 : M0, g ? N1 : N0, g ? K1 : K0, E, (op == OP_MLP1 && layer == 3) ? 1 : 0, g ? 0 : ld0, (g && get_gdim() == 256) ? 128 : 0);
#endif
      }
#ifndef NO_SCAN
#ifdef SCAN_V1
      if (op == OP_SCAN) rwkv_scan(p, smem, slot);
#else
      if (op == OP_SCAN) rwkv_scan2(p, smem, slot);
#endif
      if (op == OP_MLP1 && layer < 3 && get_gdim() == 256 && get_bid() >= 128) convert_layer_weights(p, layer + 1, smem, get_bid() - 128, 128, 6);
      if (op == OP_QKV && layer == 0 && get_gdim() == 256 && get_bid() >= 48) convert_layer_weights(p, 0, smem, get_bid() - 48, 208, 5);
#endif
    }
    else if (op == OP_WO || op == OP_MLP2) {
      const u16 *A, *B; int K; const float* gate;
      if (op == OP_MLP2) { A = (const u16*)(AR + AR_HID); B = (const u16*)(p->ws + OFF_WB + ((layer & 1) ? WB_W2T_B : WB_W2T)); K = 4096; gate = MOD + (size_t)layer * 9 * 6144 + 5 * 1024; }
      else { K = 1024; gate = MOD + (size_t)layer * 9 * 6144 + 2 * 1024;
        if (kind == 0) { A = (const u16*)(AR + AR_ATT_O); B = (const u16*)(p->ws + OFF_WB + WB_ATT_WO); }
        else if (kind == 1) { A = (const u16*)(AR + AR_NA_O); B = (const u16*)(p->ws + OFF_WB + WB_NA_WO); }
        else { A = (const u16*)(AR + AR_YG); B = (const u16*)(p->ws + OFF_WB + WB_RW_WO); } }
      const int pln = (op == OP_MLP2) ? layer * 2 : (layer == 0 ? -1 : (layer - 1) * 2 + 1);
#ifndef NO_GR
      const int nsplit = op == OP_MLP2 ? 8 : 4, Ksub = K / nsplit;
      for (int pass = 0; pass < (layer < 3 ? 2 : 1); ++pass) {
        const int c = get_bid(), unit = c / nsplit, ks = c - unit * nsplit;
        float* part = pass ? (float*)(AR + (op == OP_MLP2 ? AR_PART_MLP2 : AR_PART_WO)) + (size_t)ks * 2048 * 1024 : nullptr;
        EpiResid E{p->out, (float*)(p->ws + OFF_XC), gate, (const float*)(p->ws + OFF_STATS), pln < 0 ? nullptr : p->ln_g + (size_t)pln * 1024, pln < 0 ? nullptr : p->ln_b + (size_t)pln * 1024, part, (op == OP_WO && layer == 0) ? p->x : (const float*)p->out, (op == OP_WO && layer == 0) ? p->ctx : (const float*)(p->ws + OFF_XC)};
        pg8::Gemm g{pass ? A + (size_t)ks * Ksub : A, pass ? B + (size_t)ks * Ksub : B, M, 1024, pass ? Ksub : K, K};
        pg8::StaticOrder S; S.init(M, 1024, get_gdim(), c, 1);
        if (pass) { S.one = unit < 32 ? 1 : 2; S.one_pm = (unit >> 2) * 17 + 16; S.one_pn = unit & 3; }
        pg8::gemm_phase<EpiResid, pg8::StaticOrder, false>((PG8_LAS unsigned char*)smem, g, S, E, nullptr);
        __syncthreads();
      }
#endif
      if (op == OP_MLP2 && layer < 3) convert_layer_weights(p, layer + 1, smem, get_bid(), get_gdim(), get_gdim() == 256 ? 1 : 7);
    }
    }
    if (ph + 1 < hi) xcd_barrier(xbar);
  }
}

extern "C" void kernel_launch(void* const* d_in, const int* in_sizes, int n_in, void* d_out, int out_size, void* d_ws, size_t ws_size, hipStream_t stream) {
  static int grid_blocks = 0;
  if (!grid_blocks) {
    int dev = 0, cus = 0, per_cu = 0;
    hipGetDevice(&dev);
    hipDeviceGetAttribute(&cus, hipDeviceAttributeMultiprocessorCount, dev);
    hipFuncSetAttribute((const void*)mega, hipFuncAttributeMaxDynamicSharedMemorySize, LDS_BYTES);
    hipOccupancyMaxActiveBlocksPerMultiprocessor(&per_cu, (const void*)mega, 512, LDS_BYTES);
    if (per_cu < 1) per_cu = 1;
    grid_blocks = cus * per_cu;
    if (grid_blocks > 256) grid_blocks = 256;
    if (ws_size < 492 * MiB) fprintf(stderr, "kernel_launch: workspace too small: %zu\n", ws_size);
  }
  P p{};
  const float** pf = (const float**)&p;
  for (int i = 0; i < 35; ++i) pf[i] = (const float*)d_in[i];
  p.out = (float*)d_out; p.ws = (unsigned char*)d_ws;
#if FUSED
  hipMemsetAsync((unsigned char*)d_ws + OFF_BARW, 0, XCD_BAR_WORDS * 4, stream);
  int lo = 0, hi = NPHASE;
  void* args[] = {&p, &lo, &hi};
  hipError_t e = hipLaunchCooperativeKernel((const void*)mega, dim3(grid_blocks), dim3(512), args, LDS_BYTES, stream);
  if (e != hipSuccess) fprintf(stderr, "cooperative launch failed: %s (grid %d)\n", hipGetErrorString(e), grid_blocks);
#else
  for (int ph = 0; ph < NPHASE; ++ph) hipLaunchKernelGGL(mega, dim3(grid_blocks), dim3(512), LDS_BYTES, stream, p, ph, ph + 1);
#endif
}
```
